# Optimizing an MI355X kernel written in HIP

```python
import jax
import jax.numpy as jnp
from jax import lax
import numpy as np

D_MODEL = 1024
BATCH = 2
SEQ = 8192
DEPTH = 1

GRID_W = 64
CTX_LEN = 256
D_MIX = D_MODEL
CONV_CH = D_MIX // 2
CONV_WIDTH = 31
N_HEADS = 8
HEAD_DIM = (D_MIX - CONV_CH) // N_HEADS
ATTN_W = N_HEADS * HEAD_DIM
NA_ROWS = 8
NA_COLS = 16
QB_W = 16
KB_W = 32
N_EXPERTS = 16
D_EXPERT = 2048
EC_FACTOR = 2
N_MOD = 6
EPS = 1e-6
NEG_INF = -1e30
W_IN_COLS = 2 * CONV_CH + 3 * ATTN_W

kernel_name = 'hybrid_conformer_natten_ec_dit'


def rms_norm(x, g):
    xf = x.astype(jnp.float32)
    y = xf * lax.rsqrt(jnp.mean(xf * xf, axis=-1, keepdims=True) + EPS)
    return (y * g.astype(jnp.float32)).astype(x.dtype)


def layer_norm(x, g, b):
    xf = x.astype(jnp.float32)
    mu = jnp.mean(xf, axis=-1, keepdims=True)
    var = jnp.mean(jnp.square(xf - mu), axis=-1, keepdims=True)
    y = (xf - mu) * lax.rsqrt(var + EPS)
    return (y * g.astype(jnp.float32) + b.astype(jnp.float32)).astype(x.dtype)


def adaln(cvec, w_mod, b_mod):
    m = (jax.nn.silu(cvec) @ w_mod + b_mod).reshape(-1, 1, N_MOD * D_MODEL)
    return jnp.split(m, N_MOD, axis=-1)


def modulate(h, shift, scale):
    return h * (1.0 + scale) + shift


def conv_mixer(u, conv_w, conv_b, ln_g, ln_b):
    a, g = jnp.split(u, 2, axis=-1)
    v = a * jax.nn.sigmoid(g)
    y = lax.conv_general_dilated(
        v, conv_w[:, None, :].astype(v.dtype), window_strides=(1,),
        padding=[(CONV_WIDTH // 2, CONV_WIDTH // 2)],
        dimension_numbers=('NWC', 'WIO', 'NWC'), feature_group_count=CONV_CH) + conv_b
    return jax.nn.silu(layer_norm(y, ln_g, ln_b))


def na_indices(rows):
    kh = min(NA_ROWS, rows)
    n_blk = GRID_W // QB_W
    r = jnp.arange(rows)
    r0 = jnp.clip(r - kh // 2, 0, rows - kh)
    key_rows = r0[:, None] + jnp.arange(kh)[None, :]
    q_cols = jnp.arange(GRID_W).reshape(n_blk, QB_W)
    band0 = jnp.clip(jnp.arange(n_blk) * QB_W - (KB_W - QB_W) // 2, 0, GRID_W - KB_W)
    key_cols = band0[:, None] + jnp.arange(KB_W)[None, :]
    c0 = jnp.clip(q_cols - NA_COLS // 2, 0, GRID_W - NA_COLS)
    kc_b = key_cols[:, None, :]
    col_valid = (kc_b >= c0[:, :, None]) & (kc_b < c0[:, :, None] + NA_COLS)
    d_row = key_rows - r[:, None] + (NA_ROWS - 1)
    d_col = jnp.clip(kc_b - q_cols[:, :, None] + (NA_COLS - 1), 0, 2 * NA_COLS - 2)
    return key_rows, key_cols, col_valid, d_row, d_col


def na_attention(q, k, v, k_ctx, v_ctx, rpb, idx):
    key_rows, key_cols, col_valid, d_row, d_col = idx
    B, T, _ = q.shape
    rows, kh = key_rows.shape
    n_blk = GRID_W // QB_W
    L = k_ctx.shape[1]
    f32 = jnp.float32
    qb = q.reshape(B, rows, n_blk, QB_W, N_HEADS, HEAD_DIM).astype(f32) * (HEAD_DIM ** -0.5)
    kg = k.reshape(B, rows, GRID_W, N_HEADS, HEAD_DIM)
    vg = v.reshape(B, rows, GRID_W, N_HEADS, HEAD_DIM)
    ri = key_rows[:, None, :, None]
    ci = key_cols[None, :, None, :]
    k_band = kg[:, ri, ci]
    v_band = vg[:, ri, ci]
    kcx = k_ctx.reshape(B, L, N_HEADS, HEAD_DIM)
    vcx = v_ctx.reshape(B, L, N_HEADS, HEAD_DIM)
    bias = rpb[:, d_row[:, None, None, :, None], d_col[None, :, :, None, :]]
    s_loc = jnp.einsum('brnqhd,brnjwhd->bhrnqjw', qb, k_band.astype(f32)) + bias.astype(f32)[None]
    s_loc = jnp.where(col_valid[:, :, None, :], s_loc, NEG_INF)
    s_ctx = jnp.einsum('brnqhd,blhd->bhrnql', qb, kcx.astype(f32))
    n_loc = kh * KB_W
    s = jnp.concatenate([s_loc.reshape(s_loc.shape[:5] + (n_loc,)), s_ctx], axis=-1)
    p = jax.nn.softmax(s, axis=-1).astype(v.dtype)
    p_loc = p[..., :n_loc].reshape(s_loc.shape)
    p_ctx = p[..., n_loc:]
    o = (jnp.einsum('bhrnqjw,brnjwhd->brnqhd', p_loc, v_band)
         + jnp.einsum('bhrnql,blhd->brnqhd', p_ctx, vcx))
    return o.reshape(B, T, ATTN_W)


def ctx_attention(q, k, v):
    B, L, _ = q.shape
    f32 = jnp.float32
    qh = q.reshape(B, L, N_HEADS, HEAD_DIM).astype(f32) * (HEAD_DIM ** -0.5)
    kh = k.reshape(B, L, N_HEADS, HEAD_DIM).astype(f32)
    vh = v.reshape(B, L, N_HEADS, HEAD_DIM)
    p = jax.nn.softmax(jnp.einsum('blhd,bmhd->bhlm', qh, kh), axis=-1).astype(v.dtype)
    return jnp.einsum('bhlm,bmhd->blhd', p, vh).reshape(B, L, ATTN_W)


def ec_moe(h, w_router, w_gate, w_up, w_down):
    B, T, _ = h.shape
    cap = EC_FACTOR * T // N_EXPERTS
    aff = jax.nn.softmax((h @ w_router).astype(jnp.float32), axis=-1)
    wts, tok = lax.top_k(jnp.swapaxes(aff, 1, 2), cap)
    bidx = jnp.arange(B)[:, None, None]
    xs = h[bidx, tok]
    hid = jax.nn.silu(jnp.einsum('becd,edf->becf', xs, w_gate)) * jnp.einsum('becd,edf->becf', xs, w_up)
    y = jnp.einsum('becf,efd->becd', hid, w_down) * wts[..., None].astype(h.dtype)
    return jnp.zeros_like(h).at[bidx, tok].add(y)


def setup_inputs(seed: int = 0) -> dict:
    key = jax.random.key(seed)
    ks = jax.random.split(key, 21)
    f32 = jnp.float32

    def nrm(k, shape, scale):
        return jax.random.normal(k, shape, f32) * scale

    return {
        'x': nrm(ks[0], (BATCH, SEQ, D_MODEL), 1.0),
        'c': nrm(ks[1], (BATCH, D_MODEL), 1.0),
        'ctx': nrm(ks[2], (BATCH, CTX_LEN, D_MODEL), 1.0),
        'c_ctx': nrm(ks[3], (D_MODEL,), 1.0),
        'w_mod': nrm(ks[4], (DEPTH, D_MODEL, N_MOD * D_MODEL), 0.5 * D_MODEL ** -0.5),
        'b_mod': nrm(ks[5], (DEPTH, N_MOD * D_MODEL), 0.02),
        'norm_mix_g': 1.0 + nrm(ks[6], (DEPTH, D_MODEL), 0.02),
        'w_in': nrm(ks[7], (DEPTH, D_MODEL, W_IN_COLS), D_MODEL ** -0.5),
        'conv_w': nrm(ks[8], (DEPTH, CONV_WIDTH, CONV_CH), CONV_WIDTH ** -0.5),
        'conv_b': nrm(ks[9], (DEPTH, CONV_CH), 0.02),
        'conv_ln_g': 1.0 + nrm(ks[10], (DEPTH, CONV_CH), 0.02),
        'conv_ln_b': nrm(ks[11], (DEPTH, CONV_CH), 0.02),
        'rpb': nrm(ks[12], (DEPTH, N_HEADS, 2 * NA_ROWS - 1, 2 * NA_COLS - 1), 0.1),
        'w_out': nrm(ks[13], (DEPTH, D_MIX, D_MODEL), D_MIX ** -0.5),
        'norm_ffn_g': 1.0 + nrm(ks[14], (DEPTH, D_MODEL), 0.02),
        'w_router': nrm(ks[15], (DEPTH, D_MODEL, N_EXPERTS), D_MODEL ** -0.5),
        'w_gate': nrm(ks[16], (DEPTH, N_EXPERTS, D_MODEL, D_EXPERT), D_MODEL ** -0.5),
        'w_up': nrm(ks[17], (DEPTH, N_EXPERTS, D_MODEL, D_EXPERT), D_MODEL ** -0.5),
        'w_down': nrm(ks[18], (DEPTH, N_EXPERTS, D_EXPERT, D_MODEL), D_EXPERT ** -0.5),
        'norm_final_g': 1.0 + nrm(ks[19], (D_MODEL,), 0.02),
    }


def reference(x, c, ctx, c_ctx, w_mod, b_mod, norm_mix_g, w_in, conv_w, conv_b, conv_ln_g, conv_ln_b,
              rpb, w_out, norm_ffn_g, w_router, w_gate, w_up, w_down, norm_final_g):
    B, T, _ = x.shape
    rows = T // GRID_W
    idx = na_indices(rows)
    splits = [2 * CONV_CH, 2 * CONV_CH + ATTN_W, 2 * CONV_CH + 2 * ATTN_W]
    for l in range(DEPTH):
        last = l == DEPTH - 1
        sh1, sc1, g1, sh2, sc2, g2 = adaln(c, w_mod[l], b_mod[l])
        csh1, csc1, cg1, csh2, csc2, cg2 = adaln(c_ctx, w_mod[l], b_mod[l])

        h = modulate(rms_norm(x, norm_mix_g[l]), sh1, sc1)
        hc = modulate(rms_norm(ctx, norm_mix_g[l]), csh1, csc1)
        u, q, k, v = jnp.split(h @ w_in[l], splits, axis=-1)
        if last:
            k_c, v_c = jnp.split(hc @ w_in[l][:, splits[1]:], 2, axis=-1)
        else:
            u_c, q_c, k_c, v_c = jnp.split(hc @ w_in[l], splits, axis=-1)
        y_conv = conv_mixer(u, conv_w[l], conv_b[l], conv_ln_g[l], conv_ln_b[l])
        y_attn = na_attention(q, k, v, k_c, v_c, rpb[l], idx)
        x = x + g1 * (jnp.concatenate([y_conv, y_attn], axis=-1) @ w_out[l])
        if not last:
            yc_conv = conv_mixer(u_c, conv_w[l], conv_b[l], conv_ln_g[l], conv_ln_b[l])
            yc_attn = ctx_attention(q_c, k_c, v_c)
            ctx = ctx + cg1 * (jnp.concatenate([yc_conv, yc_attn], axis=-1) @ w_out[l])

        h2 = modulate(rms_norm(x, norm_ffn_g[l]), sh2, sc2)
        x = x + g2 * ec_moe(h2, w_router[l], w_gate[l], w_up[l], w_down[l])
        if not last:
            hc2 = modulate(rms_norm(ctx, norm_ffn_g[l]), csh2, csc2)
            ctx = ctx + cg2 * ec_moe(hc2, w_router[l], w_gate[l], w_up[l], w_down[l])
    return rms_norm(x, norm_final_g)
```

```cpp
#include <hip/hip_runtime.h>
#include <cstdio>
#include <cstdint>

#ifndef MK_ONE_LAUNCH
#define MK_ONE_LAUNCH 0
#endif

namespace pg8 {
#define PG8_LAS __attribute__((address_space(3)))
typedef unsigned short bf16_t;
typedef short bf16x8 __attribute__((ext_vector_type(8)));
typedef float f32x4 __attribute__((ext_vector_type(4)));
typedef unsigned u32x4 __attribute__((ext_vector_type(4)));
constexpr int BM = 256, BK = 64, HALF = 128, HTB = HALF * BK * 2, STAGE_BYTES = 8 * HTB;

__host__ __device__ __forceinline__ int lds_byte(int r, int c) { const int st = (r >> 4) * 2 + (c >> 5), rr = r & 15, cc = c & 31, ob = rr * 64 + cc * 2; return st * 1024 + (ob ^ (((ob >> 9) & 1) << 5)); }
__host__ __device__ __forceinline__ void stage_rc(int b, int& R, int& C) { const int st = b / 1024, sb = b % 1024, swz = sb ^ (((sb >> 9) & 1) << 5); R = (st >> 1) * 16 + swz / 64; C = (st & 1) * 32 + (swz % 64) / 2; }
__host__ __device__ __forceinline__ int perm32(int rho) { const int n = rho >> 4, i = rho & 15; return 8 * (i >> 2) + 4 * n + (i & 3); }

struct Unit { int pm, pn, kind; const char* A; const char* B; };

__device__ __forceinline__ unsigned cvt_pk_bf16(float lo, float hi) { unsigned r; asm volatile("v_cvt_pk_bf16_f32 %0, %1, %2" : "=v"(r) : "v"(lo), "v"(hi)); return r; }

template <class Epi, class Sched, bool ALIGN_EPI = true, bool SP2 = true>
__device__ __forceinline__ void gemm_phase(PG8_LAS unsigned char* lds, const int K, const Sched& S, const Epi& E) {
    const int tid = threadIdx.x, wid = __builtin_amdgcn_readfirstlane(tid >> 6), lane = tid & 63, wr = wid >> 2, wc = wid & 3, fr = lane & 15, fq = lane >> 4;
    const int nt = K / BK;
    unsigned voffA[2], voffB[2];
#pragma unroll
    for (int i = 0; i < 2; ++i) { int R, C; stage_rc(tid * 16 + i * 8192, R, C); const int Rb = Epi::PERM ? ((R & ~31) + perm32(R & 31)) : R;
        voffA[i] = (unsigned)(R * K + C) * 2u; voffB[i] = (unsigned)(Rb * K + C) * 2u; }
    const size_t kstep = (size_t)(BK * 2);
    const size_t hstep = (size_t)HALF * K * 2;
    const unsigned ldsw = (unsigned)wid * 1024u;
    const int aoff = lds_byte(wr * 64 + fr, fq * 8), boff = lds_byte(wc * 32 + fr, fq * 8);
#define PG8_SA(b, h) (((b) * 2 + (h)) * HTB)
#define PG8_SB(b, h) ((4 + (b) * 2 + (h)) * HTB)
#define PG8_STAGE(bufoff, gbase, voff) do { _Pragma("unroll") for (int _i = 0; _i < 2; ++_i) \
        __builtin_amdgcn_global_load_lds((const unsigned*)((const char*)(gbase) + (voff)[_i]), (PG8_LAS unsigned*)(lds + (bufoff) + ldsw + _i * 8192), 16, 0, 0); } while (0)
#define PG8_LDA(dst, b, h) do { _Pragma("unroll") for (int m = 0; m < 4; ++m) _Pragma("unroll") for (int k = 0; k < 2; ++k) dst[m][k] = *(const PG8_LAS bf16x8*)(lds + PG8_SA(b, h) + aoff + m * 2048 + k * 1024); } while (0)
#define PG8_LDB(dst, b, h) do { _Pragma("unroll") for (int n = 0; n < 2; ++n) _Pragma("unroll") for (int k = 0; k < 2; ++k) dst[n][k] = *(const PG8_LAS bf16x8*)(lds + PG8_SB(b, h) + boff + n * 2048 + k * 1024); } while (0)
#define PG8_MMA(ai, bj, At, Bt) do { __builtin_amdgcn_s_setprio(1); _Pragma("unroll") for (int m = 0; m < 4; ++m) _Pragma("unroll") for (int n = 0; n < 2; ++n) _Pragma("unroll") for (int k = 0; k < 2; ++k) \
        acc[ai][bj][m][n] = __builtin_amdgcn_mfma_f32_16x16x32_bf16(Bt[n][k], At[m][k], acc[ai][bj][m][n], 0, 0, 0); __builtin_amdgcn_s_setprio(0); } while (0)
#define PG8_WAIT_V(n) asm volatile("s_waitcnt vmcnt(" #n ")" ::: "memory")
#define PG8_WAIT_L(n) asm volatile("s_waitcnt lgkmcnt(" #n ")" ::: "memory")
#define PG8_BAR __builtin_amdgcn_s_barrier()
#define PG8_SCHED __builtin_amdgcn_sched_barrier(0)
    Unit cur, nxt; int ui = 0;
    if (!S.next(0, cur)) return;
    f32x4 acc[2][2][4][2];
#pragma unroll
    for (int a = 0; a < 2; ++a)
#pragma unroll
        for (int b = 0; b < 2; ++b)
#pragma unroll
            for (int m = 0; m < 4; ++m)
#pragma unroll
                for (int n = 0; n < 2; ++n) acc[a][b][m][n] = (f32x4){0.f, 0.f, 0.f, 0.f};
    bf16x8 At[4][2], B0[2][2], B1[2][2];
    const char* cA = cur.A; const char* cB = cur.B;
    if constexpr (SP2) {
        PG8_STAGE(PG8_SB(0, 0), cB, voffB); PG8_STAGE(PG8_SB(0, 1), cB + hstep, voffB); PG8_STAGE(PG8_SA(0, 0), cA, voffA); PG8_STAGE(PG8_SA(0, 1), cA + hstep, voffA);
        if (wr == 1) PG8_BAR;
        PG8_WAIT_V(2); PG8_BAR;
        PG8_STAGE(PG8_SB(1, 0), cB + kstep, voffB); PG8_STAGE(PG8_SA(1, 0), cA + kstep, voffA); PG8_STAGE(PG8_SB(1, 1), cB + hstep + kstep, voffB);
        PG8_WAIT_V(6); PG8_BAR;
    } else {
        PG8_STAGE(PG8_SB(0, 0), cB, voffB); PG8_STAGE(PG8_SA(0, 0), cA, voffA); PG8_STAGE(PG8_SB(0, 1), cB + hstep, voffB); PG8_STAGE(PG8_SA(0, 1), cA + hstep, voffA);
        if (wr == 1) PG8_BAR;
        PG8_WAIT_V(4); PG8_BAR;
        PG8_STAGE(PG8_SB(1, 0), cB + kstep, voffB); PG8_STAGE(PG8_SA(1, 0), cA + kstep, voffA); PG8_STAGE(PG8_SB(1, 1), cB + hstep + kstep, voffB);
        PG8_WAIT_V(6); PG8_BAR;
    }
    for (;;) {
        const bool has_next = S.next(ui + 1, nxt);
        const char* nA = has_next ? nxt.A : cA; const char* nB = has_next ? nxt.B : cB;
        for (int t = 0; t < nt; t += 2) {
            const bool last = (t == nt - 2);
            const char* a1 = cA + (size_t)(t + 1) * kstep;
            const char* a2 = last ? nA : cA + (size_t)(t + 2) * kstep; const char* b2 = last ? nB : cB + (size_t)(t + 2) * kstep;
            const char* a3 = a2 + kstep; const char* b3 = b2 + kstep;
            if constexpr (SP2) {
            PG8_LDB(B0, 0, 0); PG8_LDB(B1, 0, 1); PG8_SCHED; PG8_LDA(At, 0, 0); PG8_STAGE(PG8_SA(1, 1), a1 + hstep, voffA);
            PG8_WAIT_V(8); PG8_WAIT_L(0); PG8_BAR; PG8_MMA(0, 0, At, B0); PG8_MMA(0, 1, At, B1); PG8_BAR; PG8_SCHED;
            PG8_LDA(At, 0, 1); PG8_STAGE(PG8_SB(0, 0), b2, voffB); PG8_STAGE(PG8_SB(0, 1), b2 + hstep, voffB); PG8_STAGE(PG8_SA(0, 0), a2, voffA);
            PG8_WAIT_V(8); PG8_WAIT_L(0); PG8_BAR; PG8_MMA(1, 0, At, B0); PG8_MMA(1, 1, At, B1); PG8_BAR; PG8_SCHED;
            PG8_LDB(B0, 1, 0); PG8_LDB(B1, 1, 1); PG8_SCHED; PG8_LDA(At, 1, 0); PG8_STAGE(PG8_SA(0, 1), a2 + hstep, voffA);
            PG8_WAIT_V(8); PG8_WAIT_L(0); PG8_BAR; PG8_MMA(0, 0, At, B0); PG8_MMA(0, 1, At, B1); PG8_BAR; PG8_SCHED;
            PG8_LDA(At, 1, 1); PG8_STAGE(PG8_SB(1, 0), b3, voffB); PG8_STAGE(PG8_SB(1, 1), b3 + hstep, voffB); PG8_STAGE(PG8_SA(1, 0), a3, voffA);
            PG8_WAIT_V(8); PG8_WAIT_L(0); PG8_BAR; PG8_MMA(1, 0, At, B0); PG8_MMA(1, 1, At, B1); PG8_BAR; PG8_SCHED;
            } else {
            PG8_LDB(B0, 0, 0); PG8_SCHED; PG8_LDA(At, 0, 0); PG8_STAGE(PG8_SA(1, 1), a1 + hstep, voffA);
            PG8_WAIT_L(8); PG8_BAR; PG8_WAIT_L(0); PG8_MMA(0, 0, At, B0); PG8_BAR; PG8_SCHED;
            PG8_LDB(B1, 0, 1); PG8_STAGE(PG8_SB(0, 0), b2, voffB);
            PG8_BAR; PG8_WAIT_L(0); PG8_MMA(0, 1, At, B1); PG8_BAR;
            PG8_LDA(At, 0, 1); PG8_STAGE(PG8_SA(0, 0), a2, voffA);
            PG8_BAR; PG8_WAIT_L(0); PG8_MMA(1, 0, At, B0); PG8_BAR; PG8_SCHED;
            PG8_STAGE(PG8_SB(0, 1), b2 + hstep, voffB);
            PG8_WAIT_V(6); PG8_BAR; PG8_MMA(1, 1, At, B1); PG8_BAR;
            PG8_LDB(B0, 1, 0); PG8_SCHED; PG8_LDA(At, 1, 0); PG8_STAGE(PG8_SA(0, 1), a2 + hstep, voffA);
            PG8_WAIT_L(8); PG8_BAR; PG8_WAIT_L(0); PG8_MMA(0, 0, At, B0); PG8_BAR; PG8_SCHED;
            PG8_LDB(B1, 1, 1); PG8_STAGE(PG8_SB(1, 0), b3, voffB);
            PG8_BAR; PG8_WAIT_L(0); PG8_MMA(0, 1, At, B1); PG8_BAR;
            PG8_LDA(At, 1, 1); PG8_STAGE(PG8_SA(1, 0), a3, voffA);
            PG8_BAR; PG8_WAIT_L(0); PG8_MMA(1, 0, At, B0); PG8_BAR; PG8_SCHED;
            PG8_STAGE(PG8_SB(1, 1), b3 + hstep, voffB);
            PG8_WAIT_V(6); PG8_BAR; PG8_MMA(1, 1, At, B1); PG8_BAR;
            }
        }
        if constexpr (ALIGN_EPI) { if (wr == 0) PG8_BAR; }
        E(acc, cur, wr, wc, fr, fq);
        if (!has_next) break;
#pragma unroll
        for (int a = 0; a < 2; ++a)
#pragma unroll
            for (int b = 0; b < 2; ++b)
#pragma unroll
                for (int m = 0; m < 4; ++m)
#pragma unroll
                    for (int n = 0; n < 2; ++n) acc[a][b][m][n] = (f32x4){0.f, 0.f, 0.f, 0.f};
        cur = nxt; cA = nA; cB = nB; ++ui;
        if constexpr (ALIGN_EPI) { if (wr == 1) PG8_BAR; }
    }
    PG8_WAIT_V(0);
    if constexpr (!ALIGN_EPI) { if (wr == 0) PG8_BAR; }
    PG8_BAR;
#undef PG8_SA
#undef PG8_SB
#undef PG8_STAGE
#undef PG8_LDA
#undef PG8_LDB
#undef PG8_MMA
#undef PG8_WAIT_V
#undef PG8_WAIT_L
#undef PG8_BAR
#undef PG8_SCHED
}
}

constexpr int NWAVES = 8;
constexpr int DM = 1024, NB = 2, SEQ = 8192, MTOK = NB * SEQ;
constexpr int CTXL = 256, MCTX = NB * CTXL, MALL = MTOK + MCTX;
constexpr int NMODV = 6 * DM;
constexpr int CONVC = 512, CONVW = 31, NHEADS = 8, HD = 64, ATTW = 512;
constexpr int NINC = 2560;
constexpr int NEXP = 16, DEXP = 2048, CAP = 1024, MX = NB * NEXP * CAP;
constexpr int GROWS = SEQ / 64;
constexpr float EPS = 1e-6f;
constexpr float LOG2E = 1.4426950408889634f;

constexpr size_t MiB = 1u << 20;
constexpr size_t WS_CTL = 0, CTL_ZERO_BYTES = 1 * MiB;
constexpr size_t WS_MOD = 1 * MiB;
constexpr size_t WS_AFF = 2 * MiB;
constexpr size_t WS_INV = 3 * MiB;
constexpr size_t WS_TOK = 4 * MiB;
constexpr size_t WS_WT = 4 * MiB + 128 * 1024;
constexpr size_t WS_WIN = 5 * MiB;
constexpr size_t WS_WOUT = 10 * MiB;
constexpr size_t WS_WGU = 12 * MiB;
constexpr size_t WS_WD = 140 * MiB;
constexpr size_t WS_X1 = 204 * MiB;
constexpr size_t WS_XS = 268 * MiB;
constexpr size_t WS_YS = WS_XS;
constexpr size_t WS_H = 332 * MiB;
constexpr size_t WS_U = 365 * MiB;
constexpr size_t WS_Q = 381 * MiB;
constexpr size_t WS_K = 397 * MiB;
constexpr size_t WS_VT = WS_K + 16 * MiB + 512 * 1024;
constexpr size_t WS_MIX = 430 * MiB;
constexpr size_t WS_HID = 332 * MiB;
constexpr size_t WS_H2 = 462 * MiB;
constexpr size_t WS_END = 494 * MiB;
static_assert(WS_VT + (size_t)512 * MALL * 2 <= WS_MIX && WS_HID + (size_t)MX * DEXP * 2 <= WS_H2, "ws map");

constexpr int CW_TMO = 0, CW_CODE = 1;
constexpr int CW_BAR = 4096;

constexpr int RING_OFF = 0, RING_BYTES = 131072;
constexpr int LDSCTL_OFF = RING_BYTES, MISC_OFF = LDSCTL_OFF + 320;
constexpr int LDS_BYTES = 163840;
static_assert(MISC_OFF + 128 + 8 * 15 * 32 * 4 <= LDS_BYTES, "LDS map");

#define GAS __attribute__((address_space(1)))
#define LAS __attribute__((address_space(3)))
typedef unsigned short bf16;
typedef unsigned v4u __attribute__((ext_vector_type(4)));
typedef unsigned v2u __attribute__((ext_vector_type(2)));
typedef float f32x4 __attribute__((ext_vector_type(4)));
typedef float f32x16 __attribute__((ext_vector_type(16)));
typedef short bf16x8 __attribute__((ext_vector_type(8)));
typedef GAS unsigned gu32;
#define RLX_AGENT __ATOMIC_RELAXED, __HIP_MEMORY_SCOPE_AGENT
#define LDS_WAIT() asm volatile("s_waitcnt lgkmcnt(0)" ::: "memory")
#define VM_WAIT() asm volatile("s_waitcnt vmcnt(0)" ::: "memory")
__device__ __forceinline__ unsigned f2bf(float f) { unsigned u = __builtin_bit_cast(unsigned, f); return (u + 0x7fffu + ((u >> 16) & 1u)) >> 16; }
__device__ __forceinline__ unsigned pk2(float lo, float hi) { return f2bf(lo) | (f2bf(hi) << 16); }
__device__ __forceinline__ float bf_lo(unsigned w) { return __builtin_bit_cast(float, w << 16); }
__device__ __forceinline__ float bf_hi(unsigned w) { return __builtin_bit_cast(float, w & 0xffff0000u); }
__device__ __forceinline__ float fast_sigmoid(float x) { return __builtin_amdgcn_rcpf(1.0f + __builtin_amdgcn_exp2f(-x * LOG2E)); }

#define XB_TMO      128
#define XB_XCNT(j)  (256  + 64 * (j))
#define XB_XSUB(j)  (1280 + 64 * (j))
#define XB_XGEN(j)  (2304 + 64 * (j))
#define XB_TOP      3328
#define XB_TOPGEN   3392
#define XCD_BAR_WORDS 3456
#define XB_SPIN_CAP (1u << 18)
__device__ __forceinline__ unsigned xb_ld(unsigned* p)              { return __hip_atomic_load(p, __ATOMIC_RELAXED, __HIP_MEMORY_SCOPE_AGENT); }
__device__ __forceinline__ unsigned xb_add(unsigned* p, unsigned v) { return __hip_atomic_fetch_add(p, v, __ATOMIC_RELAXED, __HIP_MEMORY_SCOPE_AGENT); }
__device__ __forceinline__ unsigned xb_xcc_id() { return (unsigned)__builtin_amdgcn_s_getreg((3 << 11) | 20) & 0xFu; }
#define XB_SPIN(cond, bar) do { unsigned _sp = 0; while (cond) { __builtin_amdgcn_s_sleep(1); \
    if ((++_sp & 255u) == 0u) { if (xb_ld(&(bar)[XB_TMO])) break; if (_sp > XB_SPIN_CAP) { atomicAdd(&(bar)[XB_TMO], 1u); break; } } } } while (0)
struct XcdBarrier { unsigned* bar; unsigned x; volatile LAS unsigned* st; };
__device__ __forceinline__ XcdBarrier xcd_barrier_post(unsigned* bar, volatile LAS unsigned* st) {
    XcdBarrier b; b.bar = bar; b.x = xb_xcc_id(); b.st = st;
    if (threadIdx.x == 0) (void)xb_add(&bar[XB_XCNT(b.x)], 1u);
    return b;
}
__device__ __forceinline__ void xcd_barrier_complete(unsigned* bar, unsigned x, unsigned& nloc, unsigned& nx) {
    const unsigned G = gridDim.x * gridDim.y * gridDim.z;
    unsigned sum, cnt, mine, sp = 0u;
    for (;;) {
        sum = 0u; cnt = 0u; mine = 0u;
#pragma unroll
        for (unsigned j = 0; j < 16; ++j) { const unsigned c = xb_ld(&bar[XB_XCNT(j)]); sum += c; cnt += (c > 0u) ? 1u : 0u; mine = (j == x) ? c : mine; }
        if (sum == G) break;
        __builtin_amdgcn_s_sleep(1);
        if ((++sp & 255u) == 0u) { if (xb_ld(&bar[XB_TMO])) break; if (sp > XB_SPIN_CAP) { atomicAdd(&bar[XB_TMO], 1u); break; } }
    }
    nloc = mine > 0u ? mine : 1u; nx = cnt > 0u ? cnt : 1u;
}
__device__ __forceinline__ void xcd_barrier(const XcdBarrier& b) {
    asm volatile("s_waitcnt vmcnt(0)" ::: "memory");
    __syncthreads();
    if (threadIdx.x == 0) {
        unsigned* bar = b.bar;
        __builtin_amdgcn_s_waitcnt(0);
        unsigned nloc = b.st[0], nx = b.st[1];
        if (nloc == 0u) { xcd_barrier_complete(bar, b.x, nloc, nx); b.st[0] = nloc; b.st[1] = nx; }
        const unsigned old = xb_add(&bar[XB_XSUB(b.x)], 1u);
        const unsigned gen = old / nloc;
        if (old + 1u == (gen + 1u) * nloc) {
            __builtin_amdgcn_fence(__ATOMIC_RELEASE, "agent");
            asm volatile("s_waitcnt vmcnt(0)" ::: "memory");
            const unsigned og = xb_add(&bar[XB_TOP], 1u);
            const unsigned tg = og / nx;
            if (og + 1u == (tg + 1u) * nx) xb_add(&bar[XB_TOPGEN], 1u);
            else XB_SPIN(xb_ld(&bar[XB_TOPGEN]) == tg, bar);
            __builtin_amdgcn_fence(__ATOMIC_ACQUIRE, "agent");
            xb_add(&bar[XB_XGEN(b.x)], 1u);
            asm volatile("s_waitcnt vmcnt(0)" ::: "memory");
        } else {
            XB_SPIN(xb_ld(&bar[XB_XGEN(b.x)]) == gen, bar);
            __builtin_amdgcn_fence(__ATOMIC_ACQUIRE, "agent");
            asm volatile("s_waitcnt vmcnt(0)" ::: "memory");
        }
    }
    __syncthreads();
}

struct Args { const float* in[20]; float* out; unsigned char* ws; int ph_lo, ph_hi; };
struct Frame {
    LAS unsigned char* lds;
    volatile LAS unsigned* MISC;
    int tid, lane, wave;
    int vcu, G;
    const Args* a;
};
#define FIN(name, idx) (F.a->in[idx])
#define F_x FIN(x, 0)
#define F_c FIN(c, 1)
#define F_ctx FIN(ctx, 2)
#define F_c_ctx FIN(c_ctx, 3)
#define F_w_mod FIN(w_mod, 4)
#define F_b_mod FIN(b_mod, 5)
#define F_norm_mix_g FIN(norm_mix_g, 6)
#define F_w_in FIN(w_in, 7)
#define F_conv_w FIN(conv_w, 8)
#define F_conv_b FIN(conv_b, 9)
#define F_conv_ln_g FIN(conv_ln_g, 10)
#define F_conv_ln_b FIN(conv_ln_b, 11)
#define F_rpb FIN(rpb, 12)
#define F_w_out FIN(w_out, 13)
#define F_norm_ffn_g FIN(norm_ffn_g, 14)
#define F_w_router FIN(w_router, 15)
#define F_w_gate FIN(w_gate, 16)
#define F_w_up FIN(w_up, 17)
#define F_w_down FIN(w_down, 18)
#define F_norm_final_g FIN(norm_final_g, 19)
#define F_out (F.a->out)
#define WSP(T, off) ((T*)(F.a->ws + (off)))
#define F_MOD WSP(float, WS_MOD)
#define F_AFF WSP(float, WS_AFF)
#define F_INV WSP(int, WS_INV)
#define F_TOK WSP(int, WS_TOK)
#define F_WTS WSP(float, WS_WT)
#define F_X1 WSP(float, WS_X1)
#define F_WIN WSP(bf16, WS_WIN)
#define F_WOUT WSP(bf16, WS_WOUT)
#define F_WGU WSP(bf16, WS_WGU)
#define F_WD WSP(bf16, WS_WD)
#define F_XS WSP(bf16, WS_XS)
#define F_YS WSP(bf16, WS_YS)
#define F_H WSP(bf16, WS_H)
#define F_U WSP(bf16, WS_U)
#define F_Q WSP(bf16, WS_Q)
#define F_K WSP(bf16, WS_K)
#define F_VT WSP(bf16, WS_VT)
#define F_MIX WSP(bf16, WS_MIX)
#define F_HID WSP(bf16, WS_HID)
#define F_H2 WSP(bf16, WS_H2)

__device__ __forceinline__ float wave_sum(float v) {
#pragma unroll
    for (int o = 1; o < 64; o <<= 1) v += __shfl_xor(v, o);
    return v;
}
__device__ __forceinline__ float wave_max(float v) {
#pragma unroll
    for (int o = 1; o < 64; o <<= 1) v = fmaxf(v, __shfl_xor(v, o));
    return v;
}

__device__ __forceinline__ void transpose_item(const float* W, int N, int k0, int n0, bf16* WT, int Kdst, int drow0, LAS float* scr, int lane) {
#pragma unroll 8
    for (int i = 0; i < 32; ++i) { const int kk = 2 * i + (lane >> 5); scr[kk * 33 + (lane & 31)] = W[(size_t)(k0 + kk) * N + n0 + (lane & 31)]; }
    LDS_WAIT(); asm volatile("" ::: "memory");
    const int c = lane & 7;
#pragma unroll
    for (int j = 0; j < 4; ++j) { const int n = (lane >> 3) + 8 * j; const LAS float* s = scr + (8 * c) * 33 + n;
        v4u o; o.x = pk2(s[0 * 33], s[1 * 33]); o.y = pk2(s[2 * 33], s[3 * 33]); o.z = pk2(s[4 * 33], s[5 * 33]); o.w = pk2(s[6 * 33], s[7 * 33]);
        *(GAS v4u*)(WT + (size_t)(drow0 + n) * Kdst + k0 + 8 * c) = o; }
    LDS_WAIT(); asm volatile("" ::: "memory");
}

__device__ __forceinline__ void p0_prologue(Frame& F) {
    {
        LAS float* sl = (LAS float*)(F.lds + RING_OFF);
        LAS float* part = sl + 3 * DM;
        for (int i = F.tid; i < 3 * DM; i += NWAVES * 64) { const int r = i >> 10, k = i & 1023; const float cv = (r < 2) ? F_c[r * DM + k] : F_c_ctx[k]; sl[i] = cv * fast_sigmoid(cv); }
        __syncthreads();
        for (int it = F.vcu; it < NMODV / 64; it += F.G) {
            const int n = it * 64 + F.lane; float a0 = 0.f, a1 = 0.f, a2 = 0.f;
            const int kb = F.wave * 128;
#pragma unroll 8
            for (int k = 0; k < 128; ++k) { const float w = F_w_mod[(size_t)(kb + k) * NMODV + n]; a0 += sl[kb + k] * w; a1 += sl[DM + kb + k] * w; a2 += sl[2 * DM + kb + k] * w; }
            part[(F.wave * 3 + 0) * 64 + F.lane] = a0; part[(F.wave * 3 + 1) * 64 + F.lane] = a1; part[(F.wave * 3 + 2) * 64 + F.lane] = a2;
            __syncthreads();
            if (F.wave < 3) { float s = F_b_mod[n];
#pragma unroll
                for (int w = 0; w < 8; ++w) s += part[(w * 3 + F.wave) * 64 + F.lane];
                F_MOD[F.wave * NMODV + n] = s; }
            __syncthreads();
        }
        __syncthreads();
    }
    LAS float* scr = (LAS float*)(F.lds + RING_OFF + F.wave * 16384);
    const int gw = F.vcu * NWAVES + F.wave, NGW = F.G * NWAVES;
    constexpr int I_IN = (DM / 64) * (NINC / 32);
    constexpr int I_OUT = (DM / 64) * (DM / 32);
    constexpr int I_G = (DM / 64) * (DEXP / 32);
    constexpr int I_D = (DEXP / 64) * (DM / 32);
    constexpr int NITEMS = I_IN + I_OUT + NEXP * (2 * I_G + I_D);
    for (int it = gw; it < NITEMS; it += NGW) {
        int r = it;
        if (r < I_IN) { const int nblk = NINC / 32, kb = r / nblk, nb = r % nblk, n0 = nb * 32;
            int drow = n0;
            if (n0 < 1024) { const int half = n0 >> 9, rem = n0 & 511; drow = 256 * (rem >> 7) + 128 * half + (rem & 127); }
            transpose_item(F_w_in, NINC, kb * 64, n0, F_WIN, DM, drow, scr, F.lane); continue; }
        r -= I_IN;
        if (r < I_OUT) { const int nblk = DM / 32, kb = r / nblk, nb = r % nblk; transpose_item(F_w_out, DM, kb * 64, nb * 32, F_WOUT, DM, nb * 32, scr, F.lane); continue; }
        r -= I_OUT;
        const int e = r / (2 * I_G + I_D); r -= e * (2 * I_G + I_D);
        if (r < 2 * I_G) { const int half = r / I_G; r -= half * I_G; const int nblk = DEXP / 32, kb = r / nblk, nb = r % nblk, n0 = nb * 32;
            const int drow = 256 * (n0 >> 7) + 128 * half + (n0 & 127);
            transpose_item((half ? F_w_up : F_w_gate) + (size_t)e * DM * DEXP, DEXP, kb * 64, n0, F_WGU + (size_t)e * 2 * DEXP * DM, DM, drow, scr, F.lane); continue; }
        r -= 2 * I_G;
        { const int nblk = DM / 32, kb = r / nblk, nb = r % nblk; transpose_item(F_w_down + (size_t)e * DEXP * DM, DM, kb * 64, nb * 32, F_WD + (size_t)e * DM * DEXP, DEXP, nb * 32, scr, F.lane); }
    }
}

__device__ __forceinline__ void p1_hpass(Frame& F) {
    const int gw = F.vcu * NWAVES + F.wave, NGW = F.G * NWAVES;
    for (int m = gw; m < MALL; m += NGW) {
        const float* xr = (m < MTOK) ? F_x + (size_t)m * DM : F_ctx + (size_t)(m - MTOK) * DM;
        const float* mod = F_MOD + (size_t)((m < MTOK) ? (m >> 13) : 2) * NMODV;
        f32x4 v[4]; float ss = 0.f;
#pragma unroll
        for (int j = 0; j < 4; ++j) { v[j] = *(const GAS f32x4*)(xr + 4 * F.lane + 256 * j); ss += (v[j].x * v[j].x + v[j].y * v[j].y) + (v[j].z * v[j].z + v[j].w * v[j].w); }
        const float rstd = 1.0f / sqrtf(wave_sum(ss) * (1.0f / DM) + EPS);
        GAS v2u* o = (GAS v2u*)(F_H + (size_t)m * DM);
#pragma unroll
        for (int j = 0; j < 4; ++j) { const int col = 4 * F.lane + 256 * j;
            const f32x4 g = *(const GAS f32x4*)(F_norm_mix_g + col), sh = *(const GAS f32x4*)(mod + col), sc = *(const GAS f32x4*)(mod + DM + col);
            const f32x4 h = v[j] * rstd * g * (1.0f + sc) + sh;
            v2u w; w.x = pk2(h.x, h.y); w.y = pk2(h.z, h.w); o[F.lane + 64 * j] = w; }
    }
}

struct InProjOrder {
    int vcu, G; const char *H, *WIN;
    __device__ __forceinline__ bool next(int i, pg8::Unit& u) const {
        const size_t tstep = (size_t)256 * DM * 2;
        int pm, pn, kind;
        if (G == 256) {
            const int x = vcu >> 5, s = vcu & 31;
            if (i < 2) { pm = 32 * i + 4 * x + (s & 3); pn = s >> 2; kind = pn < 4 ? 0 : (pn < 6 ? 1 : 2); }
            else if (i == 2) {
                if (s < 16) { kind = 3; pm = s & 1; pn = 8 * x + (s >> 1); }
                else if (s == 16) { if (x < 4) { kind = 3; pm = x & 1; pn = 64 + (x >> 1); } else { kind = 2; pm = 64 + ((x - 4) >> 1); pn = 6 + ((x - 4) & 1); } }
                else return false;
            } else return false;
        } else {
            const int L = i * G + vcu;
            if (L < 512) { pm = L >> 3; pn = L & 7; kind = pn < 4 ? 0 : (pn < 6 ? 1 : 2); }
            else if (L < 516) { kind = 2; pm = 64 + ((L - 512) >> 1); pn = 6 + ((L - 512) & 1); }
            else if (L < 648) { kind = 3; pm = (L - 516) & 1; pn = (L - 516) >> 1; }
            else return false;
        }
        u.pm = pm; u.pn = pn; u.kind = kind;
        if (kind == 3) { u.A = WIN + (size_t)(8 + pm) * tstep; u.B = H + (size_t)pn * tstep; }
        else { u.A = H + (size_t)pm * tstep; u.B = WIN + (size_t)pn * tstep; }
        return true;
    }
};
struct EpiInProj {
    static constexpr bool PERM = true;
    bf16 *U, *Q, *Kb, *Vt; float qscale;
    __device__ __forceinline__ void operator()(const pg8::f32x4 (&acc)[2][2][4][2], const pg8::Unit& u, int wr, int wc, int fr, int fq) const {
        const int row0 = u.pm * 256 + wr * 64 + fr;
        if (u.kind == 0) {
            const int col0 = u.pn * 128 + wc * 32 + 8 * fq;
#pragma unroll
            for (int ai = 0; ai < 2; ++ai)
#pragma unroll
                for (int m = 0; m < 4; ++m) {
                    float v[8];
#pragma unroll
                    for (int n = 0; n < 2; ++n)
#pragma unroll
                        for (int i = 0; i < 4; ++i) v[4 * n + i] = acc[ai][0][m][n][i] * fast_sigmoid(acc[ai][1][m][n][i]);
                    v4u w; w.x = pg8::cvt_pk_bf16(v[0], v[1]); w.y = pg8::cvt_pk_bf16(v[2], v[3]); w.z = pg8::cvt_pk_bf16(v[4], v[5]); w.w = pg8::cvt_pk_bf16(v[6], v[7]);
                    *(v4u*)(U + (size_t)(row0 + ai * 128 + m * 16) * CONVC + col0) = w; }
        } else {
            bf16* base; int ldc, colt; float sc = 1.f;
            if (u.kind == 1) { base = Q; ldc = ATTW; colt = (u.pn - 4) * 256; sc = qscale; }
            else if (u.kind == 2) { base = Kb; ldc = ATTW; colt = (u.pn - 6) * 256; }
            else { base = Vt; ldc = MALL; colt = u.pn * 256; }
            const int col0 = colt + wc * 32 + 8 * fq;
#pragma unroll
            for (int ai = 0; ai < 2; ++ai)
#pragma unroll
                for (int m = 0; m < 4; ++m) { bf16* rowp = base + (size_t)(row0 + ai * 128 + m * 16) * ldc + col0;
#pragma unroll
                    for (int bj = 0; bj < 2; ++bj) { const pg8::f32x4 v0 = acc[ai][bj][m][0] * sc, v1 = acc[ai][bj][m][1] * sc;
                        v4u w; w.x = pg8::cvt_pk_bf16(v0[0], v0[1]); w.y = pg8::cvt_pk_bf16(v0[2], v0[3]); w.z = pg8::cvt_pk_bf16(v1[0], v1[1]); w.w = pg8::cvt_pk_bf16(v1[2], v1[3]);
                        *(v4u*)(rowp + bj * 128) = w; } }
        }
    }
};

constexpr int P3_Y_OFF = 0;
constexpr int P3_BIAS_OFF = MISC_OFF + 128;
constexpr float ATT_THR = 8.0f;

__device__ __forceinline__ void attn_wave(Frame& F, int b, int r) {
    const int lane = F.lane, head = F.wave, q32 = lane & 31, hh = lane >> 5;
    const LAS float* bt = (const LAS float*)(F.lds + P3_BIAS_OFF) + head * 15 * 32;
    const int tok0 = b * SEQ + r * 64;
    bf16x8 Bq[2][4];
#pragma unroll
    for (int qt = 0; qt < 2; ++qt)
#pragma unroll
        for (int ds = 0; ds < 4; ++ds) Bq[qt][ds] = *(const GAS bf16x8*)(F_Q + (size_t)(tok0 + 32 * qt + q32) * ATTW + head * HD + 16 * ds + 8 * hh);
    f32x16 O[2][2];
#pragma unroll
    for (int a = 0; a < 2; ++a)
#pragma unroll
        for (int c = 0; c < 2; ++c)
#pragma unroll
            for (int i = 0; i < 16; ++i) O[a][c][i] = 0.f;
    float mref[2] = {-1e30f, -1e30f}, lsum[2] = {0.f, 0.f};
    const int pi = (q32 & 0x13) | ((q32 & 4) << 1) | ((q32 & 8) >> 1);
    int r0 = r - 4; r0 = r0 < 0 ? 0 : (r0 > GROWS - 8 ? GROWS - 8 : r0);
    const bf16* Kh = F_K + head * HD + 8 * hh;
    const bf16* Vh = F_VT + (size_t)(head * HD + q32) * MALL + 8 * hh;
    for (int t = 0; t < 24; ++t) {
        int ktok0, drow = 0, half = 0; const bool local = t >= 8;
        if (!local) ktok0 = MTOK + b * CTXL + 32 * t;
        else { const int j = (t - 8) >> 1; half = (t - 8) & 1; const int kr = r0 + j; drow = kr - r + 7; ktok0 = b * SEQ + kr * 64 + 32 * half; }
        bf16x8 Ak[4], Av[2][2];
#pragma unroll
        for (int ds = 0; ds < 4; ++ds) Ak[ds] = *(const GAS bf16x8*)(Kh + (size_t)(ktok0 + pi) * ATTW + 16 * ds);
#pragma unroll
        for (int dt = 0; dt < 2; ++dt)
#pragma unroll
            for (int s = 0; s < 2; ++s) Av[dt][s] = *(const GAS bf16x8*)(Vh + (size_t)(32 * dt) * MALL + ktok0 + 16 * s);
        f32x16 S[2];
        if (local) {
#pragma unroll
            for (int qt = 0; qt < 2; ++qt) { const int qc = 32 * qt + q32; int c0 = qc - 8; c0 = c0 < 0 ? 0 : (c0 > 48 ? 48 : c0);
#pragma unroll
                for (int rr = 0; rr < 16; ++rr) { const int kc = 32 * half + 16 * (rr >> 3) + 8 * hh + (rr & 7); const bool valid = (kc >= c0) && (kc < c0 + 16);
                    int delta = kc - qc + 15; delta = valid ? delta : 0;
                    const float bv = bt[drow * 32 + delta]; S[qt][rr] = valid ? bv : -1e30f; } }
        } else {
#pragma unroll
            for (int qt = 0; qt < 2; ++qt)
#pragma unroll
                for (int rr = 0; rr < 16; ++rr) S[qt][rr] = 0.f;
        }
#pragma unroll
        for (int qt = 0; qt < 2; ++qt)
#pragma unroll
            for (int ds = 0; ds < 4; ++ds) S[qt] = __builtin_amdgcn_mfma_f32_32x32x16_bf16(Ak[ds], Bq[qt][ds], S[qt], 0, 0, 0);
#pragma unroll
        for (int qt = 0; qt < 2; ++qt) {
            float tm = S[qt][0];
#pragma unroll
            for (int rr = 1; rr < 16; ++rr) tm = fmaxf(tm, S[qt][rr]);
            tm = fmaxf(tm, __shfl_xor(tm, 32));
            if (__any(tm > mref[qt] + ATT_THR)) {
                const float mn = fmaxf(mref[qt], tm), sc = __builtin_amdgcn_exp2f(mref[qt] - mn);
                mref[qt] = mn; lsum[qt] *= sc;
#pragma unroll
                for (int i = 0; i < 16; ++i) { O[0][qt][i] *= sc; O[1][qt][i] *= sc; }
            }
            float p[16]; float ps = 0.f;
#pragma unroll
            for (int rr = 0; rr < 16; ++rr) { p[rr] = __builtin_amdgcn_exp2f(S[qt][rr] - mref[qt]); ps += p[rr]; }
            lsum[qt] += ps;
            bf16x8 Bp[2];
#pragma unroll
            for (int s = 0; s < 2; ++s) { v4u w; w.x = pg8::cvt_pk_bf16(p[8 * s + 0], p[8 * s + 1]); w.y = pg8::cvt_pk_bf16(p[8 * s + 2], p[8 * s + 3]); w.z = pg8::cvt_pk_bf16(p[8 * s + 4], p[8 * s + 5]); w.w = pg8::cvt_pk_bf16(p[8 * s + 6], p[8 * s + 7]);
                Bp[s] = __builtin_bit_cast(bf16x8, w); }
#pragma unroll
            for (int dt = 0; dt < 2; ++dt)
#pragma unroll
                for (int s = 0; s < 2; ++s) O[dt][qt] = __builtin_amdgcn_mfma_f32_32x32x16_bf16(Av[dt][s], Bp[s], O[dt][qt], 0, 0, 0);
        }
    }
#pragma unroll
    for (int qt = 0; qt < 2; ++qt) {
        const float lt = lsum[qt] + __shfl_xor(lsum[qt], 32), inv = 1.0f / lt;
        bf16* orow = F_MIX + (size_t)(tok0 + 32 * qt + q32) * DM + CONVC + head * HD + 4 * hh;
#pragma unroll
        for (int dt = 0; dt < 2; ++dt)
#pragma unroll
            for (int g4 = 0; g4 < 4; ++g4) { v2u w; w.x = pg8::cvt_pk_bf16(O[dt][qt][4 * g4 + 0] * inv, O[dt][qt][4 * g4 + 1] * inv); w.y = pg8::cvt_pk_bf16(O[dt][qt][4 * g4 + 2] * inv, O[dt][qt][4 * g4 + 3] * inv);
                *(GAS v2u*)(orow + 32 * dt + 8 * g4) = w; }
    }
}

typedef float f32x2 __attribute__((ext_vector_type(2)));
__device__ __forceinline__ void conv_unit(Frame& F, int b, int r) {
    const int lane = F.lane, w = F.wave;
    const int cp = F.tid & 255, th = F.tid >> 8;
    LAS float* yb = (LAS float*)(F.lds + P3_Y_OFF);
    const float *cw = F_conv_w, *cb = F_conv_b, *lg = F_conv_ln_g, *lb = F_conv_ln_b;
    asm volatile("" : "+s"(cw), "+s"(cb), "+s"(lg), "+s"(lb));
    {
        const int t0 = r * 64 + 32 * th - 15;
        f32x2 in[62];
        const bf16* up = F_U + (size_t)b * SEQ * CONVC + 2 * cp;
#pragma unroll
        for (int k = 0; k < 62; ++k) { const int tt = t0 + k; unsigned wv = 0u; if (tt >= 0 && tt < SEQ) wv = *(const GAS unsigned*)(up + (size_t)tt * CONVC); in[k] = (f32x2){bf_lo(wv), bf_hi(wv)}; }
        f32x2 wj[CONVW];
#pragma unroll
        for (int j = 0; j < CONVW; ++j) wj[j] = *(const GAS f32x2*)(cw + j * CONVC + 2 * cp);
        const f32x2 bias = *(const GAS f32x2*)(cb + 2 * cp);
#pragma unroll
        for (int t = 0; t < 32; ++t) { f32x2 a = bias;
#pragma unroll
            for (int j = 0; j < CONVW; ++j) a = wj[j] * in[t + j] + a;
            *(LAS f32x2*)(yb + (32 * th + t) * CONVC + 2 * cp) = a; }
    }
    __syncthreads();
    const f32x4 g0 = *(const GAS f32x4*)(lg + 8 * lane), g1 = *(const GAS f32x4*)(lg + 8 * lane + 4);
    const f32x4 b0 = *(const GAS f32x4*)(lb + 8 * lane), b1 = *(const GAS f32x4*)(lb + 8 * lane + 4);
#pragma unroll 2
    for (int k = 0; k < 8; ++k) { const int tk = 8 * w + k;
        f32x4 y0 = *(const LAS f32x4*)(yb + tk * CONVC + 8 * lane), y1 = *(const LAS f32x4*)(yb + tk * CONVC + 8 * lane + 4);
        const float s = wave_sum((y0.x + y0.y) + (y0.z + y0.w) + (y1.x + y1.y) + (y1.z + y1.w));
        const float mean = s * (1.0f / CONVC);
        y0 = y0 - mean; y1 = y1 - mean;
        const float q = wave_sum((y0.x * y0.x + y0.y * y0.y) + (y0.z * y0.z + y0.w * y0.w) + (y1.x * y1.x + y1.y * y1.y) + (y1.z * y1.z + y1.w * y1.w));
        const float rstd = 1.0f / sqrtf(q * (1.0f / CONVC) + EPS);
        y0 = y0 * rstd * g0 + b0; y1 = y1 * rstd * g1 + b1;
        v4u wv; wv.x = pk2(y0.x * fast_sigmoid(y0.x), y0.y * fast_sigmoid(y0.y)); wv.y = pk2(y0.z * fast_sigmoid(y0.z), y0.w * fast_sigmoid(y0.w));
        wv.z = pk2(y1.x * fast_sigmoid(y1.x), y1.y * fast_sigmoid(y1.y)); wv.w = pk2(y1.z * fast_sigmoid(y1.z), y1.w * fast_sigmoid(y1.w));
        *(GAS v4u*)(F_MIX + (size_t)(b * SEQ + r * 64 + tk) * DM + 8 * lane) = wv; }
    __syncthreads();
}

__device__ __forceinline__ void p3_mixers(Frame& F) {
    LAS float* bt = (LAS float*)(F.lds + P3_BIAS_OFF);
    for (int i = F.tid; i < NHEADS * 15 * 32; i += NWAVES * 64) { const int c = i & 31, hr = i >> 5; bt[i] = (c < 31) ? F_rpb[hr * 31 + c] * LOG2E : 0.f; }
    __syncthreads();
    for (int u = F.vcu; u < NB * GROWS; u += F.G) {
        const int b = u / GROWS, r = u % GROWS;
        attn_wave(F, b, r);
        asm volatile("" ::: "memory"); __builtin_amdgcn_sched_barrier(0); __syncthreads(); asm volatile("" ::: "memory");
        conv_unit(F, b, r);
    }
}

struct OutProjOrder {
    int vcu, G; const char *MIX, *WOUT;
    __device__ __forceinline__ bool next(int i, pg8::Unit& u) const {
        const size_t tstep = (size_t)256 * DM * 2;
        int pm, pn;
        if (G == 256) { if (i > 0) return false; const int x = vcu >> 5, s = vcu & 31; pm = 8 * x + (s & 7); pn = s >> 3; }
        else { const int L = i * G + vcu; if (L >= 256) return false; pm = L >> 2; pn = L & 3; }
        u.pm = pm; u.pn = pn; u.kind = 0; u.A = MIX + (size_t)pm * tstep; u.B = WOUT + (size_t)pn * tstep; return true;
    }
};
struct EpiOutProj {
    static constexpr bool PERM = false;
    const float* x; const float* MOD; float* X1;
    __device__ __forceinline__ void operator()(const pg8::f32x4 (&acc)[2][2][4][2], const pg8::Unit& u, int wr, int wc, int fr, int fq) const {
        const int row0 = u.pm * 256 + wr * 64 + fr, col0 = u.pn * 256 + wc * 32 + 4 * fq;
        const float* g1 = MOD + (size_t)(u.pm >> 5) * NMODV + 2 * DM;
        pg8::f32x4 gv[2][2];
#pragma unroll
        for (int bj = 0; bj < 2; ++bj)
#pragma unroll
            for (int n = 0; n < 2; ++n) gv[bj][n] = *(const pg8::f32x4*)(g1 + col0 + bj * 128 + n * 16);
#pragma unroll
        for (int ai = 0; ai < 2; ++ai)
#pragma unroll
            for (int m = 0; m < 4; ++m) { const size_t off = (size_t)(row0 + ai * 128 + m * 16) * DM + col0;
#pragma unroll
                for (int bj = 0; bj < 2; ++bj)
#pragma unroll
                    for (int n = 0; n < 2; ++n) { const pg8::f32x4 xv = *(const pg8::f32x4*)(x + off + bj * 128 + n * 16);
                        *(pg8::f32x4*)(X1 + off + bj * 128 + n * 16) = xv + gv[bj][n] * acc[ai][bj][m][n]; } }
    }
};

__device__ __forceinline__ void p5_router(Frame& F) {
    LAS f32x4* wl = (LAS f32x4*)(F.lds + RING_OFF);
    for (int idx = F.tid; idx < DM * 4; idx += NWAVES * 64) { const int c = idx >> 2, q = idx & 3; const f32x4 v = *(const GAS f32x4*)(F_w_router + c * NEXP + 4 * q);
        const int j = c >> 8, l = (c & 255) >> 2, i = c & 3; wl[((j * 4 + i) * 4 + q) * 64 + l] = v; }
    __syncthreads();
    const int gw = F.vcu * NWAVES + F.wave, NGW = F.G * NWAVES;
    for (int m = gw; m < MTOK; m += NGW) {
        const int b = m >> 13, t = m & (SEQ - 1);
        const float* mod = F_MOD + (size_t)b * NMODV;
        f32x4 v[4]; float ss = 0.f;
#pragma unroll
        for (int j = 0; j < 4; ++j) { v[j] = *(const GAS f32x4*)(F_X1 + (size_t)m * DM + 4 * F.lane + 256 * j); ss += (v[j].x * v[j].x + v[j].y * v[j].y) + (v[j].z * v[j].z + v[j].w * v[j].w); }
        const float rstd = 1.0f / sqrtf(wave_sum(ss) * (1.0f / DM) + EPS);
        GAS v2u* o = (GAS v2u*)(F_H2 + (size_t)m * DM);
        float lg[16];
#pragma unroll
        for (int e = 0; e < 16; ++e) lg[e] = 0.f;
#pragma unroll
        for (int j = 0; j < 4; ++j) { const int col = 4 * F.lane + 256 * j;
            const f32x4 g = *(const GAS f32x4*)(F_norm_ffn_g + col), sh = *(const GAS f32x4*)(mod + 3 * DM + col), sc = *(const GAS f32x4*)(mod + 4 * DM + col);
            const f32x4 h = v[j] * rstd * g * (1.0f + sc) + sh;
            v2u w; w.x = pk2(h.x, h.y); w.y = pk2(h.z, h.w); o[F.lane + 64 * j] = w;
#pragma unroll
            for (int i = 0; i < 4; ++i) {
#pragma unroll
                for (int q = 0; q < 4; ++q) { const f32x4 wv = wl[((j * 4 + i) * 4 + q) * 64 + F.lane];
                    lg[4 * q + 0] += h[i] * wv.x; lg[4 * q + 1] += h[i] * wv.y; lg[4 * q + 2] += h[i] * wv.z; lg[4 * q + 3] += h[i] * wv.w; }
                __builtin_amdgcn_sched_barrier(0); } }
        float mx = -1e30f;
#pragma unroll
        for (int e = 0; e < 16; ++e) { lg[e] = wave_sum(lg[e]); mx = fmaxf(mx, lg[e]); }
        float den = 0.f;
#pragma unroll
        for (int e = 0; e < 16; ++e) { lg[e] = __expf(lg[e] - mx); den += lg[e]; }
        float mine = 0.f;
#pragma unroll
        for (int e = 0; e < 16; ++e) mine = (F.lane == e) ? lg[e] : mine;
        if (F.lane < 16) F_AFF[(size_t)(b * NEXP + F.lane) * SEQ + t] = mine / den;
    }
}

__device__ __forceinline__ int block_excl_scan(int v, LAS int* sc, int tid, int lane, int wave, int& total) {
    int inc = v;
#pragma unroll
    for (int o = 1; o < 64; o <<= 1) { const int t = __shfl_up(inc, o); if (lane >= o) inc += t; }
    __syncthreads();
    if (lane == 63) sc[wave] = inc;
    __syncthreads();
    int base = 0, tot = 0;
#pragma unroll
    for (int w = 0; w < 8; ++w) { const int c = sc[w]; if (w < wave) base += c; tot += c; }
    total = tot;
    return base + inc - v;
}
__device__ __forceinline__ void p6_topk(Frame& F) {
    LAS int* hist = (LAS int*)(F.lds + RING_OFF);
    LAS int* sel = hist + 256;
    LAS int* sc = hist + 264;
    for (int be = blockIdx.x; be < NB * NEXP; be += F.G) {
        const int b = be >> 4, e = be & 15;
        const float* a = F_AFF + (size_t)be * SEQ + 16 * F.tid;
        unsigned v[16];
#pragma unroll
        for (int j = 0; j < 4; ++j) { const v4u q = *(const GAS v4u*)(a + 4 * j); v[4 * j] = q.x; v[4 * j + 1] = q.y; v[4 * j + 2] = q.z; v[4 * j + 3] = q.w; }
        unsigned prefix = 0u, mask = 0u; int kk = CAP;
#pragma unroll 1
        for (int pass = 0; pass < 4; ++pass) { const int shift = 24 - 8 * pass;
            __syncthreads();
            if (F.tid < 256) hist[F.tid] = 0;
            __syncthreads();
#pragma unroll
            for (int j = 0; j < 16; ++j) if ((v[j] & mask) == prefix) __hip_atomic_fetch_add(&hist[(v[j] >> shift) & 255u], 1, __ATOMIC_RELAXED, __HIP_MEMORY_SCOPE_WORKGROUP);
            __syncthreads();
            if (F.wave == 0) {
                int c[4]; int s4 = 0;
#pragma unroll
                for (int j = 0; j < 4; ++j) { c[j] = hist[4 * F.lane + j]; s4 += c[j]; }
                int suf = s4;
#pragma unroll
                for (int o = 1; o < 64; o <<= 1) { const int t = __shfl_down(suf, o); if (F.lane + o < 64) suf += t; }
                int above = suf - s4;
#pragma unroll
                for (int j = 3; j >= 0; --j) { if (above < kk && kk <= above + c[j]) { sel[0] = 4 * F.lane + j; sel[1] = kk - above; } above += c[j]; }
            }
            __syncthreads();
            prefix |= (unsigned)sel[0] << shift; mask |= 255u << shift; kk = sel[1];
        }
        const unsigned T = prefix; const int need_eq = kk;
        int ceq = 0;
#pragma unroll
        for (int j = 0; j < 16; ++j) ceq += (v[j] == T) ? 1 : 0;
        int tot; int eqb = block_excl_scan(ceq, sc, F.tid, F.lane, F.wave, tot);
        unsigned selm = 0u; int csel = 0;
#pragma unroll
        for (int j = 0; j < 16; ++j) { bool s = v[j] > T; if (v[j] == T) { s = eqb < need_eq; ++eqb; } if (s) { selm |= 1u << j; ++csel; } }
        int slot = block_excl_scan(csel, sc, F.tid, F.lane, F.wave, tot);
        const int obase = (e * 2 + b) * CAP;
        int iv[16];
#pragma unroll
        for (int j = 0; j < 16; ++j) { const bool s = (selm >> j) & 1u; iv[j] = s ? slot : -1;
            if (s) { F_TOK[obase + slot] = 16 * F.tid + j; F_WTS[obase + slot] = __builtin_bit_cast(float, v[j]); ++slot; } }
        int* ip = F_INV + (size_t)be * SEQ + 16 * F.tid;
#pragma unroll
        for (int j = 0; j < 4; ++j) *(GAS v4u*)(ip + 4 * j) = (v4u){(unsigned)iv[4 * j], (unsigned)iv[4 * j + 1], (unsigned)iv[4 * j + 2], (unsigned)iv[4 * j + 3]};
        __syncthreads();
    }
}

__device__ __forceinline__ void p6b_gather(Frame& F) {
    const int gw = F.vcu * NWAVES + F.wave, NGW = F.G * NWAVES;
    for (int R = gw; R < MX; R += NGW) {
        const int b = (R >> 10) & 1, t = F_TOK[R];
        const GAS v4u* s = (const GAS v4u*)(F_H2 + (size_t)(b * SEQ + t) * DM); GAS v4u* d = (GAS v4u*)(F_XS + (size_t)R * DM);
        const v4u a = s[F.lane], c = s[F.lane + 64]; d[F.lane] = a; d[F.lane + 64] = c;
    }
}

struct GateUpOrder {
    int vcu, G; const char *XS, *WGU;
    __device__ __forceinline__ bool next(int i, pg8::Unit& u) const {
        int e, pml, pn;
        if (G == 256) { if (i >= 8) return false; const int x = vcu >> 5, s = vcu & 31; e = 2 * x + (i >> 2); pml = s & 7; pn = 4 * (i & 3) + (s >> 3); }
        else { const int L = i * G + vcu; if (L >= 2048) return false; e = L >> 7; pml = L & 7; pn = (L >> 3) & 15; }
        u.pm = e * 8 + pml; u.pn = pn; u.kind = 0;
        u.A = XS + (size_t)u.pm * 256 * DM * 2; u.B = WGU + ((size_t)e * 2 * DEXP + (size_t)pn * 256) * DM * 2; return true;
    }
};
struct EpiSwiGLU {
    static constexpr bool PERM = true;
    bf16* HID;
    __device__ __forceinline__ void operator()(const pg8::f32x4 (&acc)[2][2][4][2], const pg8::Unit& u, int wr, int wc, int fr, int fq) const {
        const int row0 = u.pm * 256 + wr * 64 + fr, col0 = u.pn * 128 + wc * 32 + 8 * fq;
#pragma unroll
        for (int ai = 0; ai < 2; ++ai)
#pragma unroll
            for (int m = 0; m < 4; ++m) {
                float v[8];
#pragma unroll
                for (int n = 0; n < 2; ++n)
#pragma unroll
                    for (int i = 0; i < 4; ++i) { const float g = acc[ai][0][m][n][i]; v[4 * n + i] = g * fast_sigmoid(g) * acc[ai][1][m][n][i]; }
                v4u w; w.x = pg8::cvt_pk_bf16(v[0], v[1]); w.y = pg8::cvt_pk_bf16(v[2], v[3]); w.z = pg8::cvt_pk_bf16(v[4], v[5]); w.w = pg8::cvt_pk_bf16(v[6], v[7]);
                *(v4u*)(HID + (size_t)(row0 + ai * 128 + m * 16) * DEXP + col0) = w; }
    }
};
struct DownOrder {
    int vcu, G; const char *HID, *WD;
    __device__ __forceinline__ bool next(int i, pg8::Unit& u) const {
        int e, pml, pn;
        if (G == 256) { if (i >= 2) return false; const int x = vcu >> 5, s = vcu & 31; e = 2 * x + i; pml = s & 7; pn = s >> 3; }
        else { const int L = i * G + vcu; if (L >= 512) return false; e = L >> 5; pml = L & 7; pn = (L >> 3) & 3; }
        u.pm = e * 8 + pml; u.pn = pn; u.kind = 0;
        u.A = HID + (size_t)u.pm * 256 * DEXP * 2; u.B = WD + ((size_t)e * DM + (size_t)pn * 256) * DEXP * 2; return true;
    }
};
struct EpiDown {
    static constexpr bool PERM = true;
    bf16* YS; const float* WTS;
    __device__ __forceinline__ void operator()(const pg8::f32x4 (&acc)[2][2][4][2], const pg8::Unit& u, int wr, int wc, int fr, int fq) const {
        const int row0 = u.pm * 256 + wr * 64 + fr, col0 = u.pn * 256 + wc * 32 + 8 * fq;
#pragma unroll
        for (int ai = 0; ai < 2; ++ai)
#pragma unroll
            for (int m = 0; m < 4; ++m) { const int row = row0 + ai * 128 + m * 16; const float wt = WTS[row]; bf16* rowp = YS + (size_t)row * DM + col0;
#pragma unroll
                for (int bj = 0; bj < 2; ++bj) { const pg8::f32x4 v0 = acc[ai][bj][m][0] * wt, v1 = acc[ai][bj][m][1] * wt;
                    v4u w; w.x = pg8::cvt_pk_bf16(v0[0], v0[1]); w.y = pg8::cvt_pk_bf16(v0[2], v0[3]); w.z = pg8::cvt_pk_bf16(v1[0], v1[1]); w.w = pg8::cvt_pk_bf16(v1[2], v1[3]);
                    *(v4u*)(rowp + bj * 128) = w; } }
    }
};

__device__ __forceinline__ void p9_final(Frame& F) {
    const int gw = F.vcu * NWAVES + F.wave, NGW = F.G * NWAVES;
    for (int m = gw; m < MTOK; m += NGW) {
        const int b = m >> 13, t = m & (SEQ - 1);
        const float* mod = F_MOD + (size_t)b * NMODV;
        int slotv = -1;
        if (F.lane < 16) slotv = F_INV[(size_t)(b * NEXP + F.lane) * SEQ + t];
        f32x4 v[4], sum[4];
#pragma unroll
        for (int j = 0; j < 4; ++j) { v[j] = *(const GAS f32x4*)(F_X1 + (size_t)m * DM + 4 * F.lane + 256 * j); sum[j] = (f32x4){0.f, 0.f, 0.f, 0.f}; }
#pragma unroll
        for (int e = 0; e < 16; ++e) { const int sl = __builtin_amdgcn_readlane(slotv, e);
            if (sl >= 0) { const GAS v2u* yr = (const GAS v2u*)(F_YS + (size_t)((e * 2 + b) * CAP + sl) * DM);
#pragma unroll
                for (int j = 0; j < 4; ++j) { const v2u w = yr[F.lane + 64 * j]; sum[j].x += bf_lo(w.x); sum[j].y += bf_hi(w.x); sum[j].z += bf_lo(w.y); sum[j].w += bf_hi(w.y); } } }
        float ss = 0.f;
#pragma unroll
        for (int j = 0; j < 4; ++j) { const int col = 4 * F.lane + 256 * j; const f32x4 g2 = *(const GAS f32x4*)(mod + 5 * DM + col);
            v[j] = v[j] + g2 * sum[j]; ss += (v[j].x * v[j].x + v[j].y * v[j].y) + (v[j].z * v[j].z + v[j].w * v[j].w); }
        const float rstd = 1.0f / sqrtf(wave_sum(ss) * (1.0f / DM) + EPS);
#pragma unroll
        for (int j = 0; j < 4; ++j) { const int col = 4 * F.lane + 256 * j; const f32x4 g = *(const GAS f32x4*)(F_norm_final_g + col);
            *(GAS f32x4*)(F_out + (size_t)m * DM + col) = v[j] * rstd * g; }
    }
}

constexpr int N_PHASES = 10;
__global__ void __launch_bounds__(NWAVES * 64, 2) mk_fwd(Args args) {
    extern __shared__ __attribute__((aligned(16))) unsigned char lds[];
    Frame F;
    F.lds = (LAS unsigned char*)lds;
    F.MISC = (volatile LAS unsigned*)(F.lds + MISC_OFF);
    F.tid = threadIdx.x; F.lane = F.tid & 63; F.wave = __builtin_amdgcn_readfirstlane(F.tid >> 6);
    F.G = gridDim.x; { const int bx = blockIdx.x; F.vcu = (F.G % 8 == 0) ? (bx % 8) * (F.G / 8) + bx / 8 : bx; }
    F.a = &args;
    gu32* ctl = (gu32*)(args.ws + WS_CTL);
    for (int u = F.tid; u < (MISC_OFF + 128 - LDSCTL_OFF) / 4; u += NWAVES * 64) ((LAS unsigned*)(F.lds + LDSCTL_OFF))[u] = 0u;
    __syncthreads();
    const int lo = args.ph_lo, hi = args.ph_hi;
    const bool multi = (hi - lo) > 1;
    XcdBarrier bar; bar.bar = (unsigned*)(ctl + CW_BAR); bar.x = 0; bar.st = nullptr;
    if (multi) bar = xcd_barrier_post((unsigned*)(ctl + CW_BAR), F.MISC + 8);
#ifndef PH_MASK
#define PH_MASK 0xFFFF
#endif
#define IN(k) ((((PH_MASK) >> (k)) & 1) && lo <= (k) && (k) < hi)
#define SEAM(k) do { if (IN(k) && IN((k) + 1)) xcd_barrier(bar); } while (0)

    if (IN(0)) { p0_prologue(F); SEAM(0); }
    if (IN(1)) { p1_hpass(F); SEAM(1); }
    if (IN(2)) {
        InProjOrder S{F.vcu, F.G, (const char*)F_H, (const char*)F_WIN};
        EpiInProj E{F_U, F_Q, F_K, F_VT, 0.125f * LOG2E};
        pg8::gemm_phase<EpiInProj, InProjOrder>(F.lds + RING_OFF, DM, S, E);
        SEAM(2);
    }
    if (IN(3)) { p3_mixers(F); SEAM(3); }
    if (IN(4)) {
        OutProjOrder S{F.vcu, F.G, (const char*)F_MIX, (const char*)F_WOUT};
        EpiOutProj E{F_x, F_MOD, F_X1};
        pg8::gemm_phase<EpiOutProj, OutProjOrder>(F.lds + RING_OFF, DM, S, E);
        SEAM(4);
    }
    if (IN(5)) { p5_router(F); SEAM(5); }
    if (IN(6)) { p6_topk(F); SEAM(6); }
    if (IN(7)) { p6b_gather(F); SEAM(7); }
    if (IN(8)) {
        GateUpOrder S{F.vcu, F.G, (const char*)F_XS, (const char*)F_WGU};
        EpiSwiGLU E{F_HID};
        pg8::gemm_phase<EpiSwiGLU, GateUpOrder>(F.lds + RING_OFF, DM, S, E);
        SEAM(8);
    }
    if (IN(9)) {
        DownOrder S{F.vcu, F.G, (const char*)F_HID, (const char*)F_WD};
        EpiDown E{F_YS, F_WTS};
        pg8::gemm_phase<EpiDown, DownOrder>(F.lds + RING_OFF, DEXP, S, E);
        SEAM(9);
    }
    if (IN(10)) { p9_final(F); }
#undef IN
#undef SEAM
}

extern "C" void kernel_launch(void* const* d_in, const int* in_sizes, int n_in, void* d_out, int out_size, void* d_ws, size_t ws_size, hipStream_t stream) {
    static int grid = 0;
    if (grid == 0) {
        if (n_in != 20 || out_size != MTOK * DM || ws_size < WS_END) { fprintf(stderr, "kernel_launch: unexpected shapes (n_in %d out %d ws %zu)\n", n_in, out_size, ws_size); grid = -1; return; }
        int dev = 0, cus = 0, per_cu = 0;
        if (hipGetDevice(&dev) != hipSuccess || hipDeviceGetAttribute(&cus, hipDeviceAttributeMultiprocessorCount, dev) != hipSuccess) { grid = -1; return; }
        if (hipFuncSetAttribute((const void*)mk_fwd, hipFuncAttributeMaxDynamicSharedMemorySize, LDS_BYTES) != hipSuccess) { fprintf(stderr, "kernel_launch: hipFuncSetAttribute failed\n"); grid = -1; return; }
        if (hipOccupancyMaxActiveBlocksPerMultiprocessor(&per_cu, (const void*)mk_fwd, NWAVES * 64, LDS_BYTES) != hipSuccess || per_cu < 1) { fprintf(stderr, "kernel_launch: occupancy query says %d\n", per_cu); per_cu = 1; }
        (void)hipGetLastError();
        grid = cus;
    }
    if (grid < 0) return;
    (void)hipMemsetAsync((char*)d_ws + WS_CTL, 0, CTL_ZERO_BYTES, stream);
    Args a{};
    for (int i = 0; i < 20; ++i) a.in[i] = (const float*)d_in[i];
    a.out = (float*)d_out; a.ws = (unsigned char*)d_ws;
#if MK_ONE_LAUNCH
    a.ph_lo = 0; a.ph_hi = N_PHASES + 1;
    hipLaunchKernelGGL(mk_fwd, dim3(grid), dim3(NWAVES * 64), LDS_BYTES, stream, a);
#else
    for (int p = 0; p <= N_PHASES; ++p) { a.ph_lo = p; a.ph_hi = p + 1; hipLaunchKernelGGL(mk_fwd, dim3(grid), dim3(NWAVES * 64), LDS_BYTES, stream, a); }
#endif
}
```

```cpp
#include <hip/hip_runtime.h>
#include <cstdio>
#include <cstdint>

#ifndef MK_ONE_LAUNCH
#define MK_ONE_LAUNCH 1
#endif

namespace pg8 {
#define PG8_LAS __attribute__((address_space(3)))
typedef unsigned short bf16_t;
typedef short bf16x8 __attribute__((ext_vector_type(8)));
typedef float f32x4 __attribute__((ext_vector_type(4)));
typedef unsigned u32x4 __attribute__((ext_vector_type(4)));
constexpr int BM = 256, BK = 64, HALF = 128, HTB = HALF * BK * 2, STAGE_BYTES = 8 * HTB;

__host__ __device__ __forceinline__ int lds_byte(int r, int c) { const int st = (r >> 4) * 2 + (c >> 5), rr = r & 15, cc = c & 31, ob = rr * 64 + cc * 2; return st * 1024 + (ob ^ (((ob >> 9) & 1) << 5)); }
__host__ __device__ __forceinline__ void stage_rc(int b, int& R, int& C) { const int st = b / 1024, sb = b % 1024, swz = sb ^ (((sb >> 9) & 1) << 5); R = (st >> 1) * 16 + swz / 64; C = (st & 1) * 32 + (swz % 64) / 2; }
__host__ __device__ __forceinline__ int perm32(int rho) { const int n = rho >> 4, i = rho & 15; return 8 * (i >> 2) + 4 * n + (i & 3); }

struct Unit { int pm, pn, kind; const char* A; const char* B; };

__device__ __forceinline__ unsigned cvt_pk_bf16(float lo, float hi) { unsigned r; asm volatile("v_cvt_pk_bf16_f32 %0, %1, %2" : "=v"(r) : "v"(lo), "v"(hi)); return r; }

template <class Epi, class Sched, bool ALIGN_EPI = true, bool SP2 = true>
__device__ __forceinline__ void gemm_phase(PG8_LAS unsigned char* lds, const int K, const Sched& S, const Epi& E) {
    const int tid = threadIdx.x, wid = __builtin_amdgcn_readfirstlane(tid >> 6), lane = tid & 63, wr = wid >> 2, wc = wid & 3, fr = lane & 15, fq = lane >> 4;
    const int nt = K / BK;
    unsigned voffA[2], voffB[2];
#pragma unroll
    for (int i = 0; i < 2; ++i) { int R, C; stage_rc(tid * 16 + i * 8192, R, C); const int Rb = Epi::PERM ? ((R & ~31) + perm32(R & 31)) : R;
        voffA[i] = (unsigned)(R * K + C) * 2u; voffB[i] = (unsigned)(Rb * K + C) * 2u; }
    const size_t kstep = (size_t)(BK * 2);
    const size_t hstep = (size_t)HALF * K * 2;
    const unsigned ldsw = (unsigned)wid * 1024u;
    const int aoff = lds_byte(wr * 64 + fr, fq * 8), boff = lds_byte(wc * 32 + fr, fq * 8);
#define PG8_SA(b, h) (((b) * 2 + (h)) * HTB)
#define PG8_SB(b, h) ((4 + (b) * 2 + (h)) * HTB)
#define PG8_STAGE(bufoff, gbase, voff) do { _Pragma("unroll") for (int _i = 0; _i < 2; ++_i) \
        __builtin_amdgcn_global_load_lds((const unsigned*)((const char*)(gbase) + (voff)[_i]), (PG8_LAS unsigned*)(lds + (bufoff) + ldsw + _i * 8192), 16, 0, 0); } while (0)
#define PG8_LDA(dst, b, h) do { _Pragma("unroll") for (int m = 0; m < 4; ++m) _Pragma("unroll") for (int k = 0; k < 2; ++k) dst[m][k] = *(const PG8_LAS bf16x8*)(lds + PG8_SA(b, h) + aoff + m * 2048 + k * 1024); } while (0)
#define PG8_LDB(dst, b, h) do { _Pragma("unroll") for (int n = 0; n < 2; ++n) _Pragma("unroll") for (int k = 0; k < 2; ++k) dst[n][k] = *(const PG8_LAS bf16x8*)(lds + PG8_SB(b, h) + boff + n * 2048 + k * 1024); } while (0)
#define PG8_MMA(ai, bj, At, Bt) do { __builtin_amdgcn_s_setprio(1); _Pragma("unroll") for (int m = 0; m < 4; ++m) _Pragma("unroll") for (int n = 0; n < 2; ++n) _Pragma("unroll") for (int k = 0; k < 2; ++k) \
        acc[ai][bj][m][n] = __builtin_amdgcn_mfma_f32_16x16x32_bf16(Bt[n][k], At[m][k], acc[ai][bj][m][n], 0, 0, 0); __builtin_amdgcn_s_setprio(0); } while (0)
#define PG8_WAIT_V(n) asm volatile("s_waitcnt vmcnt(" #n ")" ::: "memory")
#define PG8_WAIT_L(n) asm volatile("s_waitcnt lgkmcnt(" #n ")" ::: "memory")
#define PG8_BAR __builtin_amdgcn_s_barrier()
#define PG8_SCHED __builtin_amdgcn_sched_barrier(0)
    Unit cur, nxt; int ui = 0;
    if (!S.next(0, cur)) return;
    f32x4 acc[2][2][4][2];
#pragma unroll
    for (int a = 0; a < 2; ++a)
#pragma unroll
        for (int b = 0; b < 2; ++b)
#pragma unroll
            for (int m = 0; m < 4; ++m)
#pragma unroll
                for (int n = 0; n < 2; ++n) acc[a][b][m][n] = (f32x4){0.f, 0.f, 0.f, 0.f};
    bf16x8 At[4][2], B0[2][2], B1[2][2];
    const char* cA = cur.A; const char* cB = cur.B;
    if constexpr (SP2) {
        PG8_STAGE(PG8_SB(0, 0), cB, voffB); PG8_STAGE(PG8_SB(0, 1), cB + hstep, voffB); PG8_STAGE(PG8_SA(0, 0), cA, voffA); PG8_STAGE(PG8_SA(0, 1), cA + hstep, voffA);
        if (wr == 1) PG8_BAR;
        PG8_WAIT_V(2); PG8_BAR;
        PG8_STAGE(PG8_SB(1, 0), cB + kstep, voffB); PG8_STAGE(PG8_SA(1, 0), cA + kstep, voffA); PG8_STAGE(PG8_SB(1, 1), cB + hstep + kstep, voffB);
        PG8_WAIT_V(6); PG8_BAR;
    } else {
        PG8_STAGE(PG8_SB(0, 0), cB, voffB); PG8_STAGE(PG8_SA(0, 0), cA, voffA); PG8_STAGE(PG8_SB(0, 1), cB + hstep, voffB); PG8_STAGE(PG8_SA(0, 1), cA + hstep, voffA);
        if (wr == 1) PG8_BAR;
        PG8_WAIT_V(4); PG8_BAR;
        PG8_STAGE(PG8_SB(1, 0), cB + kstep, voffB); PG8_STAGE(PG8_SA(1, 0), cA + kstep, voffA); PG8_STAGE(PG8_SB(1, 1), cB + hstep + kstep, voffB);
        PG8_WAIT_V(6); PG8_BAR;
    }
    for (;;) {
        const bool has_next = S.next(ui + 1, nxt);
        const char* nA = has_next ? nxt.A : cA; const char* nB = has_next ? nxt.B : cB;
        for (int t = 0; t < nt; t += 2) {
            const bool last = (t == nt - 2);
            const char* a1 = cA + (size_t)(t + 1) * kstep;
            const char* a2 = last ? nA : cA + (size_t)(t + 2) * kstep; const char* b2 = last ? nB : cB + (size_t)(t + 2) * kstep;
            const char* a3 = a2 + kstep; const char* b3 = b2 + kstep;
            if constexpr (SP2) {
            PG8_LDB(B0, 0, 0); PG8_LDB(B1, 0, 1); PG8_SCHED; PG8_LDA(At, 0, 0); PG8_STAGE(PG8_SA(1, 1), a1 + hstep, voffA);
            PG8_WAIT_V(8); PG8_WAIT_L(0); PG8_BAR; PG8_MMA(0, 0, At, B0); PG8_MMA(0, 1, At, B1); PG8_BAR; PG8_SCHED;
            PG8_LDA(At, 0, 1); PG8_STAGE(PG8_SB(0, 0), b2, voffB); PG8_STAGE(PG8_SB(0, 1), b2 + hstep, voffB); PG8_STAGE(PG8_SA(0, 0), a2, voffA);
            PG8_WAIT_V(8); PG8_WAIT_L(0); PG8_BAR; PG8_MMA(1, 0, At, B0); PG8_MMA(1, 1, At, B1); PG8_BAR; PG8_SCHED;
            PG8_LDB(B0, 1, 0); PG8_LDB(B1, 1, 1); PG8_SCHED; PG8_LDA(At, 1, 0); PG8_STAGE(PG8_SA(0, 1), a2 + hstep, voffA);
            PG8_WAIT_V(8); PG8_WAIT_L(0); PG8_BAR; PG8_MMA(0, 0, At, B0); PG8_MMA(0, 1, At, B1); PG8_BAR; PG8_SCHED;
            PG8_LDA(At, 1, 1); PG8_STAGE(PG8_SB(1, 0), b3, voffB); PG8_STAGE(PG8_SB(1, 1), b3 + hstep, voffB); PG8_STAGE(PG8_SA(1, 0), a3, voffA);
            PG8_WAIT_V(8); PG8_WAIT_L(0); PG8_BAR; PG8_MMA(1, 0, At, B0); PG8_MMA(1, 1, At, B1); PG8_BAR; PG8_SCHED;
            } else {
            PG8_LDB(B0, 0, 0); PG8_SCHED; PG8_LDA(At, 0, 0); PG8_STAGE(PG8_SA(1, 1), a1 + hstep, voffA);
            PG8_WAIT_L(8); PG8_BAR; PG8_WAIT_L(0); PG8_MMA(0, 0, At, B0); PG8_BAR; PG8_SCHED;
            PG8_LDB(B1, 0, 1); PG8_STAGE(PG8_SB(0, 0), b2, voffB);
            PG8_BAR; PG8_WAIT_L(0); PG8_MMA(0, 1, At, B1); PG8_BAR;
            PG8_LDA(At, 0, 1); PG8_STAGE(PG8_SA(0, 0), a2, voffA);
            PG8_BAR; PG8_WAIT_L(0); PG8_MMA(1, 0, At, B0); PG8_BAR; PG8_SCHED;
            PG8_STAGE(PG8_SB(0, 1), b2 + hstep, voffB);
            PG8_WAIT_V(6); PG8_BAR; PG8_MMA(1, 1, At, B1); PG8_BAR;
            PG8_LDB(B0, 1, 0); PG8_SCHED; PG8_LDA(At, 1, 0); PG8_STAGE(PG8_SA(0, 1), a2 + hstep, voffA);
            PG8_WAIT_L(8); PG8_BAR; PG8_WAIT_L(0); PG8_MMA(0, 0, At, B0); PG8_BAR; PG8_SCHED;
            PG8_LDB(B1, 1, 1); PG8_STAGE(PG8_SB(1, 0), b3, voffB);
            PG8_BAR; PG8_WAIT_L(0); PG8_MMA(0, 1, At, B1); PG8_BAR;
            PG8_LDA(At, 1, 1); PG8_STAGE(PG8_SA(1, 0), a3, voffA);
            PG8_BAR; PG8_WAIT_L(0); PG8_MMA(1, 0, At, B0); PG8_BAR; PG8_SCHED;
            PG8_STAGE(PG8_SB(1, 1), b3 + hstep, voffB);
            PG8_WAIT_V(6); PG8_BAR; PG8_MMA(1, 1, At, B1); PG8_BAR;
            }
        }
        if constexpr (ALIGN_EPI) { if (wr == 0) PG8_BAR; }
        E(acc, cur, wr, wc, fr, fq);
        if (!has_next) break;
#pragma unroll
        for (int a = 0; a < 2; ++a)
#pragma unroll
            for (int b = 0; b < 2; ++b)
#pragma unroll
                for (int m = 0; m < 4; ++m)
#pragma unroll
                    for (int n = 0; n < 2; ++n) acc[a][b][m][n] = (f32x4){0.f, 0.f, 0.f, 0.f};
        cur = nxt; cA = nA; cB = nB; ++ui;
        if constexpr (ALIGN_EPI) { if (wr == 1) PG8_BAR; }
    }
    PG8_WAIT_V(0);
    if constexpr (!ALIGN_EPI) { if (wr == 0) PG8_BAR; }
    PG8_BAR;
#undef PG8_SA
#undef PG8_SB
#undef PG8_STAGE
#undef PG8_LDA
#undef PG8_LDB
#undef PG8_MMA
#undef PG8_WAIT_V
#undef PG8_WAIT_L
#undef PG8_BAR
#undef PG8_SCHED
}
}

constexpr int NWAVES = 8;
constexpr int DM = 1024, NB = 2, SEQ = 8192, MTOK = NB * SEQ;
constexpr int CTXL = 256, MCTX = NB * CTXL, MALL = MTOK + MCTX;
constexpr int NMODV = 6 * DM;
constexpr int CONVC = 512, CONVW = 31, NHEADS = 8, HD = 64, ATTW = 512;
constexpr int NINC = 2560;
constexpr int NEXP = 16, DEXP = 2048, CAP = 1024, MX = NB * NEXP * CAP;
constexpr int GROWS = SEQ / 64;
constexpr float EPS = 1e-6f;
constexpr float LOG2E = 1.4426950408889634f;

constexpr size_t MiB = 1u << 20;
constexpr size_t WS_CTL = 0, CTL_ZERO_BYTES = 1 * MiB;
constexpr size_t WS_MOD = 1 * MiB;
constexpr size_t WS_AFF = 2 * MiB;
constexpr size_t WS_INV = 3 * MiB;
constexpr size_t WS_TOK = 4 * MiB;
constexpr size_t WS_WT = 4 * MiB + 128 * 1024;
constexpr size_t WS_WIN = 5 * MiB;
constexpr size_t WS_WOUT = 10 * MiB;
constexpr size_t WS_WGU = 12 * MiB;
constexpr size_t WS_WD = 140 * MiB;
constexpr size_t WS_X1 = 204 * MiB;
constexpr size_t WS_XS = 268 * MiB;
constexpr size_t WS_YS = WS_XS;
constexpr size_t WS_H = 332 * MiB;
constexpr size_t WS_U = 365 * MiB;
constexpr size_t WS_Q = 381 * MiB;
constexpr size_t WS_K = 397 * MiB;
constexpr size_t WS_VT = WS_K + 16 * MiB + 512 * 1024;
constexpr size_t WS_MIX = 430 * MiB;
constexpr size_t WS_HID = 332 * MiB;
constexpr size_t WS_H2 = 462 * MiB;
constexpr size_t WS_END = 494 * MiB;
static_assert(WS_VT + (size_t)512 * MALL * 2 <= WS_MIX && WS_HID + (size_t)MX * DEXP * 2 <= WS_H2, "ws map");

constexpr int CW_TMO = 0, CW_CODE = 1;
constexpr int CW_BAR = 4096;

constexpr int RING_OFF = 0, RING_BYTES = 131072;
constexpr int LDSCTL_OFF = RING_BYTES, MISC_OFF = LDSCTL_OFF + 320;
constexpr int LDS_BYTES = 163840;
static_assert(MISC_OFF + 128 + 8 * 15 * 32 * 4 <= LDS_BYTES, "LDS map");

#define GAS __attribute__((address_space(1)))
#define LAS __attribute__((address_space(3)))
typedef unsigned short bf16;
typedef unsigned v4u __attribute__((ext_vector_type(4)));
typedef unsigned v2u __attribute__((ext_vector_type(2)));
typedef float f32x4 __attribute__((ext_vector_type(4)));
typedef float f32x16 __attribute__((ext_vector_type(16)));
typedef short bf16x8 __attribute__((ext_vector_type(8)));
typedef GAS unsigned gu32;
#define RLX_AGENT __ATOMIC_RELAXED, __HIP_MEMORY_SCOPE_AGENT
#define LDS_WAIT() asm volatile("s_waitcnt lgkmcnt(0)" ::: "memory")
#define VM_WAIT() asm volatile("s_waitcnt vmcnt(0)" ::: "memory")
__device__ __forceinline__ unsigned f2bf(float f) { unsigned u = __builtin_bit_cast(unsigned, f); return (u + 0x7fffu + ((u >> 16) & 1u)) >> 16; }
__device__ __forceinline__ unsigned pk2(float lo, float hi) { return f2bf(lo) | (f2bf(hi) << 16); }
__device__ __forceinline__ float bf_lo(unsigned w) { return __builtin_bit_cast(float, w << 16); }
__device__ __forceinline__ float bf_hi(unsigned w) { return __builtin_bit_cast(float, w & 0xffff0000u); }
__device__ __forceinline__ float fast_sigmoid(float x) { return __builtin_amdgcn_rcpf(1.0f + __builtin_amdgcn_exp2f(-x * LOG2E)); }

#define XB_TMO      128
#define XB_XCNT(j)  (256  + 64 * (j))
#define XB_XSUB(j)  (1280 + 64 * (j))
#define XB_XGEN(j)  (2304 + 64 * (j))
#define XB_TOP      3328
#define XB_TOPGEN   3392
#define XCD_BAR_WORDS 3456
#define XB_SPIN_CAP (1u << 18)
__device__ __forceinline__ unsigned xb_ld(unsigned* p)              { return __hip_atomic_load(p, __ATOMIC_RELAXED, __HIP_MEMORY_SCOPE_AGENT); }
__device__ __forceinline__ unsigned xb_add(unsigned* p, unsigned v) { return __hip_atomic_fetch_add(p, v, __ATOMIC_RELAXED, __HIP_MEMORY_SCOPE_AGENT); }
__device__ __forceinline__ unsigned xb_xcc_id() { return (unsigned)__builtin_amdgcn_s_getreg((3 << 11) | 20) & 0xFu; }
#define XB_SPIN(cond, bar) do { unsigned _sp = 0; while (cond) { __builtin_amdgcn_s_sleep(1); \
    if ((++_sp & 255u) == 0u) { if (xb_ld(&(bar)[XB_TMO])) break; if (_sp > XB_SPIN_CAP) { atomicAdd(&(bar)[XB_TMO], 1u); break; } } } } while (0)
struct XcdBarrier { unsigned* bar; unsigned x; volatile LAS unsigned* st; };
__device__ __forceinline__ XcdBarrier xcd_barrier_post(unsigned* bar, volatile LAS unsigned* st) {
    XcdBarrier b; b.bar = bar; b.x = xb_xcc_id(); b.st = st;
    if (threadIdx.x == 0) (void)xb_add(&bar[XB_XCNT(b.x)], 1u);
    return b;
}
__device__ __forceinline__ void xcd_barrier_complete(unsigned* bar, unsigned x, unsigned& nloc, unsigned& nx) {
    const unsigned G = gridDim.x * gridDim.y * gridDim.z;
    unsigned sum, cnt, mine, sp = 0u;
    for (;;) {
        sum = 0u; cnt = 0u; mine = 0u;
#pragma unroll
        for (unsigned j = 0; j < 16; ++j) { const unsigned c = xb_ld(&bar[XB_XCNT(j)]); sum += c; cnt += (c > 0u) ? 1u : 0u; mine = (j == x) ? c : mine; }
        if (sum == G) break;
        __builtin_amdgcn_s_sleep(1);
        if ((++sp & 255u) == 0u) { if (xb_ld(&bar[XB_TMO])) break; if (sp > XB_SPIN_CAP) { atomicAdd(&bar[XB_TMO], 1u); break; } }
    }
    nloc = mine > 0u ? mine : 1u; nx = cnt > 0u ? cnt : 1u;
}
__device__ __forceinline__ void xcd_barrier(const XcdBarrier& b) {
    asm volatile("s_waitcnt vmcnt(0)" ::: "memory");
    __syncthreads();
    if (threadIdx.x == 0) {
        unsigned* bar = b.bar;
        __builtin_amdgcn_s_waitcnt(0);
        unsigned nloc = b.st[0], nx = b.st[1];
        if (nloc == 0u) { xcd_barrier_complete(bar, b.x, nloc, nx); b.st[0] = nloc; b.st[1] = nx; }
        const unsigned old = xb_add(&bar[XB_XSUB(b.x)], 1u);
        const unsigned gen = old / nloc;
        if (old + 1u == (gen + 1u) * nloc) {
            __builtin_amdgcn_fence(__ATOMIC_RELEASE, "agent");
            asm volatile("s_waitcnt vmcnt(0)" ::: "memory");
            const unsigned og = xb_add(&bar[XB_TOP], 1u);
            const unsigned tg = og / nx;
            if (og + 1u == (tg + 1u) * nx) xb_add(&bar[XB_TOPGEN], 1u);
            else XB_SPIN(xb_ld(&bar[XB_TOPGEN]) == tg, bar);
            __builtin_amdgcn_fence(__ATOMIC_ACQUIRE, "agent");
            xb_add(&bar[XB_XGEN(b.x)], 1u);
            asm volatile("s_waitcnt vmcnt(0)" ::: "memory");
        } else {
            XB_SPIN(xb_ld(&bar[XB_XGEN(b.x)]) == gen, bar);
            __builtin_amdgcn_fence(__ATOMIC_ACQUIRE, "agent");
            asm volatile("s_waitcnt vmcnt(0)" ::: "memory");
        }
    }
    __syncthreads();
}

struct Args { const float* in[20]; float* out; unsigned char* ws; int ph_lo, ph_hi; };
struct Frame {
    LAS unsigned char* lds;
    volatile LAS unsigned* MISC;
    int tid, lane, wave;
    int vcu, G;
    const Args* a;
};
#define FIN(name, idx) (F.a->in[idx])
#define F_x FIN(x, 0)
#define F_c FIN(c, 1)
#define F_ctx FIN(ctx, 2)
#define F_c_ctx FIN(c_ctx, 3)
#define F_w_mod FIN(w_mod, 4)
#define F_b_mod FIN(b_mod, 5)
#define F_norm_mix_g FIN(norm_mix_g, 6)
#define F_w_in FIN(w_in, 7)
#define F_conv_w FIN(conv_w, 8)
#define F_conv_b FIN(conv_b, 9)
#define F_conv_ln_g FIN(conv_ln_g, 10)
#define F_conv_ln_b FIN(conv_ln_b, 11)
#define F_rpb FIN(rpb, 12)
#define F_w_out FIN(w_out, 13)
#define F_norm_ffn_g FIN(norm_ffn_g, 14)
#define F_w_router FIN(w_router, 15)
#define F_w_gate FIN(w_gate, 16)
#define F_w_up FIN(w_up, 17)
#define F_w_down FIN(w_down, 18)
#define F_norm_final_g FIN(norm_final_g, 19)
#define F_out (F.a->out)
#define WSP(T, off) ((T*)(F.a->ws + (off)))
#define F_MOD WSP(float, WS_MOD)
#define F_AFF WSP(float, WS_AFF)
#define F_INV WSP(int, WS_INV)
#define F_TOK WSP(int, WS_TOK)
#define F_WTS WSP(float, WS_WT)
#define F_X1 WSP(float, WS_X1)
#define F_WIN WSP(bf16, WS_WIN)
#define F_WOUT WSP(bf16, WS_WOUT)
#define F_WGU WSP(bf16, WS_WGU)
#define F_WD WSP(bf16, WS_WD)
#define F_XS WSP(bf16, WS_XS)
#define F_YS WSP(bf16, WS_YS)
#define F_H WSP(bf16, WS_H)
#define F_U WSP(bf16, WS_U)
#define F_Q WSP(bf16, WS_Q)
#define F_K WSP(bf16, WS_K)
#define F_VT WSP(bf16, WS_VT)
#define F_MIX WSP(bf16, WS_MIX)
#define F_HID WSP(bf16, WS_HID)
#define F_H2 WSP(bf16, WS_H2)

__device__ __forceinline__ float wave_sum(float v) {
#pragma unroll
    for (int o = 1; o < 64; o <<= 1) v += __shfl_xor(v, o);
    return v;
}
__device__ __forceinline__ float wave_max(float v) {
#pragma unroll
    for (int o = 1; o < 64; o <<= 1) v = fmaxf(v, __shfl_xor(v, o));
    return v;
}

__device__ __forceinline__ void transpose_item(const float* W, int N, int k0, int n0, bf16* WT, int Kdst, int drow0, LAS float* scr, int lane) {
#pragma unroll 8
    for (int i = 0; i < 32; ++i) { const int kk = 2 * i + (lane >> 5); scr[kk * 33 + (lane & 31)] = W[(size_t)(k0 + kk) * N + n0 + (lane & 31)]; }
    LDS_WAIT(); asm volatile("" ::: "memory");
    const int c = lane & 7;
#pragma unroll
    for (int j = 0; j < 4; ++j) { const int n = (lane >> 3) + 8 * j; const LAS float* s = scr + (8 * c) * 33 + n;
        v4u o; o.x = pk2(s[0 * 33], s[1 * 33]); o.y = pk2(s[2 * 33], s[3 * 33]); o.z = pk2(s[4 * 33], s[5 * 33]); o.w = pk2(s[6 * 33], s[7 * 33]);
        *(GAS v4u*)(WT + (size_t)(drow0 + n) * Kdst + k0 + 8 * c) = o; }
    LDS_WAIT(); asm volatile("" ::: "memory");
}

__device__ __forceinline__ void p0_prologue(Frame& F) {
    {
        LAS float* sl = (LAS float*)(F.lds + RING_OFF);
        LAS float* part = sl + 3 * DM;
        for (int i = F.tid; i < 3 * DM; i += NWAVES * 64) { const int r = i >> 10, k = i & 1023; const float cv = (r < 2) ? F_c[r * DM + k] : F_c_ctx[k]; sl[i] = cv * fast_sigmoid(cv); }
        __syncthreads();
        for (int it = F.vcu; it < NMODV / 64; it += F.G) {
            const int n = it * 64 + F.lane; float a0 = 0.f, a1 = 0.f, a2 = 0.f;
            const int kb = F.wave * 128;
#pragma unroll 8
            for (int k = 0; k < 128; ++k) { const float w = F_w_mod[(size_t)(kb + k) * NMODV + n]; a0 += sl[kb + k] * w; a1 += sl[DM + kb + k] * w; a2 += sl[2 * DM + kb + k] * w; }
            part[(F.wave * 3 + 0) * 64 + F.lane] = a0; part[(F.wave * 3 + 1) * 64 + F.lane] = a1; part[(F.wave * 3 + 2) * 64 + F.lane] = a2;
            __syncthreads();
            if (F.wave < 3) { float s = F_b_mod[n];
#pragma unroll
                for (int w = 0; w < 8; ++w) s += part[(w * 3 + F.wave) * 64 + F.lane];
                F_MOD[F.wave * NMODV + n] = s; }
            __syncthreads();
        }
        __syncthreads();
    }
    LAS float* scr = (LAS float*)(F.lds + RING_OFF + F.wave * 16384);
    const int gw = F.vcu * NWAVES + F.wave, NGW = F.G * NWAVES;
    constexpr int I_IN = (DM / 64) * (NINC / 32);
    constexpr int I_OUT = (DM / 64) * (DM / 32);
    constexpr int I_G = (DM / 64) * (DEXP / 32);
    constexpr int I_D = (DEXP / 64) * (DM / 32);
    constexpr int NITEMS = I_IN + I_OUT + NEXP * (2 * I_G + I_D);
    for (int it = gw; it < NITEMS; it += NGW) {
        int r = it;
        if (r < I_IN) { const int nblk = NINC / 32, kb = r / nblk, nb = r % nblk, n0 = nb * 32;
            int drow = n0;
            if (n0 < 1024) { const int half = n0 >> 9, rem = n0 & 511; drow = 256 * (rem >> 7) + 128 * half + (rem & 127); }
            transpose_item(F_w_in, NINC, kb * 64, n0, F_WIN, DM, drow, scr, F.lane); continue; }
        r -= I_IN;
        if (r < I_OUT) { const int nblk = DM / 32, kb = r / nblk, nb = r % nblk; transpose_item(F_w_out, DM, kb * 64, nb * 32, F_WOUT, DM, nb * 32, scr, F.lane); continue; }
        r -= I_OUT;
        const int e = r / (2 * I_G + I_D); r -= e * (2 * I_G + I_D);
        if (r < 2 * I_G) { const int half = r / I_G; r -= half * I_G; const int nblk = DEXP / 32, kb = r / nblk, nb = r % nblk, n0 = nb * 32;
            const int drow = 256 * (n0 >> 7) + 128 * half + (n0 & 127);
            transpose_item((half ? F_w_up : F_w_gate) + (size_t)e * DM * DEXP, DEXP, kb * 64, n0, F_WGU + (size_t)e * 2 * DEXP * DM, DM, drow, scr, F.lane); continue; }
        r -= 2 * I_G;
        { const int nblk = DM / 32, kb = r / nblk, nb = r % nblk; transpose_item(F_w_down + (size_t)e * DEXP * DM, DM, kb * 64, nb * 32, F_WD + (size_t)e * DM * DEXP, DEXP, nb * 32, scr, F.lane); }
    }
}

__device__ __forceinline__ void p1_hpass(Frame& F) {
    const int gw = F.vcu * NWAVES + F.wave, NGW = F.G * NWAVES;
    for (int m = gw; m < MALL; m += NGW) {
        const float* xr = (m < MTOK) ? F_x + (size_t)m * DM : F_ctx + (size_t)(m - MTOK) * DM;
        const float* mod = F_MOD + (size_t)((m < MTOK) ? (m >> 13) : 2) * NMODV;
        f32x4 v[4]; float ss = 0.f;
#pragma unroll
        for (int j = 0; j < 4; ++j) { v[j] = *(const GAS f32x4*)(xr + 4 * F.lane + 256 * j); ss += (v[j].x * v[j].x + v[j].y * v[j].y) + (v[j].z * v[j].z + v[j].w * v[j].w); }
        const float rstd = 1.0f / sqrtf(wave_sum(ss) * (1.0f / DM) + EPS);
        GAS v2u* o = (GAS v2u*)(F_H + (size_t)m * DM);
#pragma unroll
        for (int j = 0; j < 4; ++j) { const int col = 4 * F.lane + 256 * j;
            const f32x4 g = *(const GAS f32x4*)(F_norm_mix_g + col), sh = *(const GAS f32x4*)(mod + col), sc = *(const GAS f32x4*)(mod + DM + col);
            const f32x4 h = v[j] * rstd * g * (1.0f + sc) + sh;
            v2u w; w.x = pk2(h.x, h.y); w.y = pk2(h.z, h.w); o[F.lane + 64 * j] = w; }
    }
}

struct InProjOrder {
    int vcu, G; const char *H, *WIN;
    __device__ __forceinline__ bool next(int i, pg8::Unit& u) const {
        const size_t tstep = (size_t)256 * DM * 2;
        int pm, pn, kind;
        if (G == 256) {
            const int x = vcu >> 5, s = vcu & 31;
            if (i < 2) { pm = 32 * i + 4 * x + (s & 3); pn = s >> 2; kind = pn < 4 ? 0 : (pn < 6 ? 1 : 2); }
            else if (i == 2) {
                if (s < 16) { kind = 3; pm = s & 1; pn = 8 * x + (s >> 1); }
                else if (s == 16) { if (x < 4) { kind = 3; pm = x & 1; pn = 64 + (x >> 1); } else { kind = 2; pm = 64 + ((x - 4) >> 1); pn = 6 + ((x - 4) & 1); } }
                else return false;
            } else return false;
        } else {
            const int L = i * G + vcu;
            if (L < 512) { pm = L >> 3; pn = L & 7; kind = pn < 4 ? 0 : (pn < 6 ? 1 : 2); }
            else if (L < 516) { kind = 2; pm = 64 + ((L - 512) >> 1); pn = 6 + ((L - 512) & 1); }
            else if (L < 648) { kind = 3; pm = (L - 516) & 1; pn = (L - 516) >> 1; }
            else return false;
        }
        u.pm = pm; u.pn = pn; u.kind = kind;
        if (kind == 3) { u.A = WIN + (size_t)(8 + pm) * tstep; u.B = H + (size_t)pn * tstep; }
        else { u.A = H + (size_t)pm * tstep; u.B = WIN + (size_t)pn * tstep; }
        return true;
    }
};
struct EpiInProj {
    static constexpr bool PERM = true;
    bf16 *U, *Q, *Kb, *Vt; float qscale;
    __device__ __forceinline__ void operator()(const pg8::f32x4 (&acc)[2][2][4][2], const pg8::Unit& u, int wr, int wc, int fr, int fq) const {
        const int row0 = u.pm * 256 + wr * 64 + fr;
        if (u.kind == 0) {
            const int col0 = u.pn * 128 + wc * 32 + 8 * fq;
#pragma unroll
            for (int ai = 0; ai < 2; ++ai)
#pragma unroll
                for (int m = 0; m < 4; ++m) {
                    float v[8];
#pragma unroll
                    for (int n = 0; n < 2; ++n)
#pragma unroll
                        for (int i = 0; i < 4; ++i) v[4 * n + i] = acc[ai][0][m][n][i] * fast_sigmoid(acc[ai][1][m][n][i]);
                    v4u w; w.x = pg8::cvt_pk_bf16(v[0], v[1]); w.y = pg8::cvt_pk_bf16(v[2], v[3]); w.z = pg8::cvt_pk_bf16(v[4], v[5]); w.w = pg8::cvt_pk_bf16(v[6], v[7]);
                    *(v4u*)(U + (size_t)(row0 + ai * 128 + m * 16) * CONVC + col0) = w; }
        } else {
            bf16* base; int ldc, colt; float sc = 1.f;
            if (u.kind == 1) { base = Q; ldc = ATTW; colt = (u.pn - 4) * 256; sc = qscale; }
            else if (u.kind == 2) { base = Kb; ldc = ATTW; colt = (u.pn - 6) * 256; }
            else { base = Vt; ldc = MALL; colt = u.pn * 256; }
            const int col0 = colt + wc * 32 + 8 * fq;
#pragma unroll
            for (int ai = 0; ai < 2; ++ai)
#pragma unroll
                for (int m = 0; m < 4; ++m) { bf16* rowp = base + (size_t)(row0 + ai * 128 + m * 16) * ldc + col0;
#pragma unroll
                    for (int bj = 0; bj < 2; ++bj) { const pg8::f32x4 v0 = acc[ai][bj][m][0] * sc, v1 = acc[ai][bj][m][1] * sc;
                        v4u w; w.x = pg8::cvt_pk_bf16(v0[0], v0[1]); w.y = pg8::cvt_pk_bf16(v0[2], v0[3]); w.z = pg8::cvt_pk_bf16(v1[0], v1[1]); w.w = pg8::cvt_pk_bf16(v1[2], v1[3]);
                        *(v4u*)(rowp + bj * 128) = w; } }
        }
    }
};

constexpr int P3_Y_OFF = 0;
constexpr int P3_BIAS_OFF = MISC_OFF + 128;
constexpr float ATT_THR = 8.0f;

__device__ __forceinline__ void attn_wave(Frame& F, int b, int r) {
    const int lane = F.lane, head = F.wave, q32 = lane & 31, hh = lane >> 5;
    const LAS float* bt = (const LAS float*)(F.lds + P3_BIAS_OFF) + head * 15 * 32;
    const int tok0 = b * SEQ + r * 64;
    bf16x8 Bq[2][4];
#pragma unroll
    for (int qt = 0; qt < 2; ++qt)
#pragma unroll
        for (int ds = 0; ds < 4; ++ds) Bq[qt][ds] = *(const GAS bf16x8*)(F_Q + (size_t)(tok0 + 32 * qt + q32) * ATTW + head * HD + 16 * ds + 8 * hh);
    f32x16 O[2][2];
#pragma unroll
    for (int a = 0; a < 2; ++a)
#pragma unroll
        for (int c = 0; c < 2; ++c)
#pragma unroll
            for (int i = 0; i < 16; ++i) O[a][c][i] = 0.f;
    float mref[2] = {-1e30f, -1e30f}, lsum[2] = {0.f, 0.f};
    const int pi = (q32 & 0x13) | ((q32 & 4) << 1) | ((q32 & 8) >> 1);
    int r0 = r - 4; r0 = r0 < 0 ? 0 : (r0 > GROWS - 8 ? GROWS - 8 : r0);
    const bf16* Kh = F_K + head * HD + 8 * hh;
    const bf16* Vh = F_VT + (size_t)(head * HD + q32) * MALL + 8 * hh;
    for (int t = 0; t < 24; ++t) {
        int ktok0, drow = 0, half = 0; const bool local = t >= 8;
        if (!local) ktok0 = MTOK + b * CTXL + 32 * t;
        else { const int j = (t - 8) >> 1; half = (t - 8) & 1; const int kr = r0 + j; drow = kr - r + 7; ktok0 = b * SEQ + kr * 64 + 32 * half; }
        bf16x8 Ak[4], Av[2][2];
#pragma unroll
        for (int ds = 0; ds < 4; ++ds) Ak[ds] = *(const GAS bf16x8*)(Kh + (size_t)(ktok0 + pi) * ATTW + 16 * ds);
#pragma unroll
        for (int dt = 0; dt < 2; ++dt)
#pragma unroll
            for (int s = 0; s < 2; ++s) Av[dt][s] = *(const GAS bf16x8*)(Vh + (size_t)(32 * dt) * MALL + ktok0 + 16 * s);
        f32x16 S[2];
        if (local) {
#pragma unroll
            for (int qt = 0; qt < 2; ++qt) { const int qc = 32 * qt + q32; int c0 = qc - 8; c0 = c0 < 0 ? 0 : (c0 > 48 ? 48 : c0);
#pragma unroll
                for (int rr = 0; rr < 16; ++rr) { const int kc = 32 * half + 16 * (rr >> 3) + 8 * hh + (rr & 7); const bool valid = (kc >= c0) && (kc < c0 + 16);
                    int delta = kc - qc + 15; delta = valid ? delta : 0;
                    const float bv = bt[drow * 32 + delta]; S[qt][rr] = valid ? bv : -1e30f; } }
        } else {
#pragma unroll
            for (int qt = 0; qt < 2; ++qt)
#pragma unroll
                for (int rr = 0; rr < 16; ++rr) S[qt][rr] = 0.f;
        }
#pragma unroll
        for (int qt = 0; qt < 2; ++qt)
#pragma unroll
            for (int ds = 0; ds < 4; ++ds) S[qt] = __builtin_amdgcn_mfma_f32_32x32x16_bf16(Ak[ds], Bq[qt][ds], S[qt], 0, 0, 0);
#pragma unroll
        for (int qt = 0; qt < 2; ++qt) {
            float tm = S[qt][0];
#pragma unroll
            for (int rr = 1; rr < 16; ++rr) tm = fmaxf(tm, S[qt][rr]);
            tm = fmaxf(tm, __shfl_xor(tm, 32));
            if (__any(tm > mref[qt] + ATT_THR)) {
                const float mn = fmaxf(mref[qt], tm), sc = __builtin_amdgcn_exp2f(mref[qt] - mn);
                mref[qt] = mn; lsum[qt] *= sc;
#pragma unroll
                for (int i = 0; i < 16; ++i) { O[0][qt][i] *= sc; O[1][qt][i] *= sc; }
            }
            float p[16]; float ps = 0.f;
#pragma unroll
            for (int rr = 0; rr < 16; ++rr) { p[rr] = __builtin_amdgcn_exp2f(S[qt][rr] - mref[qt]); ps += p[rr]; }
            lsum[qt] += ps;
            bf16x8 Bp[2];
#pragma unroll
            for (int s = 0; s < 2; ++s) { v4u w; w.x = pg8::cvt_pk_bf16(p[8 * s + 0], p[8 * s + 1]); w.y = pg8::cvt_pk_bf16(p[8 * s + 2], p[8 * s + 3]); w.z = pg8::cvt_pk_bf16(p[8 * s + 4], p[8 * s + 5]); w.w = pg8::cvt_pk_bf16(p[8 * s + 6], p[8 * s + 7]);
                Bp[s] = __builtin_bit_cast(bf16x8, w); }
#pragma unroll
            for (int dt = 0; dt < 2; ++dt)
#pragma unroll
                for (int s = 0; s < 2; ++s) O[dt][qt] = __builtin_amdgcn_mfma_f32_32x32x16_bf16(Av[dt][s], Bp[s], O[dt][qt], 0, 0, 0);
        }
    }
#pragma unroll
    for (int qt = 0; qt < 2; ++qt) {
        const float lt = lsum[qt] + __shfl_xor(lsum[qt], 32), inv = 1.0f / lt;
        bf16* orow = F_MIX + (size_t)(tok0 + 32 * qt + q32) * DM + CONVC + head * HD + 4 * hh;
#pragma unroll
        for (int dt = 0; dt < 2; ++dt)
#pragma unroll
            for (int g4 = 0; g4 < 4; ++g4) { v2u w; w.x = pg8::cvt_pk_bf16(O[dt][qt][4 * g4 + 0] * inv, O[dt][qt][4 * g4 + 1] * inv); w.y = pg8::cvt_pk_bf16(O[dt][qt][4 * g4 + 2] * inv, O[dt][qt][4 * g4 + 3] * inv);
                *(GAS v2u*)(orow + 32 * dt + 8 * g4) = w; }
    }
}

typedef float f32x2 __attribute__((ext_vector_type(2)));
__device__ __forceinline__ void conv_unit(Frame& F, int b, int r) {
    const int lane = F.lane, w = F.wave;
    const int cp = F.tid & 255, th = F.tid >> 8;
    LAS float* yb = (LAS float*)(F.lds + P3_Y_OFF);
    const float *cw = F_conv_w, *cb = F_conv_b, *lg = F_conv_ln_g, *lb = F_conv_ln_b;
    asm volatile("" : "+s"(cw), "+s"(cb), "+s"(lg), "+s"(lb));
    {
        const int t0 = r * 64 + 32 * th - 15;
        f32x2 in[62];
        const bf16* up = F_U + (size_t)b * SEQ * CONVC + 2 * cp;
#pragma unroll
        for (int k = 0; k < 62; ++k) { const int tt = t0 + k; unsigned wv = 0u; if (tt >= 0 && tt < SEQ) wv = *(const GAS unsigned*)(up + (size_t)tt * CONVC); in[k] = (f32x2){bf_lo(wv), bf_hi(wv)}; }
        f32x2 wj[CONVW];
#pragma unroll
        for (int j = 0; j < CONVW; ++j) wj[j] = *(const GAS f32x2*)(cw + j * CONVC + 2 * cp);
        const f32x2 bias = *(const GAS f32x2*)(cb + 2 * cp);
#pragma unroll
        for (int t = 0; t < 32; ++t) { f32x2 a = bias;
#pragma unroll
            for (int j = 0; j < CONVW; ++j) a = wj[j] * in[t + j] + a;
            *(LAS f32x2*)(yb + (32 * th + t) * CONVC + 2 * cp) = a; }
    }
    __syncthreads();
    const f32x4 g0 = *(const GAS f32x4*)(lg + 8 * lane), g1 = *(const GAS f32x4*)(lg + 8 * lane + 4);
    const f32x4 b0 = *(const GAS f32x4*)(lb + 8 * lane), b1 = *(const GAS f32x4*)(lb + 8 * lane + 4);
#pragma unroll 2
    for (int k = 0; k < 8; ++k) { const int tk = 8 * w + k;
        f32x4 y0 = *(const LAS f32x4*)(yb + tk * CONVC + 8 * lane), y1 = *(const LAS f32x4*)(yb + tk * CONVC + 8 * lane + 4);
        const float s = wave_sum((y0.x + y0.y) + (y0.z + y0.w) + (y1.x + y1.y) + (y1.z + y1.w));
        const float mean = s * (1.0f / CONVC);
        y0 = y0 - mean; y1 = y1 - mean;
        const float q = wave_sum((y0.x * y0.x + y0.y * y0.y) + (y0.z * y0.z + y0.w * y0.w) + (y1.x * y1.x + y1.y * y1.y) + (y1.z * y1.z + y1.w * y1.w));
        const float rstd = 1.0f / sqrtf(q * (1.0f / CONVC) + EPS);
        y0 = y0 * rstd * g0 + b0; y1 = y1 * rstd * g1 + b1;
        v4u wv; wv.x = pk2(y0.x * fast_sigmoid(y0.x), y0.y * fast_sigmoid(y0.y)); wv.y = pk2(y0.z * fast_sigmoid(y0.z), y0.w * fast_sigmoid(y0.w));
        wv.z = pk2(y1.x * fast_sigmoid(y1.x), y1.y * fast_sigmoid(y1.y)); wv.w = pk2(y1.z * fast_sigmoid(y1.z), y1.w * fast_sigmoid(y1.w));
        *(GAS v4u*)(F_MIX + (size_t)(b * SEQ + r * 64 + tk) * DM + 8 * lane) = wv; }
    __syncthreads();
}

__device__ __forceinline__ void p3_mixers(Frame& F) {
    LAS float* bt = (LAS float*)(F.lds + P3_BIAS_OFF);
    for (int i = F.tid; i < NHEADS * 15 * 32; i += NWAVES * 64) { const int c = i & 31, hr = i >> 5; bt[i] = (c < 31) ? F_rpb[hr * 31 + c] * LOG2E : 0.f; }
    __syncthreads();
    for (int u = F.vcu; u < NB * GROWS; u += F.G) {
        const int b = u / GROWS, r = u % GROWS;
        attn_wave(F, b, r);
        asm volatile("" ::: "memory"); __builtin_amdgcn_sched_barrier(0); __syncthreads(); asm volatile("" ::: "memory");
        conv_unit(F, b, r);
    }
}

struct OutProjOrder {
    int vcu, G; const char *MIX, *WOUT;
    __device__ __forceinline__ bool next(int i, pg8::Unit& u) const {
        const size_t tstep = (size_t)256 * DM * 2;
        int pm, pn;
        if (G == 256) { if (i > 0) return false; const int x = vcu >> 5, s = vcu & 31; pm = 8 * x + (s & 7); pn = s >> 3; }
        else { const int L = i * G + vcu; if (L >= 256) return false; pm = L >> 2; pn = L & 3; }
        u.pm = pm; u.pn = pn; u.kind = 0; u.A = MIX + (size_t)pm * tstep; u.B = WOUT + (size_t)pn * tstep; return true;
    }
};
struct EpiOutProj {
    static constexpr bool PERM = false;
    const float* x; const float* MOD; float* X1;
    __device__ __forceinline__ void operator()(const pg8::f32x4 (&acc)[2][2][4][2], const pg8::Unit& u, int wr, int wc, int fr, int fq) const {
        const int row0 = u.pm * 256 + wr * 64 + fr, col0 = u.pn * 256 + wc * 32 + 4 * fq;
        const float* g1 = MOD + (size_t)(u.pm >> 5) * NMODV + 2 * DM;
        pg8::f32x4 gv[2][2];
#pragma unroll
        for (int bj = 0; bj < 2; ++bj)
#pragma unroll
            for (int n = 0; n < 2; ++n) gv[bj][n] = *(const pg8::f32x4*)(g1 + col0 + bj * 128 + n * 16);
#pragma unroll
        for (int ai = 0; ai < 2; ++ai)
#pragma unroll
            for (int m = 0; m < 4; ++m) { const size_t off = (size_t)(row0 + ai * 128 + m * 16) * DM + col0;
#pragma unroll
                for (int bj = 0; bj < 2; ++bj)
#pragma unroll
                    for (int n = 0; n < 2; ++n) { const pg8::f32x4 xv = *(const pg8::f32x4*)(x + off + bj * 128 + n * 16);
                        *(pg8::f32x4*)(X1 + off + bj * 128 + n * 16) = xv + gv[bj][n] * acc[ai][bj][m][n]; } }
    }
};

__device__ __forceinline__ void p5_router(Frame& F) {
    LAS f32x4* wl = (LAS f32x4*)(F.lds + RING_OFF);
    for (int idx = F.tid; idx < DM * 4; idx += NWAVES * 64) { const int c = idx >> 2, q = idx & 3; const f32x4 v = *(const GAS f32x4*)(F_w_router + c * NEXP + 4 * q);
        const int j = c >> 8, l = (c & 255) >> 2, i = c & 3; wl[((j * 4 + i) * 4 + q) * 64 + l] = v; }
    __syncthreads();
    const int gw = F.vcu * NWAVES + F.wave, NGW = F.G * NWAVES;
    for (int m = gw; m < MTOK; m += NGW) {
        const int b = m >> 13, t = m & (SEQ - 1);
        const float* mod = F_MOD + (size_t)b * NMODV;
        f32x4 v[4]; float ss = 0.f;
#pragma unroll
        for (int j = 0; j < 4; ++j) { v[j] = *(const GAS f32x4*)(F_X1 + (size_t)m * DM + 4 * F.lane + 256 * j); ss += (v[j].x * v[j].x + v[j].y * v[j].y) + (v[j].z * v[j].z + v[j].w * v[j].w); }
        const float rstd = 1.0f / sqrtf(wave_sum(ss) * (1.0f / DM) + EPS);
        GAS v2u* o = (GAS v2u*)(F_H2 + (size_t)m * DM);
        float lg[16];
#pragma unroll
        for (int e = 0; e < 16; ++e) lg[e] = 0.f;
#pragma unroll
        for (int j = 0; j < 4; ++j) { const int col = 4 * F.lane + 256 * j;
            const f32x4 g = *(const GAS f32x4*)(F_norm_ffn_g + col), sh = *(const GAS f32x4*)(mod + 3 * DM + col), sc = *(const GAS f32x4*)(mod + 4 * DM + col);
            const f32x4 h = v[j] * rstd * g * (1.0f + sc) + sh;
            v2u w; w.x = pk2(h.x, h.y); w.y = pk2(h.z, h.w); o[F.lane + 64 * j] = w;
#pragma unroll
            for (int i = 0; i < 4; ++i) {
#pragma unroll
                for (int q = 0; q < 4; ++q) { const f32x4 wv = wl[((j * 4 + i) * 4 + q) * 64 + F.lane];
                    lg[4 * q + 0] += h[i] * wv.x; lg[4 * q + 1] += h[i] * wv.y; lg[4 * q + 2] += h[i] * wv.z; lg[4 * q + 3] += h[i] * wv.w; }
                __builtin_amdgcn_sched_barrier(0); } }
        float mx = -1e30f;
#pragma unroll
        for (int e = 0; e < 16; ++e) { lg[e] = wave_sum(lg[e]); mx = fmaxf(mx, lg[e]); }
        float den = 0.f;
#pragma unroll
        for (int e = 0; e < 16; ++e) { lg[e] = __expf(lg[e] - mx); den += lg[e]; }
        float mine = 0.f;
#pragma unroll
        for (int e = 0; e < 16; ++e) mine = (F.lane == e) ? lg[e] : mine;
        if (F.lane < 16) F_AFF[(size_t)(b * NEXP + F.lane) * SEQ + t] = mine / den;
    }
}

__device__ __forceinline__ int block_excl_scan(int v, LAS int* sc, int tid, int lane, int wave, int& total) {
    int inc = v;
#pragma unroll
    for (int o = 1; o < 64; o <<= 1) { const int t = __shfl_up(inc, o); if (lane >= o) inc += t; }
    __syncthreads();
    if (lane == 63) sc[wave] = inc;
    __syncthreads();
    int base = 0, tot = 0;
#pragma unroll
    for (int w = 0; w < 8; ++w) { const int c = sc[w]; if (w < wave) base += c; tot += c; }
    total = tot;
    return base + inc - v;
}
__device__ __forceinline__ void p6_topk(Frame& F) {
    LAS int* hist = (LAS int*)(F.lds + RING_OFF);
    LAS int* sel = hist + 256;
    LAS int* sc = hist + 264;
    for (int be = blockIdx.x; be < NB * NEXP; be += F.G) {
        const int b = be >> 4, e = be & 15;
        const float* a = F_AFF + (size_t)be * SEQ + 16 * F.tid;
        unsigned v[16];
#pragma unroll
        for (int j = 0; j < 4; ++j) { const v4u q = *(const GAS v4u*)(a + 4 * j); v[4 * j] = q.x; v[4 * j + 1] = q.y; v[4 * j + 2] = q.z; v[4 * j + 3] = q.w; }
        unsigned prefix = 0u, mask = 0u; int kk = CAP;
#pragma unroll 1
        for (int pass = 0; pass < 4; ++pass) { const int shift = 24 - 8 * pass;
            __syncthreads();
            if (F.tid < 256) hist[F.tid] = 0;
            __syncthreads();
#pragma unroll
            for (int j = 0; j < 16; ++j) if ((v[j] & mask) == prefix) __hip_atomic_fetch_add(&hist[(v[j] >> shift) & 255u], 1, __ATOMIC_RELAXED, __HIP_MEMORY_SCOPE_WORKGROUP);
            __syncthreads();
            if (F.wave == 0) {
                int c[4]; int s4 = 0;
#pragma unroll
                for (int j = 0; j < 4; ++j) { c[j] = hist[4 * F.lane + j]; s4 += c[j]; }
                int suf = s4;
#pragma unroll
                for (int o = 1; o < 64; o <<= 1) { const int t = __shfl_down(suf, o); if (F.lane + o < 64) suf += t; }
                int above = suf - s4;
#pragma unroll
                for (int j = 3; j >= 0; --j) { if (above < kk && kk <= above + c[j]) { sel[0] = 4 * F.lane + j; sel[1] = kk - above; } above += c[j]; }
            }
            __syncthreads();
            prefix |= (unsigned)sel[0] << shift; mask |= 255u << shift; kk = sel[1];
        }
        const unsigned T = prefix; const int need_eq = kk;
        int ceq = 0;
#pragma unroll
        for (int j = 0; j < 16; ++j) ceq += (v[j] == T) ? 1 : 0;
        int tot; int eqb = block_excl_scan(ceq, sc, F.tid, F.lane, F.wave, tot);
        unsigned selm = 0u; int csel = 0;
#pragma unroll
        for (int j = 0; j < 16; ++j) { bool s = v[j] > T; if (v[j] == T) { s = eqb < need_eq; ++eqb; } if (s) { selm |= 1u << j; ++csel; } }
        int slot = block_excl_scan(csel, sc, F.tid, F.lane, F.wave, tot);
        const int obase = (e * 2 + b) * CAP;
        int iv[16];
#pragma unroll
        for (int j = 0; j < 16; ++j) { const bool s = (selm >> j) & 1u; iv[j] = s ? slot : -1;
            if (s) { F_TOK[obase + slot] = 16 * F.tid + j; F_WTS[obase + slot] = __builtin_bit_cast(float, v[j]); ++slot; } }
        int* ip = F_INV + (size_t)be * SEQ + 16 * F.tid;
#pragma unroll
        for (int j = 0; j < 4; ++j) *(GAS v4u*)(ip + 4 * j) = (v4u){(unsigned)iv[4 * j], (unsigned)iv[4 * j + 1], (unsigned)iv[4 * j + 2], (unsigned)iv[4 * j + 3]};
        __syncthreads();
    }
}

__device__ __forceinline__ void p6b_gather(Frame& F) {
    const int gw = F.vcu * NWAVES + F.wave, NGW = F.G * NWAVES;
    for (int R = gw; R < MX; R += NGW) {
        const int b = (R >> 10) & 1, t = F_TOK[R];
        const GAS v4u* s = (const GAS v4u*)(F_H2 + (size_t)(b * SEQ + t) * DM); GAS v4u* d = (GAS v4u*)(F_XS + (size_t)R * DM);
        const v4u a = s[F.lane], c = s[F.lane + 64]; d[F.lane] = a; d[F.lane + 64] = c;
    }
}

struct GateUpOrder {
    int vcu, G; const char *XS, *WGU;
    __device__ __forceinline__ bool next(int i, pg8::Unit& u) const {
        int e, pml, pn;
        if (G == 256) { if (i >= 8) return false; const int x = vcu >> 5, s = vcu & 31; e = 2 * x + (i >> 2); pml = s & 7; pn = 4 * (i & 3) + (s >> 3); }
        else { const int L = i * G + vcu; if (L >= 2048) return false; e = L >> 7; pml = L & 7; pn = (L >> 3) & 15; }
        u.pm = e * 8 + pml; u.pn = pn; u.kind = 0;
        u.A = XS + (size_t)u.pm * 256 * DM * 2; u.B = WGU + ((size_t)e * 2 * DEXP + (size_t)pn * 256) * DM * 2; return true;
    }
};
struct EpiSwiGLU {
    static constexpr bool PERM = true;
    bf16* HID;
    __device__ __forceinline__ void operator()(const pg8::f32x4 (&acc)[2][2][4][2], const pg8::Unit& u, int wr, int wc, int fr, int fq) const {
        const int row0 = u.pm * 256 + wr * 64 + fr, col0 = u.pn * 128 + wc * 32 + 8 * fq;
#pragma unroll
        for (int ai = 0; ai < 2; ++ai)
#pragma unroll
            for (int m = 0; m < 4; ++m) {
                float v[8];
#pragma unroll
                for (int n = 0; n < 2; ++n)
#pragma unroll
                    for (int i = 0; i < 4; ++i) { const float g = acc[ai][0][m][n][i]; v[4 * n + i] = g * fast_sigmoid(g) * acc[ai][1][m][n][i]; }
                v4u w; w.x = pg8::cvt_pk_bf16(v[0], v[1]); w.y = pg8::cvt_pk_bf16(v[2], v[3]); w.z = pg8::cvt_pk_bf16(v[4], v[5]); w.w = pg8::cvt_pk_bf16(v[6], v[7]);
                *(v4u*)(HID + (size_t)(row0 + ai * 128 + m * 16) * DEXP + col0) = w; }
    }
};
struct DownOrder {
    int vcu, G; const char *HID, *WD;
    __device__ __forceinline__ bool next(int i, pg8::Unit& u) const {
        int e, pml, pn;
        if (G == 256) { if (i >= 2) return false; const int x = vcu >> 5, s = vcu & 31; e = 2 * x + i; pml = s & 7; pn = s >> 3; }
        else { const int L = i * G + vcu; if (L >= 512) return false; e = L >> 5; pml = L & 7; pn = (L >> 3) & 3; }
        u.pm = e * 8 + pml; u.pn = pn; u.kind = 0;
        u.A = HID + (size_t)u.pm * 256 * DEXP * 2; u.B = WD + ((size_t)e * DM + (size_t)pn * 256) * DEXP * 2; return true;
    }
};
struct EpiDown {
    static constexpr bool PERM = true;
    bf16* YS; const float* WTS;
    __device__ __forceinline__ void operator()(const pg8::f32x4 (&acc)[2][2][4][2], const pg8::Unit& u, int wr, int wc, int fr, int fq) const {
        const int row0 = u.pm * 256 + wr * 64 + fr, col0 = u.pn * 256 + wc * 32 + 8 * fq;
#pragma unroll
        for (int ai = 0; ai < 2; ++ai)
#pragma unroll
            for (int m = 0; m < 4; ++m) { const int row = row0 + ai * 128 + m * 16; const float wt = WTS[row]; bf16* rowp = YS + (size_t)row * DM + col0;
#pragma unroll
                for (int bj = 0; bj < 2; ++bj) { const pg8::f32x4 v0 = acc[ai][bj][m][0] * wt, v1 = acc[ai][bj][m][1] * wt;
                    v4u w; w.x = pg8::cvt_pk_bf16(v0[0], v0[1]); w.y = pg8::cvt_pk_bf16(v0[2], v0[3]); w.z = pg8::cvt_pk_bf16(v1[0], v1[1]); w.w = pg8::cvt_pk_bf16(v1[2], v1[3]);
                    *(v4u*)(rowp + bj * 128) = w; } }
    }
};

__device__ __forceinline__ void p9_final(Frame& F) {
    const int gw = F.vcu * NWAVES + F.wave, NGW = F.G * NWAVES;
    for (int m = gw; m < MTOK; m += NGW) {
        const int b = m >> 13, t = m & (SEQ - 1);
        const float* mod = F_MOD + (size_t)b * NMODV;
        int slotv = -1;
        if (F.lane < 16) slotv = F_INV[(size_t)(b * NEXP + F.lane) * SEQ + t];
        f32x4 v[4], sum[4];
#pragma unroll
        for (int j = 0; j < 4; ++j) { v[j] = *(const GAS f32x4*)(F_X1 + (size_t)m * DM + 4 * F.lane + 256 * j); sum[j] = (f32x4){0.f, 0.f, 0.f, 0.f}; }
#pragma unroll
        for (int e = 0; e < 16; ++e) { const int sl = __builtin_amdgcn_readlane(slotv, e);
            if (sl >= 0) { const GAS v2u* yr = (const GAS v2u*)(F_YS + (size_t)((e * 2 + b) * CAP + sl) * DM);
#pragma unroll
                for (int j = 0; j < 4; ++j) { const v2u w = yr[F.lane + 64 * j]; sum[j].x += bf_lo(w.x); sum[j].y += bf_hi(w.x); sum[j].z += bf_lo(w.y); sum[j].w += bf_hi(w.y); } } }
        float ss = 0.f;
#pragma unroll
        for (int j = 0; j < 4; ++j) { const int col = 4 * F.lane + 256 * j; const f32x4 g2 = *(const GAS f32x4*)(mod + 5 * DM + col);
            v[j] = v[j] + g2 * sum[j]; ss += (v[j].x * v[j].x + v[j].y * v[j].y) + (v[j].z * v[j].z + v[j].w * v[j].w); }
        const float rstd = 1.0f / sqrtf(wave_sum(ss) * (1.0f / DM) + EPS);
#pragma unroll
        for (int j = 0; j < 4; ++j) { const int col = 4 * F.lane + 256 * j; const f32x4 g = *(const GAS f32x4*)(F_norm_final_g + col);
            *(GAS f32x4*)(F_out + (size_t)m * DM + col) = v[j] * rstd * g; }
    }
}

constexpr int N_PHASES = 10;
__global__ void __launch_bounds__(NWAVES * 64, 2) mk_fwd(Args args) {
    extern __shared__ __attribute__((aligned(16))) unsigned char lds[];
    Frame F;
    F.lds = (LAS unsigned char*)lds;
    F.MISC = (volatile LAS unsigned*)(F.lds + MISC_OFF);
    F.tid = threadIdx.x; F.lane = F.tid & 63; F.wave = __builtin_amdgcn_readfirstlane(F.tid >> 6);
    F.G = gridDim.x; { const int bx = blockIdx.x; F.vcu = (F.G % 8 == 0) ? (bx % 8) * (F.G / 8) + bx / 8 : bx; }
    F.a = &args;
    gu32* ctl = (gu32*)(args.ws + WS_CTL);
    for (int u = F.tid; u < (MISC_OFF + 128 - LDSCTL_OFF) / 4; u += NWAVES * 64) ((LAS unsigned*)(F.lds + LDSCTL_OFF))[u] = 0u;
    __syncthreads();
    const int lo = args.ph_lo, hi = args.ph_hi;
    const bool multi = (hi - lo) > 1;
    XcdBarrier bar; bar.bar = (unsigned*)(ctl + CW_BAR); bar.x = 0; bar.st = nullptr;
    if (multi) bar = xcd_barrier_post((unsigned*)(ctl + CW_BAR), F.MISC + 8);
#ifndef PH_MASK
#define PH_MASK 0xFFFF
#endif
#define IN(k) ((((PH_MASK) >> (k)) & 1) && lo <= (k) && (k) < hi)
#define SEAM(k) do { if (IN(k) && IN((k) + 1)) xcd_barrier(bar); } while (0)

    if (IN(0)) { p0_prologue(F); SEAM(0); }
    if (IN(1)) { p1_hpass(F); SEAM(1); }
    if (IN(2)) {
        InProjOrder S{F.vcu, F.G, (const char*)F_H, (const char*)F_WIN};
        EpiInProj E{F_U, F_Q, F_K, F_VT, 0.125f * LOG2E};
        pg8::gemm_phase<EpiInProj, InProjOrder>(F.lds + RING_OFF, DM, S, E);
        SEAM(2);
    }
    if (IN(3)) { p3_mixers(F); SEAM(3); }
    if (IN(4)) {
        OutProjOrder S{F.vcu, F.G, (const char*)F_MIX, (const char*)F_WOUT};
        EpiOutProj E{F_x, F_MOD, F_X1};
        pg8::gemm_phase<EpiOutProj, OutProjOrder>(F.lds + RING_OFF, DM, S, E);
        SEAM(4);
    }
    if (IN(5)) { p5_router(F); SEAM(5); }
    if (IN(6)) { p6_topk(F); SEAM(6); }
    if (IN(7)) { p6b_gather(F); SEAM(7); }
    if (IN(8)) {
        GateUpOrder S{F.vcu, F.G, (const char*)F_XS, (const char*)F_WGU};
        EpiSwiGLU E{F_HID};
        pg8::gemm_phase<EpiSwiGLU, GateUpOrder>(F.lds + RING_OFF, DM, S, E);
        SEAM(8);
    }
    if (IN(9)) {
        DownOrder S{F.vcu, F.G, (const char*)F_HID, (const char*)F_WD};
        EpiDown E{F_YS, F_WTS};
        pg8::gemm_phase<EpiDown, DownOrder>(F.lds + RING_OFF, DEXP, S, E);
        SEAM(9);
    }
    if (IN(10)) { p9_final(F); }
#undef IN
#undef SEAM
}

extern "C" void kernel_launch(void* const* d_in, const int* in_sizes, int n_in, void* d_out, int out_size, void* d_ws, size_t ws_size, hipStream_t stream) {
    static int grid = 0;
    if (grid == 0) {
        if (n_in != 20 || out_size != MTOK * DM || ws_size < WS_END) { fprintf(stderr, "kernel_launch: unexpected shapes (n_in %d out %d ws %zu)\n", n_in, out_size, ws_size); grid = -1; return; }
        int dev = 0, cus = 0, per_cu = 0;
        if (hipGetDevice(&dev) != hipSuccess || hipDeviceGetAttribute(&cus, hipDeviceAttributeMultiprocessorCount, dev) != hipSuccess) { grid = -1; return; }
        if (hipFuncSetAttribute((const void*)mk_fwd, hipFuncAttributeMaxDynamicSharedMemorySize, LDS_BYTES) != hipSuccess) { fprintf(stderr, "kernel_launch: hipFuncSetAttribute failed\n"); grid = -1; return; }
        if (hipOccupancyMaxActiveBlocksPerMultiprocessor(&per_cu, (const void*)mk_fwd, NWAVES * 64, LDS_BYTES) != hipSuccess || per_cu < 1) { fprintf(stderr, "kernel_launch: occupancy query says %d\n", per_cu); per_cu = 1; }
        (void)hipGetLastError();
        grid = cus;
    }
    if (grid < 0) return;
    (void)hipMemsetAsync((char*)d_ws + WS_CTL, 0, CTL_ZERO_BYTES, stream);
    Args a{};
    for (int i = 0; i < 20; ++i) a.in[i] = (const float*)d_in[i];
    a.out = (float*)d_out; a.ws = (unsigned char*)d_ws;
#if MK_ONE_LAUNCH
    a.ph_lo = 0; a.ph_hi = N_PHASES + 1;
    hipLaunchKernelGGL(mk_fwd, dim3(grid), dim3(NWAVES * 64), LDS_BYTES, stream, a);
#else
    for (int p = 0; p <= N_PHASES; ++p) { a.ph_lo = p; a.ph_hi = p + 1; hipLaunchKernelGGL(mk_fwd, dim3(grid), dim3(NWAVES * 64), LDS_BYTES, stream, a); }
#endif
}
```

```cpp
#include <hip/hip_runtime.h>
#include <cstdio>
#include <cstdint>

#ifndef MK_ONE_LAUNCH
#define MK_ONE_LAUNCH 1
#endif

namespace pg8 {
#define PG8_LAS __attribute__((address_space(3)))
typedef unsigned short bf16_t;
typedef short bf16x8 __attribute__((ext_vector_type(8)));
typedef float f32x4 __attribute__((ext_vector_type(4)));
typedef unsigned u32x4 __attribute__((ext_vector_type(4)));
constexpr int BM = 256, BK = 64, HALF = 128, HTB = HALF * BK * 2, STAGE_BYTES = 8 * HTB;

__host__ __device__ __forceinline__ int lds_byte(int r, int c) { const int st = (r >> 4) * 2 + (c >> 5), rr = r & 15, cc = c & 31, ob = rr * 64 + cc * 2; return st * 1024 + (ob ^ (((ob >> 9) & 1) << 5)); }
__host__ __device__ __forceinline__ void stage_rc(int b, int& R, int& C) { const int st = b / 1024, sb = b % 1024, swz = sb ^ (((sb >> 9) & 1) << 5); R = (st >> 1) * 16 + swz / 64; C = (st & 1) * 32 + (swz % 64) / 2; }
__host__ __device__ __forceinline__ int perm32(int rho) { const int n = rho >> 4, i = rho & 15; return 8 * (i >> 2) + 4 * n + (i & 3); }

struct Unit { int pm, pn, kind; const char* A; const char* B; };

__device__ __forceinline__ unsigned cvt_pk_bf16(float lo, float hi) { unsigned r; asm volatile("v_cvt_pk_bf16_f32 %0, %1, %2" : "=v"(r) : "v"(lo), "v"(hi)); return r; }

template <class Epi, class Sched, bool GATHER = false, bool ALIGN_EPI = true, bool SP2 = true>
__device__ __forceinline__ void gemm_phase(PG8_LAS unsigned char* lds, const int K, const Sched& S, const Epi& E) {
    const int tid = threadIdx.x, wid = __builtin_amdgcn_readfirstlane(tid >> 6), lane = tid & 63, wr = wid >> 2, wc = wid & 3, fr = lane & 15, fq = lane >> 4;
    const int nt = K / BK;
    unsigned voffA[2], voffB[2];
#pragma unroll
    for (int i = 0; i < 2; ++i) { int R, C; stage_rc(tid * 16 + i * 8192, R, C); const int Rb = Epi::PERM ? ((R & ~31) + perm32(R & 31)) : R;
        voffA[i] = (unsigned)(R * K + C) * 2u; voffB[i] = (unsigned)(Rb * K + C) * 2u; }
    const size_t kstep = (size_t)(BK * 2);
    const size_t hstep = (size_t)HALF * K * 2;
    const unsigned ldsw = (unsigned)wid * 1024u;
    const int aoff = lds_byte(wr * 64 + fr, fq * 8), boff = lds_byte(wc * 32 + fr, fq * 8);
#define PG8_SA(b, h) (((b) * 2 + (h)) * HTB)
#define PG8_SB(b, h) ((4 + (b) * 2 + (h)) * HTB)
#define PG8_STAGE(bufoff, gbase, voff) do { _Pragma("unroll") for (int _i = 0; _i < 2; ++_i) \
        __builtin_amdgcn_global_load_lds((const unsigned*)((const char*)(gbase) + (voff)[_i]), (PG8_LAS unsigned*)(lds + (bufoff) + ldsw + _i * 8192), 16, 0, 0); } while (0)
#define PG8_STAGE_A(bufoff, kptr, h, goff) do { _Pragma("unroll") for (int _i = 0; _i < 2; ++_i) \
        __builtin_amdgcn_global_load_lds((const unsigned*)((const char*)(kptr) + (GATHER ? (goff)[h][_i] : (voffA[_i] + (unsigned)((h) * hstep)))), (PG8_LAS unsigned*)(lds + (bufoff) + ldsw + _i * 8192), 16, 0, 0); } while (0)
#define PG8_LDA(dst, b, h) do { _Pragma("unroll") for (int m = 0; m < 4; ++m) _Pragma("unroll") for (int k = 0; k < 2; ++k) dst[m][k] = *(const PG8_LAS bf16x8*)(lds + PG8_SA(b, h) + aoff + m * 2048 + k * 1024); } while (0)
#define PG8_LDB(dst, b, h) do { _Pragma("unroll") for (int n = 0; n < 2; ++n) _Pragma("unroll") for (int k = 0; k < 2; ++k) dst[n][k] = *(const PG8_LAS bf16x8*)(lds + PG8_SB(b, h) + boff + n * 2048 + k * 1024); } while (0)
#define PG8_MMA(ai, bj, At, Bt) do { __builtin_amdgcn_s_setprio(1); _Pragma("unroll") for (int m = 0; m < 4; ++m) _Pragma("unroll") for (int n = 0; n < 2; ++n) _Pragma("unroll") for (int k = 0; k < 2; ++k) \
        acc[ai][bj][m][n] = __builtin_amdgcn_mfma_f32_16x16x32_bf16(Bt[n][k], At[m][k], acc[ai][bj][m][n], 0, 0, 0); __builtin_amdgcn_s_setprio(0); } while (0)
#define PG8_WAIT_V(n) asm volatile("s_waitcnt vmcnt(" #n ")" ::: "memory")
#define PG8_WAIT_L(n) asm volatile("s_waitcnt lgkmcnt(" #n ")" ::: "memory")
#define PG8_BAR __builtin_amdgcn_s_barrier()
#define PG8_SCHED __builtin_amdgcn_sched_barrier(0)
    Unit cur, nxt; int ui = 0;
    if (!S.next(0, cur)) return;
    f32x4 acc[2][2][4][2];
#pragma unroll
    for (int a = 0; a < 2; ++a)
#pragma unroll
        for (int b = 0; b < 2; ++b)
#pragma unroll
            for (int m = 0; m < 4; ++m)
#pragma unroll
                for (int n = 0; n < 2; ++n) acc[a][b][m][n] = (f32x4){0.f, 0.f, 0.f, 0.f};
    bf16x8 At[4][2], B0[2][2], B1[2][2];
    const char* cA = cur.A; const char* cB = cur.B;
    unsigned goffC[2][2] = {{0u, 0u}, {0u, 0u}}, goffN[2][2] = {{0u, 0u}, {0u, 0u}}, goffS[2][2] = {{0u, 0u}, {0u, 0u}};
    int gR[2], gC[2];
#pragma unroll
    for (int i = 0; i < 2; ++i) stage_rc(tid * 16 + i * 8192, gR[i], gC[i]);
    if constexpr (GATHER) {
#pragma unroll
        for (int h = 0; h < 2; ++h)
#pragma unroll
            for (int i = 0; i < 2; ++i) goffC[h][i] = (unsigned)((S.row_base(cur) + S.rows(cur)[h * HALF + gR[i]]) * K + gC[i]) * 2u;
    }
    if constexpr (SP2) {
        PG8_STAGE(PG8_SB(0, 0), cB, voffB); PG8_STAGE(PG8_SB(0, 1), cB + hstep, voffB); PG8_STAGE_A(PG8_SA(0, 0), cA, 0, goffC); PG8_STAGE_A(PG8_SA(0, 1), cA, 1, goffC);
        if (wr == 1) PG8_BAR;
        PG8_WAIT_V(2); PG8_BAR;
        PG8_STAGE(PG8_SB(1, 0), cB + kstep, voffB); PG8_STAGE_A(PG8_SA(1, 0), cA + kstep, 0, goffC); PG8_STAGE(PG8_SB(1, 1), cB + hstep + kstep, voffB);
        PG8_WAIT_V(6); PG8_BAR;
    } else {
        PG8_STAGE(PG8_SB(0, 0), cB, voffB); PG8_STAGE_A(PG8_SA(0, 0), cA, 0, goffC); PG8_STAGE(PG8_SB(0, 1), cB + hstep, voffB); PG8_STAGE_A(PG8_SA(0, 1), cA, 1, goffC);
        if (wr == 1) PG8_BAR;
        PG8_WAIT_V(4); PG8_BAR;
        PG8_STAGE(PG8_SB(1, 0), cB + kstep, voffB); PG8_STAGE_A(PG8_SA(1, 0), cA + kstep, 0, goffC); PG8_STAGE(PG8_SB(1, 1), cB + hstep + kstep, voffB);
        PG8_WAIT_V(6); PG8_BAR;
    }
    for (;;) {
        const bool has_next = S.next(ui + 1, nxt);
        const char* nA = has_next ? nxt.A : cA; const char* nB = has_next ? nxt.B : cB;
        if constexpr (GATHER) {
#pragma unroll
            for (int h = 0; h < 2; ++h)
#pragma unroll
                for (int i = 0; i < 2; ++i) goffN[h][i] = has_next ? (unsigned)((S.row_base(nxt) + S.rows(nxt)[h * HALF + gR[i]]) * K + gC[i]) * 2u : goffC[h][i];
        }
        for (int t = 0; t < nt; t += 2) {
            const bool last = (t == nt - 2);
            const char* a1 = cA + (size_t)(t + 1) * kstep;
            const char* a2 = last ? nA : cA + (size_t)(t + 2) * kstep; const char* b2 = last ? nB : cB + (size_t)(t + 2) * kstep;
            const char* a3 = a2 + kstep; const char* b3 = b2 + kstep;
            if constexpr (GATHER) {
#pragma unroll
                for (int h = 0; h < 2; ++h)
#pragma unroll
                    for (int i = 0; i < 2; ++i) goffS[h][i] = last ? goffN[h][i] : goffC[h][i];
            }
            if constexpr (SP2) {
            PG8_LDB(B0, 0, 0); PG8_LDB(B1, 0, 1); PG8_SCHED; PG8_LDA(At, 0, 0); PG8_STAGE_A(PG8_SA(1, 1), a1, 1, goffC);
            PG8_WAIT_V(8); PG8_WAIT_L(0); PG8_BAR; PG8_MMA(0, 0, At, B0); PG8_MMA(0, 1, At, B1); PG8_BAR; PG8_SCHED;
            PG8_LDA(At, 0, 1); PG8_STAGE(PG8_SB(0, 0), b2, voffB); PG8_STAGE(PG8_SB(0, 1), b2 + hstep, voffB); PG8_STAGE_A(PG8_SA(0, 0), a2, 0, goffS);
            PG8_WAIT_V(8); PG8_WAIT_L(0); PG8_BAR; PG8_MMA(1, 0, At, B0); PG8_MMA(1, 1, At, B1); PG8_BAR; PG8_SCHED;
            PG8_LDB(B0, 1, 0); PG8_LDB(B1, 1, 1); PG8_SCHED; PG8_LDA(At, 1, 0); PG8_STAGE_A(PG8_SA(0, 1), a2, 1, goffS);
            PG8_WAIT_V(8); PG8_WAIT_L(0); PG8_BAR; PG8_MMA(0, 0, At, B0); PG8_MMA(0, 1, At, B1); PG8_BAR; PG8_SCHED;
            PG8_LDA(At, 1, 1); PG8_STAGE(PG8_SB(1, 0), b3, voffB); PG8_STAGE(PG8_SB(1, 1), b3 + hstep, voffB); PG8_STAGE_A(PG8_SA(1, 0), a3, 0, goffS);
            PG8_WAIT_V(8); PG8_WAIT_L(0); PG8_BAR; PG8_MMA(1, 0, At, B0); PG8_MMA(1, 1, At, B1); PG8_BAR; PG8_SCHED;
            } else {
            PG8_LDB(B0, 0, 0); PG8_SCHED; PG8_LDA(At, 0, 0); PG8_STAGE_A(PG8_SA(1, 1), a1, 1, goffC);
            PG8_WAIT_L(8); PG8_BAR; PG8_WAIT_L(0); PG8_MMA(0, 0, At, B0); PG8_BAR; PG8_SCHED;
            PG8_LDB(B1, 0, 1); PG8_STAGE(PG8_SB(0, 0), b2, voffB);
            PG8_BAR; PG8_WAIT_L(0); PG8_MMA(0, 1, At, B1); PG8_BAR;
            PG8_LDA(At, 0, 1); PG8_STAGE_A(PG8_SA(0, 0), a2, 0, goffS);
            PG8_BAR; PG8_WAIT_L(0); PG8_MMA(1, 0, At, B0); PG8_BAR; PG8_SCHED;
            PG8_STAGE(PG8_SB(0, 1), b2 + hstep, voffB);
            PG8_WAIT_V(6); PG8_BAR; PG8_MMA(1, 1, At, B1); PG8_BAR;
            PG8_LDB(B0, 1, 0); PG8_SCHED; PG8_LDA(At, 1, 0); PG8_STAGE_A(PG8_SA(0, 1), a2, 1, goffS);
            PG8_WAIT_L(8); PG8_BAR; PG8_WAIT_L(0); PG8_MMA(0, 0, At, B0); PG8_BAR; PG8_SCHED;
            PG8_LDB(B1, 1, 1); PG8_STAGE(PG8_SB(1, 0), b3, voffB);
            PG8_BAR; PG8_WAIT_L(0); PG8_MMA(0, 1, At, B1); PG8_BAR;
            PG8_LDA(At, 1, 1); PG8_STAGE_A(PG8_SA(1, 0), a3, 0, goffS);
            PG8_BAR; PG8_WAIT_L(0); PG8_MMA(1, 0, At, B0); PG8_BAR; PG8_SCHED;
            PG8_STAGE(PG8_SB(1, 1), b3 + hstep, voffB);
            PG8_WAIT_V(6); PG8_BAR; PG8_MMA(1, 1, At, B1); PG8_BAR;
            }
        }
        if constexpr (ALIGN_EPI) { if (wr == 0) PG8_BAR; }
        E(acc, cur, wr, wc, fr, fq);
        if (!has_next) break;
#pragma unroll
        for (int a = 0; a < 2; ++a)
#pragma unroll
            for (int b = 0; b < 2; ++b)
#pragma unroll
                for (int m = 0; m < 4; ++m)
#pragma unroll
                    for (int n = 0; n < 2; ++n) acc[a][b][m][n] = (f32x4){0.f, 0.f, 0.f, 0.f};
        cur = nxt; cA = nA; cB = nB; ++ui;
        if constexpr (GATHER) {
#pragma unroll
            for (int h = 0; h < 2; ++h)
#pragma unroll
                for (int i = 0; i < 2; ++i) goffC[h][i] = goffN[h][i];
        }
        if constexpr (ALIGN_EPI) { if (wr == 1) PG8_BAR; }
    }
    PG8_WAIT_V(0);
    if constexpr (!ALIGN_EPI) { if (wr == 0) PG8_BAR; }
    PG8_BAR;
#undef PG8_SA
#undef PG8_SB
#undef PG8_STAGE
#undef PG8_STAGE_A
#undef PG8_LDA
#undef PG8_LDB
#undef PG8_MMA
#undef PG8_WAIT_V
#undef PG8_WAIT_L
#undef PG8_BAR
#undef PG8_SCHED
}
}

constexpr int NWAVES = 8;
constexpr int DM = 1024, NB = 2, SEQ = 8192, MTOK = NB * SEQ;
constexpr int CTXL = 256, MCTX = NB * CTXL, MALL = MTOK + MCTX;
constexpr int NMODV = 6 * DM;
constexpr int CONVC = 512, CONVW = 31, NHEADS = 8, HD = 64, ATTW = 512;
constexpr int NINC = 2560;
constexpr int NEXP = 16, DEXP = 2048, CAP = 1024, MX = NB * NEXP * CAP;
constexpr int GROWS = SEQ / 64;
constexpr float EPS = 1e-6f;
constexpr float LOG2E = 1.4426950408889634f;

constexpr size_t MiB = 1u << 20;
constexpr size_t WS_CTL = 0, CTL_ZERO_BYTES = 1 * MiB;
constexpr size_t WS_MOD = 1 * MiB;
constexpr size_t WS_AFF = 2 * MiB;
constexpr size_t WS_INV = 3 * MiB;
constexpr size_t WS_TOK = 4 * MiB;
constexpr size_t WS_WT = 4 * MiB + 128 * 1024;
constexpr size_t WS_WIN = 5 * MiB;
constexpr size_t WS_WOUT = 10 * MiB;
constexpr size_t WS_WGU = 12 * MiB;
constexpr size_t WS_WD = 140 * MiB;
constexpr size_t WS_X1 = 204 * MiB;
constexpr size_t WS_YS = 268 * MiB;
constexpr size_t WS_H = 332 * MiB;
constexpr size_t WS_U = 365 * MiB;
constexpr size_t WS_Q = 381 * MiB;
constexpr size_t WS_K = 397 * MiB;
constexpr size_t WS_VT = WS_K + 16 * MiB + 512 * 1024;
constexpr size_t WS_MIX = 430 * MiB;
constexpr size_t WS_HID = 332 * MiB;
constexpr size_t WS_H2 = 462 * MiB;
constexpr size_t WS_END = 494 * MiB;
static_assert(WS_VT + (size_t)512 * MALL * 2 <= WS_MIX && WS_HID + (size_t)MX * DEXP * 2 <= WS_H2, "ws map");

constexpr int CW_TMO = 0, CW_CODE = 1;
constexpr int CW_BAR = 4096;

constexpr int RING_OFF = 0, RING_BYTES = 131072;
constexpr int LDSCTL_OFF = RING_BYTES, MISC_OFF = LDSCTL_OFF + 320;
constexpr int LDS_BYTES = 163840;
static_assert(MISC_OFF + 128 + 8 * 15 * 32 * 4 <= LDS_BYTES, "LDS map");

#define GAS __attribute__((address_space(1)))
#define LAS __attribute__((address_space(3)))
typedef unsigned short bf16;
typedef unsigned v4u __attribute__((ext_vector_type(4)));
typedef unsigned v2u __attribute__((ext_vector_type(2)));
typedef float f32x4 __attribute__((ext_vector_type(4)));
typedef float f32x16 __attribute__((ext_vector_type(16)));
typedef short bf16x8 __attribute__((ext_vector_type(8)));
typedef GAS unsigned gu32;
#define RLX_AGENT __ATOMIC_RELAXED, __HIP_MEMORY_SCOPE_AGENT
#define LDS_WAIT() asm volatile("s_waitcnt lgkmcnt(0)" ::: "memory")
#define VM_WAIT() asm volatile("s_waitcnt vmcnt(0)" ::: "memory")
__device__ __forceinline__ unsigned f2bf(float f) { unsigned u = __builtin_bit_cast(unsigned, f); return (u + 0x7fffu + ((u >> 16) & 1u)) >> 16; }
__device__ __forceinline__ unsigned pk2(float lo, float hi) { return f2bf(lo) | (f2bf(hi) << 16); }
__device__ __forceinline__ float bf_lo(unsigned w) { return __builtin_bit_cast(float, w << 16); }
__device__ __forceinline__ float bf_hi(unsigned w) { return __builtin_bit_cast(float, w & 0xffff0000u); }
__device__ __forceinline__ float fast_sigmoid(float x) { return __builtin_amdgcn_rcpf(1.0f + __builtin_amdgcn_exp2f(-x * LOG2E)); }

#define XB_TMO      128
#define XB_XCNT(j)  (256  + 64 * (j))
#define XB_XSUB(j)  (1280 + 64 * (j))
#define XB_XGEN(j)  (2304 + 64 * (j))
#define XB_TOP      3328
#define XB_TOPGEN   3392
#define XCD_BAR_WORDS 3456
#define XB_SPIN_CAP (1u << 18)
__device__ __forceinline__ unsigned xb_ld(unsigned* p)              { return __hip_atomic_load(p, __ATOMIC_RELAXED, __HIP_MEMORY_SCOPE_AGENT); }
__device__ __forceinline__ unsigned xb_add(unsigned* p, unsigned v) { return __hip_atomic_fetch_add(p, v, __ATOMIC_RELAXED, __HIP_MEMORY_SCOPE_AGENT); }
__device__ __forceinline__ unsigned xb_xcc_id() { return (unsigned)__builtin_amdgcn_s_getreg((3 << 11) | 20) & 0xFu; }
#define XB_SPIN(cond, bar) do { unsigned _sp = 0; while (cond) { __builtin_amdgcn_s_sleep(1); \
    if ((++_sp & 255u) == 0u) { if (xb_ld(&(bar)[XB_TMO])) break; if (_sp > XB_SPIN_CAP) { atomicAdd(&(bar)[XB_TMO], 1u); break; } } } } while (0)
struct XcdBarrier { unsigned* bar; unsigned x; volatile LAS unsigned* st; };
__device__ __forceinline__ XcdBarrier xcd_barrier_post(unsigned* bar, volatile LAS unsigned* st) {
    XcdBarrier b; b.bar = bar; b.x = xb_xcc_id(); b.st = st;
    if (threadIdx.x == 0) (void)xb_add(&bar[XB_XCNT(b.x)], 1u);
    return b;
}
__device__ __forceinline__ void xcd_barrier_complete(unsigned* bar, unsigned x, unsigned& nloc, unsigned& nx) {
    const unsigned G = gridDim.x * gridDim.y * gridDim.z;
    unsigned sum, cnt, mine, sp = 0u;
    for (;;) {
        sum = 0u; cnt = 0u; mine = 0u;
#pragma unroll
        for (unsigned j = 0; j < 16; ++j) { const unsigned c = xb_ld(&bar[XB_XCNT(j)]); sum += c; cnt += (c > 0u) ? 1u : 0u; mine = (j == x) ? c : mine; }
        if (sum == G) break;
        __builtin_amdgcn_s_sleep(1);
        if ((++sp & 255u) == 0u) { if (xb_ld(&bar[XB_TMO])) break; if (sp > XB_SPIN_CAP) { atomicAdd(&bar[XB_TMO], 1u); break; } }
    }
    nloc = mine > 0u ? mine : 1u; nx = cnt > 0u ? cnt : 1u;
}
__device__ __forceinline__ void xcd_barrier(const XcdBarrier& b) {
    asm volatile("s_waitcnt vmcnt(0)" ::: "memory");
    __syncthreads();
    if (threadIdx.x == 0) {
        unsigned* bar = b.bar;
        __builtin_amdgcn_s_waitcnt(0);
        unsigned nloc = b.st[0], nx = b.st[1];
        if (nloc == 0u) { xcd_barrier_complete(bar, b.x, nloc, nx); b.st[0] = nloc; b.st[1] = nx; }
        const unsigned old = xb_add(&bar[XB_XSUB(b.x)], 1u);
        const unsigned gen = old / nloc;
        if (old + 1u == (gen + 1u) * nloc) {
            __builtin_amdgcn_fence(__ATOMIC_RELEASE, "agent");
            asm volatile("s_waitcnt vmcnt(0)" ::: "memory");
            const unsigned og = xb_add(&bar[XB_TOP], 1u);
            const unsigned tg = og / nx;
            if (og + 1u == (tg + 1u) * nx) xb_add(&bar[XB_TOPGEN], 1u);
            else XB_SPIN(xb_ld(&bar[XB_TOPGEN]) == tg, bar);
            __builtin_amdgcn_fence(__ATOMIC_ACQUIRE, "agent");
            xb_add(&bar[XB_XGEN(b.x)], 1u);
            asm volatile("s_waitcnt vmcnt(0)" ::: "memory");
        } else {
            XB_SPIN(xb_ld(&bar[XB_XGEN(b.x)]) == gen, bar);
            __builtin_amdgcn_fence(__ATOMIC_ACQUIRE, "agent");
            asm volatile("s_waitcnt vmcnt(0)" ::: "memory");
        }
    }
    __syncthreads();
}

struct Args { const float* in[20]; float* out; unsigned char* ws; int ph_lo, ph_hi; };
struct Frame {
    LAS unsigned char* lds;
    volatile LAS unsigned* MISC;
    int tid, lane, wave;
    int vcu, G;
    const Args* a;
};
#define FIN(name, idx) (F.a->in[idx])
#define F_x FIN(x, 0)
#define F_c FIN(c, 1)
#define F_ctx FIN(ctx, 2)
#define F_c_ctx FIN(c_ctx, 3)
#define F_w_mod FIN(w_mod, 4)
#define F_b_mod FIN(b_mod, 5)
#define F_norm_mix_g FIN(norm_mix_g, 6)
#define F_w_in FIN(w_in, 7)
#define F_conv_w FIN(conv_w, 8)
#define F_conv_b FIN(conv_b, 9)
#define F_conv_ln_g FIN(conv_ln_g, 10)
#define F_conv_ln_b FIN(conv_ln_b, 11)
#define F_rpb FIN(rpb, 12)
#define F_w_out FIN(w_out, 13)
#define F_norm_ffn_g FIN(norm_ffn_g, 14)
#define F_w_router FIN(w_router, 15)
#define F_w_gate FIN(w_gate, 16)
#define F_w_up FIN(w_up, 17)
#define F_w_down FIN(w_down, 18)
#define F_norm_final_g FIN(norm_final_g, 19)
#define F_out (F.a->out)
#define WSP(T, off) ((T*)(F.a->ws + (off)))
#define F_MOD WSP(float, WS_MOD)
#define F_AFF WSP(float, WS_AFF)
#define F_INV WSP(int, WS_INV)
#define F_TOK WSP(int, WS_TOK)
#define F_WTS WSP(float, WS_WT)
#define F_X1 WSP(float, WS_X1)
#define F_WIN WSP(bf16, WS_WIN)
#define F_WOUT WSP(bf16, WS_WOUT)
#define F_WGU WSP(bf16, WS_WGU)
#define F_WD WSP(bf16, WS_WD)
#define F_YS WSP(bf16, WS_YS)
#define F_H WSP(bf16, WS_H)
#define F_U WSP(bf16, WS_U)
#define F_Q WSP(bf16, WS_Q)
#define F_K WSP(bf16, WS_K)
#define F_VT WSP(bf16, WS_VT)
#define F_MIX WSP(bf16, WS_MIX)
#define F_HID WSP(bf16, WS_HID)
#define F_H2 WSP(bf16, WS_H2)

template <int CTRL> __device__ __forceinline__ float dpp_mov(float v) { return __builtin_bit_cast(float, __builtin_amdgcn_update_dpp(0, __builtin_bit_cast(int, v), CTRL, 0xF, 0xF, true)); }
__device__ __forceinline__ float row16_sum(float v) { v += dpp_mov<0xB1>(v); v += dpp_mov<0x4E>(v); v += dpp_mov<0x141>(v); v += dpp_mov<0x140>(v); return v; }
__device__ __forceinline__ float row16_max(float v) { v = fmaxf(v, dpp_mov<0xB1>(v)); v = fmaxf(v, dpp_mov<0x4E>(v)); v = fmaxf(v, dpp_mov<0x141>(v)); v = fmaxf(v, dpp_mov<0x140>(v)); return v; }
__device__ __forceinline__ float rdlane(float v, int l) { return __builtin_bit_cast(float, __builtin_amdgcn_readlane(__builtin_bit_cast(int, v), l)); }
__device__ __forceinline__ float wave_sum(float v) {
    v = row16_sum(v);
    return (rdlane(v, 0) + rdlane(v, 16)) + (rdlane(v, 32) + rdlane(v, 48));
}
__device__ __forceinline__ float half_sum(float v, int half) {
    v = row16_sum(v);
    const float lo = rdlane(v, 0) + rdlane(v, 16), hi = rdlane(v, 32) + rdlane(v, 48);
    return half ? hi : lo;
}
__device__ __forceinline__ float wave_max(float v) {
#pragma unroll
    for (int o = 1; o < 64; o <<= 1) v = fmaxf(v, __shfl_xor(v, o));
    return v;
}

__device__ __forceinline__ void transpose_item(const float* W, int N, int k0, int n0, bf16* WT, int Kdst, int drow0, LAS float* scr, int lane) {
#pragma unroll 8
    for (int i = 0; i < 32; ++i) { const int kk = 2 * i + (lane >> 5); scr[kk * 33 + (lane & 31)] = W[(size_t)(k0 + kk) * N + n0 + (lane & 31)]; }
    LDS_WAIT(); asm volatile("" ::: "memory");
    const int c = lane & 7;
#pragma unroll
    for (int j = 0; j < 4; ++j) { const int n = (lane >> 3) + 8 * j; const LAS float* s = scr + (8 * c) * 33 + n;
        v4u o; o.x = pk2(s[0 * 33], s[1 * 33]); o.y = pk2(s[2 * 33], s[3 * 33]); o.z = pk2(s[4 * 33], s[5 * 33]); o.w = pk2(s[6 * 33], s[7 * 33]);
        *(GAS v4u*)(WT + (size_t)(drow0 + n) * Kdst + k0 + 8 * c) = o; }
    LDS_WAIT(); asm volatile("" ::: "memory");
}

__device__ __forceinline__ void p0_prologue(Frame& F) {
    {
        LAS float* sl = (LAS float*)(F.lds + RING_OFF);
        LAS float* part = sl + 3 * DM;
        for (int i = F.tid; i < 3 * DM; i += NWAVES * 64) { const int r = i >> 10, k = i & 1023; const float cv = (r < 2) ? F_c[r * DM + k] : F_c_ctx[k]; sl[i] = cv * fast_sigmoid(cv); }
        __syncthreads();
        for (int it = F.vcu; it < NMODV / 64; it += F.G) {
            const int n = it * 64 + F.lane; float a0 = 0.f, a1 = 0.f, a2 = 0.f;
            const int kb = F.wave * 128;
#pragma unroll 8
            for (int k = 0; k < 128; ++k) { const float w = F_w_mod[(size_t)(kb + k) * NMODV + n]; a0 += sl[kb + k] * w; a1 += sl[DM + kb + k] * w; a2 += sl[2 * DM + kb + k] * w; }
            part[(F.wave * 3 + 0) * 64 + F.lane] = a0; part[(F.wave * 3 + 1) * 64 + F.lane] = a1; part[(F.wave * 3 + 2) * 64 + F.lane] = a2;
            __syncthreads();
            if (F.wave < 3) { float s = F_b_mod[n];
#pragma unroll
                for (int w = 0; w < 8; ++w) s += part[(w * 3 + F.wave) * 64 + F.lane];
                F_MOD[F.wave * NMODV + n] = s; }
            __syncthreads();
        }
        __syncthreads();
    }
    LAS float* scr = (LAS float*)(F.lds + RING_OFF + F.wave * 16384);
    const int gw = F.vcu * NWAVES + F.wave, NGW = F.G * NWAVES;
    constexpr int I_IN = (DM / 64) * (NINC / 32);
    constexpr int I_OUT = (DM / 64) * (DM / 32);
    constexpr int I_G = (DM / 64) * (DEXP / 32);
    constexpr int I_D = (DEXP / 64) * (DM / 32);
    constexpr int NITEMS = I_IN + I_OUT + NEXP * (2 * I_G + I_D);
    for (int it = gw; it < NITEMS; it += NGW) {
        int r = it;
        if (r < I_IN) { const int nblk = NINC / 32, kb = r / nblk, nb = r % nblk, n0 = nb * 32;
            int drow = n0;
            if (n0 < 1024) { const int half = n0 >> 9, rem = n0 & 511; drow = 256 * (rem >> 7) + 128 * half + (rem & 127); }
            transpose_item(F_w_in, NINC, kb * 64, n0, F_WIN, DM, drow, scr, F.lane); continue; }
        r -= I_IN;
        if (r < I_OUT) { const int nblk = DM / 32, kb = r / nblk, nb = r % nblk; transpose_item(F_w_out, DM, kb * 64, nb * 32, F_WOUT, DM, nb * 32, scr, F.lane); continue; }
        r -= I_OUT;
        const int e = r / (2 * I_G + I_D); r -= e * (2 * I_G + I_D);
        if (r < 2 * I_G) { const int half = r / I_G; r -= half * I_G; const int nblk = DEXP / 32, kb = r / nblk, nb = r % nblk, n0 = nb * 32;
            const int drow = 256 * (n0 >> 7) + 128 * half + (n0 & 127);
            transpose_item((half ? F_w_up : F_w_gate) + (size_t)e * DM * DEXP, DEXP, kb * 64, n0, F_WGU + (size_t)e * 2 * DEXP * DM, DM, drow, scr, F.lane); continue; }
        r -= 2 * I_G;
        { const int nblk = DM / 32, kb = r / nblk, nb = r % nblk; transpose_item(F_w_down + (size_t)e * DEXP * DM, DM, kb * 64, nb * 32, F_WD + (size_t)e * DM * DEXP, DEXP, nb * 32, scr, F.lane); }
    }
}

__device__ __forceinline__ void p1_hpass(Frame& F) {
    const int gw = F.vcu * NWAVES + F.wave, NGW = F.G * NWAVES;
    for (int m = gw; m < MALL; m += NGW) {
        const float* xr = (m < MTOK) ? F_x + (size_t)m * DM : F_ctx + (size_t)(m - MTOK) * DM;
        const float* mod = F_MOD + (size_t)((m < MTOK) ? (m >> 13) : 2) * NMODV;
        f32x4 v[4]; float ss = 0.f;
#pragma unroll
        for (int j = 0; j < 4; ++j) { v[j] = *(const GAS f32x4*)(xr + 4 * F.lane + 256 * j); ss += (v[j].x * v[j].x + v[j].y * v[j].y) + (v[j].z * v[j].z + v[j].w * v[j].w); }
        const float rstd = 1.0f / sqrtf(wave_sum(ss) * (1.0f / DM) + EPS);
        GAS v2u* o = (GAS v2u*)(F_H + (size_t)m * DM);
#pragma unroll
        for (int j = 0; j < 4; ++j) { const int col = 4 * F.lane + 256 * j;
            const f32x4 g = *(const GAS f32x4*)(F_norm_mix_g + col), sh = *(const GAS f32x4*)(mod + col), sc = *(const GAS f32x4*)(mod + DM + col);
            const f32x4 h = v[j] * rstd * g * (1.0f + sc) + sh;
            v2u w; w.x = pk2(h.x, h.y); w.y = pk2(h.z, h.w); o[F.lane + 64 * j] = w; }
    }
}

struct InProjOrder {
    int vcu, G; const char *H, *WIN;
    __device__ __forceinline__ bool next(int i, pg8::Unit& u) const {
        const size_t tstep = (size_t)256 * DM * 2;
        int pm, pn, kind;
        if (G == 256) {
            const int x = vcu >> 5, s = vcu & 31;
            if (i < 2) { pm = 32 * i + 4 * x + (s & 3); pn = s >> 2; kind = pn < 4 ? 0 : (pn < 6 ? 1 : 2); }
            else if (i == 2) {
                if (s < 16) { kind = 3; pm = s & 1; pn = 8 * x + (s >> 1); }
                else if (s == 16) { if (x < 4) { kind = 3; pm = x & 1; pn = 64 + (x >> 1); } else { kind = 2; pm = 64 + ((x - 4) >> 1); pn = 6 + ((x - 4) & 1); } }
                else return false;
            } else return false;
        } else {
            const int L = i * G + vcu;
            if (L < 512) { pm = L >> 3; pn = L & 7; kind = pn < 4 ? 0 : (pn < 6 ? 1 : 2); }
            else if (L < 516) { kind = 2; pm = 64 + ((L - 512) >> 1); pn = 6 + ((L - 512) & 1); }
            else if (L < 648) { kind = 3; pm = (L - 516) & 1; pn = (L - 516) >> 1; }
            else return false;
        }
        u.pm = pm; u.pn = pn; u.kind = kind;
        if (kind == 3) { u.A = WIN + (size_t)(8 + pm) * tstep; u.B = H + (size_t)pn * tstep; }
        else { u.A = H + (size_t)pm * tstep; u.B = WIN + (size_t)pn * tstep; }
        return true;
    }
};
struct EpiInProj {
    static constexpr bool PERM = true;
    bf16 *U, *Q, *Kb, *Vt; float qscale;
    __device__ __forceinline__ void operator()(const pg8::f32x4 (&acc)[2][2][4][2], const pg8::Unit& u, int wr, int wc, int fr, int fq) const {
        const int row0 = u.pm * 256 + wr * 64 + fr;
        if (u.kind == 0) {
            const int col0 = u.pn * 128 + wc * 32 + 8 * fq;
#pragma unroll
            for (int ai = 0; ai < 2; ++ai)
#pragma unroll
                for (int m = 0; m < 4; ++m) {
                    float v[8];
#pragma unroll
                    for (int n = 0; n < 2; ++n)
#pragma unroll
                        for (int i = 0; i < 4; ++i) v[4 * n + i] = acc[ai][0][m][n][i] * fast_sigmoid(acc[ai][1][m][n][i]);
                    v4u w; w.x = pg8::cvt_pk_bf16(v[0], v[1]); w.y = pg8::cvt_pk_bf16(v[2], v[3]); w.z = pg8::cvt_pk_bf16(v[4], v[5]); w.w = pg8::cvt_pk_bf16(v[6], v[7]);
                    *(v4u*)(U + (size_t)(row0 + ai * 128 + m * 16) * CONVC + col0) = w; }
        } else {
            bf16* base; int ldc, colt; float sc = 1.f;
            if (u.kind == 1) { base = Q; ldc = ATTW; colt = (u.pn - 4) * 256; sc = qscale; }
            else if (u.kind == 2) { base = Kb; ldc = ATTW; colt = (u.pn - 6) * 256; }
            else { base = Vt; ldc = MALL; colt = u.pn * 256; }
            const int col0 = colt + wc * 32 + 8 * fq;
#pragma unroll
            for (int ai = 0; ai < 2; ++ai)
#pragma unroll
                for (int m = 0; m < 4; ++m) { bf16* rowp = base + (size_t)(row0 + ai * 128 + m * 16) * ldc + col0;
#pragma unroll
                    for (int bj = 0; bj < 2; ++bj) { const pg8::f32x4 v0 = acc[ai][bj][m][0] * sc, v1 = acc[ai][bj][m][1] * sc;
                        v4u w; w.x = pg8::cvt_pk_bf16(v0[0], v0[1]); w.y = pg8::cvt_pk_bf16(v0[2], v0[3]); w.z = pg8::cvt_pk_bf16(v1[0], v1[1]); w.w = pg8::cvt_pk_bf16(v1[2], v1[3]);
                        *(v4u*)(rowp + bj * 128) = w; } }
        }
    }
};

constexpr int P3_Y_OFF = 0;
constexpr int P3_BIAS_OFF = MISC_OFF + 128;
constexpr float ATT_THR = 8.0f;

__device__ __forceinline__ void attn_wave(Frame& F, int b, int r) {
    const int lane = F.lane, head = F.wave, q32 = lane & 31, hh = lane >> 5;
    const LAS float* bt = (const LAS float*)(F.lds + P3_BIAS_OFF) + head * 15 * 32;
    const int tok0 = b * SEQ + r * 64;
    bf16x8 Bq[2][4];
#pragma unroll
    for (int qt = 0; qt < 2; ++qt)
#pragma unroll
        for (int ds = 0; ds < 4; ++ds) Bq[qt][ds] = *(const GAS bf16x8*)(F_Q + (size_t)(tok0 + 32 * qt + q32) * ATTW + head * HD + 16 * ds + 8 * hh);
    f32x16 O[2][2];
#pragma unroll
    for (int a = 0; a < 2; ++a)
#pragma unroll
        for (int c = 0; c < 2; ++c)
#pragma unroll
            for (int i = 0; i < 16; ++i) O[a][c][i] = 0.f;
    float mref[2] = {-1e30f, -1e30f}, lsum[2] = {0.f, 0.f};
    const int pi = (q32 & 0x13) | ((q32 & 4) << 1) | ((q32 & 8) >> 1);
    int r0 = r - 4; r0 = r0 < 0 ? 0 : (r0 > GROWS - 8 ? GROWS - 8 : r0);
    const bf16* Kh = F_K + head * HD + 8 * hh;
    const bf16* Vh = F_VT + (size_t)(head * HD + q32) * MALL + 8 * hh;
    for (int t = 0; t < 24; ++t) {
        int ktok0, drow = 0, half = 0; const bool local = t >= 8;
        if (!local) ktok0 = MTOK + b * CTXL + 32 * t;
        else { const int j = (t - 8) >> 1; half = (t - 8) & 1; const int kr = r0 + j; drow = kr - r + 7; ktok0 = b * SEQ + kr * 64 + 32 * half; }
        bf16x8 Ak[4], Av[2][2];
#pragma unroll
        for (int ds = 0; ds < 4; ++ds) Ak[ds] = *(const GAS bf16x8*)(Kh + (size_t)(ktok0 + pi) * ATTW + 16 * ds);
#pragma unroll
        for (int dt = 0; dt < 2; ++dt)
#pragma unroll
            for (int s = 0; s < 2; ++s) Av[dt][s] = *(const GAS bf16x8*)(Vh + (size_t)(32 * dt) * MALL + ktok0 + 16 * s);
        f32x16 S[2];
        if (local) {
#pragma unroll
            for (int qt = 0; qt < 2; ++qt) { const int qc = 32 * qt + q32; int c0 = qc - 8; c0 = c0 < 0 ? 0 : (c0 > 48 ? 48 : c0);
#pragma unroll
                for (int rr = 0; rr < 16; ++rr) { const int kc = 32 * half + 16 * (rr >> 3) + 8 * hh + (rr & 7); const bool valid = (kc >= c0) && (kc < c0 + 16);
                    int delta = kc - qc + 15; delta = valid ? delta : 0;
                    const float bv = bt[drow * 32 + delta]; S[qt][rr] = valid ? bv : -1e30f; } }
        } else {
#pragma unroll
            for (int qt = 0; qt < 2; ++qt)
#pragma unroll
                for (int rr = 0; rr < 16; ++rr) S[qt][rr] = 0.f;
        }
#pragma unroll
        for (int qt = 0; qt < 2; ++qt)
#pragma unroll
            for (int ds = 0; ds < 4; ++ds) S[qt] = __builtin_amdgcn_mfma_f32_32x32x16_bf16(Ak[ds], Bq[qt][ds], S[qt], 0, 0, 0);
#pragma unroll
        for (int qt = 0; qt < 2; ++qt) {
            float tm = S[qt][0];
#pragma unroll
            for (int rr = 1; rr < 16; ++rr) tm = fmaxf(tm, S[qt][rr]);
            tm = fmaxf(tm, __shfl_xor(tm, 32));
            if (__any(tm > mref[qt] + ATT_THR)) {
                const float mn = fmaxf(mref[qt], tm), sc = __builtin_amdgcn_exp2f(mref[qt] - mn);
                mref[qt] = mn; lsum[qt] *= sc;
#pragma unroll
                for (int i = 0; i < 16; ++i) { O[0][qt][i] *= sc; O[1][qt][i] *= sc; }
            }
            float p[16]; float ps = 0.f;
#pragma unroll
            for (int rr = 0; rr < 16; ++rr) { p[rr] = __builtin_amdgcn_exp2f(S[qt][rr] - mref[qt]); ps += p[rr]; }
            lsum[qt] += ps;
            bf16x8 Bp[2];
#pragma unroll
            for (int s = 0; s < 2; ++s) { v4u w; w.x = pg8::cvt_pk_bf16(p[8 * s + 0], p[8 * s + 1]); w.y = pg8::cvt_pk_bf16(p[8 * s + 2], p[8 * s + 3]); w.z = pg8::cvt_pk_bf16(p[8 * s + 4], p[8 * s + 5]); w.w = pg8::cvt_pk_bf16(p[8 * s + 6], p[8 * s + 7]);
                Bp[s] = __builtin_bit_cast(bf16x8, w); }
#pragma unroll
            for (int dt = 0; dt < 2; ++dt)
#pragma unroll
                for (int s = 0; s < 2; ++s) O[dt][qt] = __builtin_amdgcn_mfma_f32_32x32x16_bf16(Av[dt][s], Bp[s], O[dt][qt], 0, 0, 0);
        }
    }
#pragma unroll
    for (int qt = 0; qt < 2; ++qt) {
        const float lt = lsum[qt] + __shfl_xor(lsum[qt], 32), inv = 1.0f / lt;
        bf16* orow = F_MIX + (size_t)(tok0 + 32 * qt + q32) * DM + CONVC + head * HD + 4 * hh;
#pragma unroll
        for (int dt = 0; dt < 2; ++dt)
#pragma unroll
            for (int g4 = 0; g4 < 4; ++g4) { v2u w; w.x = pg8::cvt_pk_bf16(O[dt][qt][4 * g4 + 0] * inv, O[dt][qt][4 * g4 + 1] * inv); w.y = pg8::cvt_pk_bf16(O[dt][qt][4 * g4 + 2] * inv, O[dt][qt][4 * g4 + 3] * inv);
                *(GAS v2u*)(orow + 32 * dt + 8 * g4) = w; }
    }
}

typedef float f32x2 __attribute__((ext_vector_type(2)));
__device__ __forceinline__ void conv_unit(Frame& F, int b, int r) {
    const int lane = F.lane, w = F.wave;
    const int cp = F.tid & 255, th = F.tid >> 8;
    LAS float* yb = (LAS float*)(F.lds + P3_Y_OFF);
    const float *cw = F_conv_w, *cb = F_conv_b, *lg = F_conv_ln_g, *lb = F_conv_ln_b;
    asm volatile("" : "+s"(cw), "+s"(cb), "+s"(lg), "+s"(lb));
    {
        const int t0 = r * 64 + 32 * th - 15;
        f32x2 in[62];
        const bf16* up = F_U + (size_t)b * SEQ * CONVC + 2 * cp;
#pragma unroll
        for (int k = 0; k < 62; ++k) { const int tt = t0 + k; unsigned wv = 0u; if (tt >= 0 && tt < SEQ) wv = *(const GAS unsigned*)(up + (size_t)tt * CONVC); in[k] = (f32x2){bf_lo(wv), bf_hi(wv)}; }
        f32x2 wj[CONVW];
#pragma unroll
        for (int j = 0; j < CONVW; ++j) wj[j] = *(const GAS f32x2*)(cw + j * CONVC + 2 * cp);
        const f32x2 bias = *(const GAS f32x2*)(cb + 2 * cp);
#pragma unroll
        for (int t = 0; t < 32; ++t) { f32x2 a = bias;
#pragma unroll
            for (int j = 0; j < CONVW; ++j) a = wj[j] * in[t + j] + a;
            *(LAS f32x2*)(yb + (32 * th + t) * CONVC + 2 * cp) = a; }
    }
    __syncthreads();
    const f32x4 g0 = *(const GAS f32x4*)(lg + 8 * lane), g1 = *(const GAS f32x4*)(lg + 8 * lane + 4);
    const f32x4 b0 = *(const GAS f32x4*)(lb + 8 * lane), b1 = *(const GAS f32x4*)(lb + 8 * lane + 4);
#pragma unroll 2
    for (int k = 0; k < 8; ++k) { const int tk = 8 * w + k;
        f32x4 y0 = *(const LAS f32x4*)(yb + tk * CONVC + 8 * lane), y1 = *(const LAS f32x4*)(yb + tk * CONVC + 8 * lane + 4);
        const float s = wave_sum((y0.x + y0.y) + (y0.z + y0.w) + (y1.x + y1.y) + (y1.z + y1.w));
        const float mean = s * (1.0f / CONVC);
        y0 = y0 - mean; y1 = y1 - mean;
        const float q = wave_sum((y0.x * y0.x + y0.y * y0.y) + (y0.z * y0.z + y0.w * y0.w) + (y1.x * y1.x + y1.y * y1.y) + (y1.z * y1.z + y1.w * y1.w));
        const float rstd = 1.0f / sqrtf(q * (1.0f / CONVC) + EPS);
        y0 = y0 * rstd * g0 + b0; y1 = y1 * rstd * g1 + b1;
        v4u wv; wv.x = pk2(y0.x * fast_sigmoid(y0.x), y0.y * fast_sigmoid(y0.y)); wv.y = pk2(y0.z * fast_sigmoid(y0.z), y0.w * fast_sigmoid(y0.w));
        wv.z = pk2(y1.x * fast_sigmoid(y1.x), y1.y * fast_sigmoid(y1.y)); wv.w = pk2(y1.z * fast_sigmoid(y1.z), y1.w * fast_sigmoid(y1.w));
        *(GAS v4u*)(F_MIX + (size_t)(b * SEQ + r * 64 + tk) * DM + 8 * lane) = wv; }
    __syncthreads();
}

__device__ __forceinline__ void p3_mixers(Frame& F) {
    LAS float* bt = (LAS float*)(F.lds + P3_BIAS_OFF);
    for (int i = F.tid; i < NHEADS * 15 * 32; i += NWAVES * 64) { const int c = i & 31, hr = i >> 5; bt[i] = (c < 31) ? F_rpb[hr * 31 + c] * LOG2E : 0.f; }
    __syncthreads();
    for (int u = F.vcu; u < NB * GROWS; u += F.G) {
        const int b = u / GROWS, r = u % GROWS;
#ifndef PROBE_ATTN
#define PROBE_ATTN 1
#endif
#ifndef PROBE_CONV
#define PROBE_CONV 1
#endif
#pragma unroll 1
        for (int rp = 0; rp < PROBE_ATTN; ++rp) attn_wave(F, b, r);
        asm volatile("" ::: "memory"); __builtin_amdgcn_sched_barrier(0); __syncthreads(); asm volatile("" ::: "memory");
#pragma unroll 1
        for (int rp = 0; rp < PROBE_CONV; ++rp) conv_unit(F, b, r);
    }
}

struct OutProjOrder {
    int vcu, G; const char *MIX, *WOUT;
    __device__ __forceinline__ bool next(int i, pg8::Unit& u) const {
        const size_t tstep = (size_t)256 * DM * 2;
        int pm, pn;
        if (G == 256) { if (i > 0) return false; const int x = vcu >> 5, s = vcu & 31; pm = 8 * x + (s & 7); pn = s >> 3; }
        else { const int L = i * G + vcu; if (L >= 256) return false; pm = L >> 2; pn = L & 3; }
        u.pm = pm; u.pn = pn; u.kind = 0; u.A = MIX + (size_t)pm * tstep; u.B = WOUT + (size_t)pn * tstep; return true;
    }
};
struct EpiOutProj {
    static constexpr bool PERM = false;
    const float* x; const float* MOD; float* X1;
    __device__ __forceinline__ void operator()(const pg8::f32x4 (&acc)[2][2][4][2], const pg8::Unit& u, int wr, int wc, int fr, int fq) const {
        const int row0 = u.pm * 256 + wr * 64 + fr, col0 = u.pn * 256 + wc * 32 + 4 * fq;
        const float* g1 = MOD + (size_t)(u.pm >> 5) * NMODV + 2 * DM;
        pg8::f32x4 gv[2][2];
#pragma unroll
        for (int bj = 0; bj < 2; ++bj)
#pragma unroll
            for (int n = 0; n < 2; ++n) gv[bj][n] = *(const pg8::f32x4*)(g1 + col0 + bj * 128 + n * 16);
#pragma unroll
        for (int ai = 0; ai < 2; ++ai)
#pragma unroll
            for (int m = 0; m < 4; ++m) { const size_t off = (size_t)(row0 + ai * 128 + m * 16) * DM + col0;
#pragma unroll
                for (int bj = 0; bj < 2; ++bj)
#pragma unroll
                    for (int n = 0; n < 2; ++n) { const pg8::f32x4 xv = *(const pg8::f32x4*)(x + off + bj * 128 + n * 16);
                        *(pg8::f32x4*)(X1 + off + bj * 128 + n * 16) = xv + gv[bj][n] * acc[ai][bj][m][n]; } }
    }
};

__device__ __forceinline__ void p5_router(Frame& F) {
    LAS f32x4* wl = (LAS f32x4*)(F.lds + RING_OFF);
    for (int idx = F.tid; idx < DM * 4; idx += NWAVES * 64) { const int c = idx >> 2, q = idx & 3; const f32x4 v = *(const GAS f32x4*)(F_w_router + c * NEXP + 4 * q);
        const int j = c >> 8, l = (c & 255) >> 2, i = c & 3; wl[((j * 4 + i) * 4 + q) * 64 + l] = v; }
    __syncthreads();
    const int gw = F.vcu * NWAVES + F.wave, NGW = F.G * NWAVES, lane = F.lane;
    for (int qd = gw; qd < MTOK / 4; qd += NGW) {
        const int m0 = 4 * qd, b = m0 >> 13;
        const float* mod = F_MOD + (size_t)b * NMODV;
        f32x4 v[4][4];
#pragma unroll
        for (int tk = 0; tk < 4; ++tk)
#pragma unroll
            for (int j = 0; j < 4; ++j) v[tk][j] = *(const GAS f32x4*)(F_X1 + (size_t)(m0 + tk) * DM + 4 * lane + 256 * j);
        float rstd[4];
#pragma unroll
        for (int tk = 0; tk < 4; ++tk) { float ss = 0.f;
#pragma unroll
            for (int j = 0; j < 4; ++j) ss += (v[tk][j].x * v[tk][j].x + v[tk][j].y * v[tk][j].y) + (v[tk][j].z * v[tk][j].z + v[tk][j].w * v[tk][j].w);
            rstd[tk] = 1.0f / sqrtf(wave_sum(ss) * (1.0f / DM) + EPS); }
        float lg[64];
#pragma unroll
        for (int e = 0; e < 64; ++e) lg[e] = 0.f;
#pragma unroll
        for (int j = 0; j < 4; ++j) { const int col = 4 * lane + 256 * j;
            const f32x4 g = *(const GAS f32x4*)(F_norm_ffn_g + col), sh = *(const GAS f32x4*)(mod + 3 * DM + col), sc = *(const GAS f32x4*)(mod + 4 * DM + col);
            const f32x4 gs = g * (1.0f + sc);
#pragma unroll
            for (int tk = 0; tk < 4; ++tk) { v[tk][j] = v[tk][j] * rstd[tk] * gs + sh;
                v2u w; w.x = pk2(v[tk][j].x, v[tk][j].y); w.y = pk2(v[tk][j].z, v[tk][j].w); ((GAS v2u*)(F_H2 + (size_t)(m0 + tk) * DM))[lane + 64 * j] = w; }
#pragma unroll
            for (int i = 0; i < 4; ++i) {
#pragma unroll
                for (int q = 0; q < 4; ++q) { const f32x4 wv = wl[((j * 4 + i) * 4 + q) * 64 + lane];
#pragma unroll
                    for (int tk = 0; tk < 4; ++tk) { const float hv = v[tk][j][i];
                        lg[tk * 16 + 4 * q + 0] += hv * wv.x; lg[tk * 16 + 4 * q + 1] += hv * wv.y; lg[tk * 16 + 4 * q + 2] += hv * wv.z; lg[tk * 16 + 4 * q + 3] += hv * wv.w; } }
                __builtin_amdgcn_sched_barrier(0); } }
#pragma unroll
        for (int w = 32; w >= 1; w >>= 1) {
#pragma unroll
            for (int i = 0; i < w; ++i) { const bool up = (lane & w) != 0; const float send = up ? lg[i] : lg[i + w], keep = up ? lg[i + w] : lg[i]; lg[i] = keep + __shfl_xor(send, w); } }
        const float logit = lg[0];
        const float mx = row16_max(logit), p = __expf(logit - mx), den = row16_sum(p);
        const int tk = lane >> 4, e = lane & 15, t = (m0 + tk) & (SEQ - 1);
        F_AFF[(size_t)(b * NEXP + e) * SEQ + t] = p / den;
    }
}

__device__ __forceinline__ int block_excl_scan(int v, LAS int* sc, int tid, int lane, int wave, int& total) {
    int inc = v;
#pragma unroll
    for (int o = 1; o < 64; o <<= 1) { const int t = __shfl_up(inc, o); if (lane >= o) inc += t; }
    __syncthreads();
    if (lane == 63) sc[wave] = inc;
    __syncthreads();
    int base = 0, tot = 0;
#pragma unroll
    for (int w = 0; w < 8; ++w) { const int c = sc[w]; if (w < wave) base += c; tot += c; }
    total = tot;
    return base + inc - v;
}
__device__ __forceinline__ void p6_topk(Frame& F) {
    LAS int* hist = (LAS int*)(F.lds + RING_OFF);
    LAS int* sel = hist + 256;
    LAS int* sc = hist + 264;
    for (int be = blockIdx.x; be < NB * NEXP; be += F.G) {
        const int b = be >> 4, e = be & 15;
        const float* a = F_AFF + (size_t)be * SEQ + 16 * F.tid;
        unsigned v[16];
#pragma unroll
        for (int j = 0; j < 4; ++j) { const v4u q = *(const GAS v4u*)(a + 4 * j); v[4 * j] = q.x; v[4 * j + 1] = q.y; v[4 * j + 2] = q.z; v[4 * j + 3] = q.w; }
        unsigned prefix = 0u, mask = 0u; int kk = CAP;
#pragma unroll 1
        for (int pass = 0; pass < 4; ++pass) { const int shift = 24 - 8 * pass;
            __syncthreads();
            if (F.tid < 256) hist[F.tid] = 0;
            __syncthreads();
#pragma unroll
            for (int j = 0; j < 16; ++j) if ((v[j] & mask) == prefix) __hip_atomic_fetch_add(&hist[(v[j] >> shift) & 255u], 1, __ATOMIC_RELAXED, __HIP_MEMORY_SCOPE_WORKGROUP);
            __syncthreads();
            if (F.wave == 0) {
                int c[4]; int s4 = 0;
#pragma unroll
                for (int j = 0; j < 4; ++j) { c[j] = hist[4 * F.lane + j]; s4 += c[j]; }
                int suf = s4;
#pragma unroll
                for (int o = 1; o < 64; o <<= 1) { const int t = __shfl_down(suf, o); if (F.lane + o < 64) suf += t; }
                int above = suf - s4;
#pragma unroll
                for (int j = 3; j >= 0; --j) { if (above < kk && kk <= above + c[j]) { sel[0] = 4 * F.lane + j; sel[1] = kk - above; } above += c[j]; }
            }
            __syncthreads();
            prefix |= (unsigned)sel[0] << shift; mask |= 255u << shift; kk = sel[1];
        }
        const unsigned T = prefix; const int need_eq = kk;
        int ceq = 0;
#pragma unroll
        for (int j = 0; j < 16; ++j) ceq += (v[j] == T) ? 1 : 0;
        int tot; int eqb = block_excl_scan(ceq, sc, F.tid, F.lane, F.wave, tot);
        unsigned selm = 0u; int csel = 0;
#pragma unroll
        for (int j = 0; j < 16; ++j) { bool s = v[j] > T; if (v[j] == T) { s = eqb < need_eq; ++eqb; } if (s) { selm |= 1u << j; ++csel; } }
        int slot = block_excl_scan(csel, sc, F.tid, F.lane, F.wave, tot);
        const int obase = (e * 2 + b) * CAP;
        int iv[16];
#pragma unroll
        for (int j = 0; j < 16; ++j) { const bool s = (selm >> j) & 1u; iv[j] = s ? slot : -1;
            if (s) { F_TOK[obase + slot] = 16 * F.tid + j; F_WTS[obase + slot] = __builtin_bit_cast(float, v[j]); ++slot; } }
        int* ip = F_INV + (size_t)be * SEQ + 16 * F.tid;
#pragma unroll
        for (int j = 0; j < 4; ++j) *(GAS v4u*)(ip + 4 * j) = (v4u){(unsigned)iv[4 * j], (unsigned)iv[4 * j + 1], (unsigned)iv[4 * j + 2], (unsigned)iv[4 * j + 3]};
        __syncthreads();
    }
}

struct GateUpOrder {
    int vcu, G; const char *H2, *WGU; const int* TOK;
    __device__ __forceinline__ bool next(int i, pg8::Unit& u) const {
        int e, pml, pn;
        if (G == 256) { if (i >= 8) return false; const int x = vcu >> 5, s = vcu & 31; e = 2 * x + (i >> 2); pml = s & 7; pn = 4 * (i & 3) + (s >> 3); }
        else { const int L = i * G + vcu; if (L >= 2048) return false; e = L >> 7; pml = L & 7; pn = (L >> 3) & 15; }
        u.pm = e * 8 + pml; u.pn = pn; u.kind = 0;
        u.A = H2; u.B = WGU + ((size_t)e * 2 * DEXP + (size_t)pn * 256) * DM * 2; return true;
    }
    __device__ __forceinline__ const int* rows(const pg8::Unit& u) const { return TOK + u.pm * 256; }
    __device__ __forceinline__ int row_base(const pg8::Unit& u) const { return ((u.pm >> 2) & 1) * SEQ; }
};
struct EpiSwiGLU {
    static constexpr bool PERM = true;
    bf16* HID;
    __device__ __forceinline__ void operator()(const pg8::f32x4 (&acc)[2][2][4][2], const pg8::Unit& u, int wr, int wc, int fr, int fq) const {
        const int row0 = u.pm * 256 + wr * 64 + fr, col0 = u.pn * 128 + wc * 32 + 8 * fq;
#pragma unroll
        for (int ai = 0; ai < 2; ++ai)
#pragma unroll
            for (int m = 0; m < 4; ++m) {
                float v[8];
#pragma unroll
                for (int n = 0; n < 2; ++n)
#pragma unroll
                    for (int i = 0; i < 4; ++i) { const float g = acc[ai][0][m][n][i]; v[4 * n + i] = g * fast_sigmoid(g) * acc[ai][1][m][n][i]; }
                v4u w; w.x = pg8::cvt_pk_bf16(v[0], v[1]); w.y = pg8::cvt_pk_bf16(v[2], v[3]); w.z = pg8::cvt_pk_bf16(v[4], v[5]); w.w = pg8::cvt_pk_bf16(v[6], v[7]);
                *(v4u*)(HID + (size_t)(row0 + ai * 128 + m * 16) * DEXP + col0) = w; }
    }
};
struct DownOrder {
    int vcu, G; const char *HID, *WD;
    __device__ __forceinline__ bool next(int i, pg8::Unit& u) const {
        int e, pml, pn;
        if (G == 256) { if (i >= 2) return false; const int x = vcu >> 5, s = vcu & 31; e = 2 * x + i; pml = s & 7; pn = s >> 3; }
        else { const int L = i * G + vcu; if (L >= 512) return false; e = L >> 5; pml = L & 7; pn = (L >> 3) & 3; }
        u.pm = e * 8 + pml; u.pn = pn; u.kind = 0;
        u.A = HID + (size_t)u.pm * 256 * DEXP * 2; u.B = WD + ((size_t)e * DM + (size_t)pn * 256) * DEXP * 2; return true;
    }
};
struct EpiDown {
    static constexpr bool PERM = true;
    bf16* YS; const float* WTS;
    __device__ __forceinline__ void operator()(const pg8::f32x4 (&acc)[2][2][4][2], const pg8::Unit& u, int wr, int wc, int fr, int fq) const {
        const int row0 = u.pm * 256 + wr * 64 + fr, col0 = u.pn * 256 + wc * 32 + 8 * fq;
#pragma unroll
        for (int ai = 0; ai < 2; ++ai)
#pragma unroll
            for (int m = 0; m < 4; ++m) { const int row = row0 + ai * 128 + m * 16; const float wt = WTS[row]; bf16* rowp = YS + (size_t)row * DM + col0;
#pragma unroll
                for (int bj = 0; bj < 2; ++bj) { const pg8::f32x4 v0 = acc[ai][bj][m][0] * wt, v1 = acc[ai][bj][m][1] * wt;
                    v4u w; w.x = pg8::cvt_pk_bf16(v0[0], v0[1]); w.y = pg8::cvt_pk_bf16(v0[2], v0[3]); w.z = pg8::cvt_pk_bf16(v1[0], v1[1]); w.w = pg8::cvt_pk_bf16(v1[2], v1[3]);
                    *(v4u*)(rowp + bj * 128) = w; } }
    }
};

__device__ __forceinline__ void p9_final(Frame& F) {
    const int gw = F.vcu * NWAVES + F.wave, NGW = F.G * NWAVES, lane = F.lane, half = lane >> 5, l32 = lane & 31;
    for (int pr = gw; pr < MTOK / 2; pr += NGW) {
        const int m = 2 * pr + half, b = m >> 13, t = m & (SEQ - 1);
        const float* mod = F_MOD + (size_t)b * NMODV;
        int slotv = -1;
        if (l32 < 16) slotv = F_INV[(size_t)(b * NEXP + l32) * SEQ + t];
        f32x4 v[8], sum[8];
#pragma unroll
        for (int j = 0; j < 8; ++j) { v[j] = *(const GAS f32x4*)(F_X1 + (size_t)m * DM + 4 * l32 + 128 * j); sum[j] = (f32x4){0.f, 0.f, 0.f, 0.f}; }
        const unsigned long long bal = __ballot(slotv >= 0);
        unsigned my16 = (unsigned)(bal >> (32 * half)) & 0xffffu;
        const int cnt = __popc(my16), ocnt = __popc((unsigned)(bal >> (32 * (1 - half))) & 0xffffu);
        const int maxcnt = cnt > ocnt ? cnt : ocnt;
        for (int k0 = 0; k0 < maxcnt; k0 += 4) {
            v2u rows[4][8]; bool val[4];
#pragma unroll
            for (int kk = 0; kk < 4; ++kk) { val[kk] = my16 != 0u; const int e = val[kk] ? (__ffs(my16) - 1) : 0; my16 &= my16 - 1u;
                const int sl = __shfl(slotv, 32 * half + e);
                const GAS v2u* yr = (const GAS v2u*)(F_YS + (size_t)((e * 2 + b) * CAP + (sl < 0 ? 0 : sl)) * DM) + l32;
#pragma unroll
                for (int j = 0; j < 8; ++j) rows[kk][j] = val[kk] ? yr[32 * j] : (v2u){0u, 0u}; }
#pragma unroll
            for (int kk = 0; kk < 4; ++kk)
#pragma unroll
                for (int j = 0; j < 8; ++j) { const v2u w = rows[kk][j]; sum[j].x += bf_lo(w.x); sum[j].y += bf_hi(w.x); sum[j].z += bf_lo(w.y); sum[j].w += bf_hi(w.y); }
        }
        float ss = 0.f;
#pragma unroll
        for (int j = 0; j < 8; ++j) { const int col = 4 * l32 + 128 * j; const f32x4 g2 = *(const GAS f32x4*)(mod + 5 * DM + col);
            v[j] = v[j] + g2 * sum[j]; ss += (v[j].x * v[j].x + v[j].y * v[j].y) + (v[j].z * v[j].z + v[j].w * v[j].w); }
        const float rstd = 1.0f / sqrtf(half_sum(ss, half) * (1.0f / DM) + EPS);
#pragma unroll
        for (int j = 0; j < 8; ++j) { const int col = 4 * l32 + 128 * j; const f32x4 g = *(const GAS f32x4*)(F_norm_final_g + col);
            *(GAS f32x4*)(F_out + (size_t)m * DM + col) = v[j] * rstd * g; }
    }
}

__device__ __forceinline__ void p5_router_old(Frame& F) {
    LAS f32x4* wl = (LAS f32x4*)(F.lds + RING_OFF);
    for (int idx = F.tid; idx < DM * 4; idx += NWAVES * 64) { const int c = idx >> 2, q = idx & 3; const f32x4 v = *(const GAS f32x4*)(F_w_router + c * NEXP + 4 * q);
        const int j = c >> 8, l = (c & 255) >> 2, i = c & 3; wl[((j * 4 + i) * 4 + q) * 64 + l] = v; }
    __syncthreads();
    const int gw = F.vcu * NWAVES + F.wave, NGW = F.G * NWAVES;
    for (int m = gw; m < MTOK; m += NGW) {
        const int b = m >> 13, t = m & (SEQ - 1);
        const float* mod = F_MOD + (size_t)b * NMODV;
        f32x4 v[4]; float ss = 0.f;
#pragma unroll
        for (int j = 0; j < 4; ++j) { v[j] = *(const GAS f32x4*)(F_X1 + (size_t)m * DM + 4 * F.lane + 256 * j); ss += (v[j].x * v[j].x + v[j].y * v[j].y) + (v[j].z * v[j].z + v[j].w * v[j].w); }
        const float rstd = 1.0f / sqrtf(wave_sum(ss) * (1.0f / DM) + EPS);
        GAS v2u* o = (GAS v2u*)(F_H2 + (size_t)m * DM);
        float lg[16];
#pragma unroll
        for (int e = 0; e < 16; ++e) lg[e] = 0.f;
#pragma unroll
        for (int j = 0; j < 4; ++j) { const int col = 4 * F.lane + 256 * j;
            const f32x4 g = *(const GAS f32x4*)(F_norm_ffn_g + col), sh = *(const GAS f32x4*)(mod + 3 * DM + col), sc = *(const GAS f32x4*)(mod + 4 * DM + col);
            const f32x4 h = v[j] * rstd * g * (1.0f + sc) + sh;
            v2u w; w.x = pk2(h.x, h.y); w.y = pk2(h.z, h.w); o[F.lane + 64 * j] = w;
#pragma unroll
            for (int i = 0; i < 4; ++i) {
#pragma unroll
                for (int q = 0; q < 4; ++q) { const f32x4 wv = wl[((j * 4 + i) * 4 + q) * 64 + F.lane];
                    lg[4 * q + 0] += h[i] * wv.x; lg[4 * q + 1] += h[i] * wv.y; lg[4 * q + 2] += h[i] * wv.z; lg[4 * q + 3] += h[i] * wv.w; }
                __builtin_amdgcn_sched_barrier(0); } }
        float mx = -1e30f;
#pragma unroll
        for (int e = 0; e < 16; ++e) { lg[e] = wave_sum(lg[e]); mx = fmaxf(mx, lg[e]); }
        float den = 0.f;
#pragma unroll
        for (int e = 0; e < 16; ++e) { lg[e] = __expf(lg[e] - mx); den += lg[e]; }
        float mine = 0.f;
#pragma unroll
        for (int e = 0; e < 16; ++e) mine = (F.lane == e) ? lg[e] : mine;
        if (F.lane < 16) F_AFF[(size_t)(b * NEXP + F.lane) * SEQ + t] = mine / den;
    }
}


__device__ __forceinline__ void p9_final_old(Frame& F) {
    const int gw = F.vcu * NWAVES + F.wave, NGW = F.G * NWAVES;
    for (int m = gw; m < MTOK; m += NGW) {
        const int b = m >> 13, t = m & (SEQ - 1);
        const float* mod = F_MOD + (size_t)b * NMODV;
        int slotv = -1;
        if (F.lane < 16) slotv = F_INV[(size_t)(b * NEXP + F.lane) * SEQ + t];
        f32x4 v[4], sum[4];
#pragma unroll
        for (int j = 0; j < 4; ++j) { v[j] = *(const GAS f32x4*)(F_X1 + (size_t)m * DM + 4 * F.lane + 256 * j); sum[j] = (f32x4){0.f, 0.f, 0.f, 0.f}; }
#pragma unroll
        for (int e = 0; e < 16; ++e) { const int sl = __builtin_amdgcn_readlane(slotv, e);
            if (sl >= 0) { const GAS v2u* yr = (const GAS v2u*)(F_YS + (size_t)((e * 2 + b) * CAP + sl) * DM);
#pragma unroll
                for (int j = 0; j < 4; ++j) { const v2u w = yr[F.lane + 64 * j]; sum[j].x += bf_lo(w.x); sum[j].y += bf_hi(w.x); sum[j].z += bf_lo(w.y); sum[j].w += bf_hi(w.y); } } }
        float ss = 0.f;
#pragma unroll
        for (int j = 0; j < 4; ++j) { const int col = 4 * F.lane + 256 * j; const f32x4 g2 = *(const GAS f32x4*)(mod + 5 * DM + col);
            v[j] = v[j] + g2 * sum[j]; ss += (v[j].x * v[j].x + v[j].y * v[j].y) + (v[j].z * v[j].z + v[j].w * v[j].w); }
        const float rstd = 1.0f / sqrtf(wave_sum(ss) * (1.0f / DM) + EPS);
#pragma unroll
        for (int j = 0; j < 4; ++j) { const int col = 4 * F.lane + 256 * j; const f32x4 g = *(const GAS f32x4*)(F_norm_final_g + col);
            *(GAS f32x4*)(F_out + (size_t)m * DM + col) = v[j] * rstd * g; }
    }
}


constexpr int N_PHASES = 9;
__global__ void __launch_bounds__(NWAVES * 64, 2) mk_fwd(Args args) {
    extern __shared__ __attribute__((aligned(16))) unsigned char lds[];
    Frame F;
    F.lds = (LAS unsigned char*)lds;
    F.MISC = (volatile LAS unsigned*)(F.lds + MISC_OFF);
    F.tid = threadIdx.x; F.lane = F.tid & 63; F.wave = __builtin_amdgcn_readfirstlane(F.tid >> 6);
    F.G = gridDim.x; { const int bx = blockIdx.x; F.vcu = (F.G % 8 == 0) ? (bx % 8) * (F.G / 8) + bx / 8 : bx; }
    F.a = &args;
    gu32* ctl = (gu32*)(args.ws + WS_CTL);
    for (int u = F.tid; u < (MISC_OFF + 128 - LDSCTL_OFF) / 4; u += NWAVES * 64) ((LAS unsigned*)(F.lds + LDSCTL_OFF))[u] = 0u;
    __syncthreads();
    const int lo = args.ph_lo, hi = args.ph_hi;
    const bool multi = (hi - lo) > 1;
    XcdBarrier bar; bar.bar = (unsigned*)(ctl + CW_BAR); bar.x = 0; bar.st = nullptr;
    if (multi) bar = xcd_barrier_post((unsigned*)(ctl + CW_BAR), F.MISC + 8);
#ifndef PH_MASK
#define PH_MASK 0xFFFF
#endif
#define IN(k) ((((PH_MASK) >> (k)) & 1) && lo <= (k) && (k) < hi)
#define SEAM(k) do { if (IN(k) && IN((k) + 1)) xcd_barrier(bar); } while (0)

#ifndef PROBE_REP
#define PROBE_REP 0
#endif
#define NREP(k) (1 + (((PROBE_REP) >> (k)) & 1))
#define PHASE(k, ...) if (IN(k)) { for (int rep_ = 0; rep_ < NREP(k); ++rep_) { __VA_ARGS__; if (rep_ + 1 < NREP(k)) xcd_barrier(bar); } SEAM(k); }
    PHASE(0, p0_prologue(F))
    PHASE(1, p1_hpass(F))
    PHASE(2, { InProjOrder S{F.vcu, F.G, (const char*)F_H, (const char*)F_WIN};
               EpiInProj E{F_U, F_Q, F_K, F_VT, 0.125f * LOG2E};
               pg8::gemm_phase<EpiInProj, InProjOrder>(F.lds + RING_OFF, DM, S, E); })
    PHASE(3, p3_mixers(F))
    PHASE(4, { OutProjOrder S{F.vcu, F.G, (const char*)F_MIX, (const char*)F_WOUT};
               EpiOutProj E{F_x, F_MOD, F_X1};
               pg8::gemm_phase<EpiOutProj, OutProjOrder>(F.lds + RING_OFF, DM, S, E); })
#ifdef OLD_P5
    PHASE(5, p5_router_old(F))
#else
    PHASE(5, p5_router(F))
#endif
    PHASE(6, p6_topk(F))
    PHASE(7, { GateUpOrder S{F.vcu, F.G, (const char*)F_H2, (const char*)F_WGU, F_TOK};
               EpiSwiGLU E{F_HID};
               pg8::gemm_phase<EpiSwiGLU, GateUpOrder, true>(F.lds + RING_OFF, DM, S, E); })
    PHASE(8, { DownOrder S{F.vcu, F.G, (const char*)F_HID, (const char*)F_WD};
               EpiDown E{F_YS, F_WTS};
               pg8::gemm_phase<EpiDown, DownOrder>(F.lds + RING_OFF, DEXP, S, E); })
#ifdef OLD_P9
    PHASE(9, p9_final_old(F))
#else
    PHASE(9, p9_final(F))
#endif
#undef IN
#undef SEAM
}

extern "C" void kernel_launch(void* const* d_in, const int* in_sizes, int n_in, void* d_out, int out_size, void* d_ws, size_t ws_size, hipStream_t stream) {
    static int grid = 0;
    if (grid == 0) {
        if (n_in != 20 || out_size != MTOK * DM || ws_size < WS_END) { fprintf(stderr, "kernel_launch: unexpected shapes (n_in %d out %d ws %zu)\n", n_in, out_size, ws_size); grid = -1; return; }
        int dev = 0, cus = 0, per_cu = 0;
        if (hipGetDevice(&dev) != hipSuccess || hipDeviceGetAttribute(&cus, hipDeviceAttributeMultiprocessorCount, dev) != hipSuccess) { grid = -1; return; }
        if (hipFuncSetAttribute((const void*)mk_fwd, hipFuncAttributeMaxDynamicSharedMemorySize, LDS_BYTES) != hipSuccess) { fprintf(stderr, "kernel_launch: hipFuncSetAttribute failed\n"); grid = -1; return; }
        if (hipOccupancyMaxActiveBlocksPerMultiprocessor(&per_cu, (const void*)mk_fwd, NWAVES * 64, LDS_BYTES) != hipSuccess || per_cu < 1) { fprintf(stderr, "kernel_launch: occupancy query says %d\n", per_cu); per_cu = 1; }
        (void)hipGetLastError();
        grid = cus;
    }
    if (grid < 0) return;
    (void)hipMemsetAsync((char*)d_ws + WS_CTL, 0, CTL_ZERO_BYTES, stream);
    Args a{};
    for (int i = 0; i < 20; ++i) a.in[i] = (const float*)d_in[i];
    a.out = (float*)d_out; a.ws = (unsigned char*)d_ws;
#if MK_ONE_LAUNCH
    a.ph_lo = 0; a.ph_hi = N_PHASES + 1;
    hipLaunchKernelGGL(mk_fwd, dim3(grid), dim3(NWAVES * 64), LDS_BYTES, stream, a);
#else
    for (int p = 0; p <= N_PHASES; ++p) { a.ph_lo = p; a.ph_hi = p + 1; hipLaunchKernelGGL(mk_fwd, dim3(grid), dim3(NWAVES * 64), LDS_BYTES, stream, a); }
#endif
}
```

```cpp
#include <hip/hip_runtime.h>
#include <cstdio>
#include <cstdint>

#ifndef MK_ONE_LAUNCH
#define MK_ONE_LAUNCH 1
#endif

namespace pg8 {
#define PG8_LAS __attribute__((address_space(3)))
typedef unsigned short bf16_t;
typedef short bf16x8 __attribute__((ext_vector_type(8)));
typedef float f32x4 __attribute__((ext_vector_type(4)));
typedef unsigned u32x4 __attribute__((ext_vector_type(4)));
constexpr int BM = 256, BK = 64, HALF = 128, HTB = HALF * BK * 2, STAGE_BYTES = 8 * HTB;
constexpr int GIDX_OFF = 147456;

__host__ __device__ __forceinline__ int lds_byte(int r, int c) { const int st = (r >> 4) * 2 + (c >> 5), rr = r & 15, cc = c & 31, ob = rr * 64 + cc * 2; return st * 1024 + (ob ^ (((ob >> 9) & 1) << 5)); }
__host__ __device__ __forceinline__ void stage_rc(int b, int& R, int& C) { const int st = b / 1024, sb = b % 1024, swz = sb ^ (((sb >> 9) & 1) << 5); R = (st >> 1) * 16 + swz / 64; C = (st & 1) * 32 + (swz % 64) / 2; }
__host__ __device__ __forceinline__ int perm32(int rho) { const int n = rho >> 4, i = rho & 15; return 8 * (i >> 2) + 4 * n + (i & 3); }

struct Unit { int pm, pn, kind; const char* A; const char* B; };

__device__ __forceinline__ unsigned cvt_pk_bf16(float lo, float hi) { unsigned r; asm volatile("v_cvt_pk_bf16_f32 %0, %1, %2" : "=v"(r) : "v"(lo), "v"(hi)); return r; }

template <class Epi, class Sched, bool GATHER = false, bool ALIGN_EPI = true, bool SP2 = true>
__device__ __forceinline__ void gemm_phase(PG8_LAS unsigned char* lds, const int K, const Sched& S, const Epi& E) {
    const int tid = threadIdx.x, wid = __builtin_amdgcn_readfirstlane(tid >> 6), lane = tid & 63, wr = wid >> 2, wc = wid & 3, fr = lane & 15, fq = lane >> 4;
    const int nt = K / BK;
    unsigned voffA[2], voffB[2];
#pragma unroll
    for (int i = 0; i < 2; ++i) { int R, C; stage_rc(tid * 16 + i * 8192, R, C); const int Rb = Epi::PERM ? ((R & ~31) + perm32(R & 31)) : R;
        voffA[i] = (unsigned)(R * K + C) * 2u; voffB[i] = (unsigned)(Rb * K + C) * 2u; }
    const size_t kstep = (size_t)(BK * 2);
    const size_t hstep = (size_t)HALF * K * 2;
    const unsigned ldsw = (unsigned)wid * 1024u;
    const int aoff = lds_byte(wr * 64 + fr, fq * 8), boff = lds_byte(wc * 32 + fr, fq * 8);
#define PG8_SA(b, h) (((b) * 2 + (h)) * HTB)
#define PG8_SB(b, h) ((4 + (b) * 2 + (h)) * HTB)
#define PG8_STAGE(bufoff, gbase, voff) do { _Pragma("unroll") for (int _i = 0; _i < 2; ++_i) \
        __builtin_amdgcn_global_load_lds((const unsigned*)((const char*)(gbase) + (voff)[_i]), (PG8_LAS unsigned*)(lds + (bufoff) + ldsw + _i * 8192), 16, 0, 0); } while (0)
#define PG8_STAGE_A(bufoff, kptr, h, goff) do { _Pragma("unroll") for (int _i = 0; _i < 2; ++_i) \
        __builtin_amdgcn_global_load_lds((const unsigned*)((const char*)(kptr) + (GATHER ? (goff)[h][_i] : (voffA[_i] + (unsigned)((h) * hstep)))), (PG8_LAS unsigned*)(lds + (bufoff) + ldsw + _i * 8192), 16, 0, 0); } while (0)
#define PG8_LDA(dst, b, h) do { _Pragma("unroll") for (int m = 0; m < 4; ++m) _Pragma("unroll") for (int k = 0; k < 2; ++k) dst[m][k] = *(const PG8_LAS bf16x8*)(lds + PG8_SA(b, h) + aoff + m * 2048 + k * 1024); } while (0)
#define PG8_LDB(dst, b, h) do { _Pragma("unroll") for (int n = 0; n < 2; ++n) _Pragma("unroll") for (int k = 0; k < 2; ++k) dst[n][k] = *(const PG8_LAS bf16x8*)(lds + PG8_SB(b, h) + boff + n * 2048 + k * 1024); } while (0)
#define PG8_MMA(ai, bj, At, Bt) do { __builtin_amdgcn_s_setprio(1); _Pragma("unroll") for (int m = 0; m < 4; ++m) _Pragma("unroll") for (int n = 0; n < 2; ++n) _Pragma("unroll") for (int k = 0; k < 2; ++k) \
        acc[ai][bj][m][n] = __builtin_amdgcn_mfma_f32_16x16x32_bf16(Bt[n][k], At[m][k], acc[ai][bj][m][n], 0, 0, 0); __builtin_amdgcn_s_setprio(0); } while (0)
#define PG8_WAIT_V(n) asm volatile("s_waitcnt vmcnt(" #n ")" ::: "memory")
#define PG8_WAIT_L(n) asm volatile("s_waitcnt lgkmcnt(" #n ")" ::: "memory")
#define PG8_BAR __builtin_amdgcn_s_barrier()
#define PG8_SCHED __builtin_amdgcn_sched_barrier(0)
    Unit cur, nxt; int ui = 0;
    if (!S.next(0, cur)) return;
    f32x4 acc[2][2][4][2];
#pragma unroll
    for (int a = 0; a < 2; ++a)
#pragma unroll
        for (int b = 0; b < 2; ++b)
#pragma unroll
            for (int m = 0; m < 4; ++m)
#pragma unroll
                for (int n = 0; n < 2; ++n) acc[a][b][m][n] = (f32x4){0.f, 0.f, 0.f, 0.f};
    bf16x8 At[4][2], B0[2][2], B1[2][2];
    const char* cA = cur.A; const char* cB = cur.B;
    unsigned goffC[2][2] = {{0u, 0u}, {0u, 0u}}, goffN[2][2] = {{0u, 0u}, {0u, 0u}}, goffS[2][2] = {{0u, 0u}, {0u, 0u}};
    int gR[2], gC[2];
#pragma unroll
    for (int i = 0; i < 2; ++i) stage_rc(tid * 16 + i * 8192, gR[i], gC[i]);
    if constexpr (GATHER) {
#pragma unroll
        for (int h = 0; h < 2; ++h)
#pragma unroll
            for (int i = 0; i < 2; ++i) goffC[h][i] = (unsigned)((S.row_base(cur) + S.rows(cur)[h * HALF + gR[i]]) * K + gC[i]) * 2u;
    }
    if constexpr (SP2) {
        PG8_STAGE(PG8_SB(0, 0), cB, voffB); PG8_STAGE(PG8_SB(0, 1), cB + hstep, voffB); PG8_STAGE_A(PG8_SA(0, 0), cA, 0, goffC); PG8_STAGE_A(PG8_SA(0, 1), cA, 1, goffC);
        if (wr == 1) PG8_BAR;
        PG8_WAIT_V(2); PG8_BAR;
        PG8_STAGE(PG8_SB(1, 0), cB + kstep, voffB); PG8_STAGE_A(PG8_SA(1, 0), cA + kstep, 0, goffC); PG8_STAGE(PG8_SB(1, 1), cB + hstep + kstep, voffB);
        PG8_WAIT_V(6); PG8_BAR;
    } else {
        PG8_STAGE(PG8_SB(0, 0), cB, voffB); PG8_STAGE_A(PG8_SA(0, 0), cA, 0, goffC); PG8_STAGE(PG8_SB(0, 1), cB + hstep, voffB); PG8_STAGE_A(PG8_SA(0, 1), cA, 1, goffC);
        if (wr == 1) PG8_BAR;
        PG8_WAIT_V(4); PG8_BAR;
        PG8_STAGE(PG8_SB(1, 0), cB + kstep, voffB); PG8_STAGE_A(PG8_SA(1, 0), cA + kstep, 0, goffC); PG8_STAGE(PG8_SB(1, 1), cB + hstep + kstep, voffB);
        PG8_WAIT_V(6); PG8_BAR;
    }
    for (;;) {
        const bool has_next = S.next(ui + 1, nxt);
        const char* nA = has_next ? nxt.A : cA; const char* nB = has_next ? nxt.B : cB;
        if constexpr (GATHER) {
            if (has_next && wid < 4) __builtin_amdgcn_global_load_lds((const unsigned*)(S.rows(nxt) + tid), (PG8_LAS unsigned*)(lds + GIDX_OFF + ((ui + 1) & 1) * 1024 + wid * 256), 4, 0, 0);
        }
        for (int t = 0; t < nt; t += 2) {
            const bool last = (t == nt - 2);
            const char* a1 = cA + (size_t)(t + 1) * kstep;
            const char* a2 = last ? nA : cA + (size_t)(t + 2) * kstep; const char* b2 = last ? nB : cB + (size_t)(t + 2) * kstep;
            const char* a3 = a2 + kstep; const char* b3 = b2 + kstep;
            if constexpr (GATHER) {
                if (last && has_next) { const PG8_LAS int* mb = (const PG8_LAS int*)(lds + GIDX_OFF + ((ui + 1) & 1) * 1024); const int rb = S.row_base(nxt);
#pragma unroll
                    for (int h = 0; h < 2; ++h)
#pragma unroll
                        for (int i = 0; i < 2; ++i) goffN[h][i] = (unsigned)((rb + mb[h * HALF + gR[i]]) * K + gC[i]) * 2u;
                } else if (last) {
#pragma unroll
                    for (int h = 0; h < 2; ++h)
#pragma unroll
                        for (int i = 0; i < 2; ++i) goffN[h][i] = goffC[h][i];
                }
#pragma unroll
                for (int h = 0; h < 2; ++h)
#pragma unroll
                    for (int i = 0; i < 2; ++i) goffS[h][i] = last ? goffN[h][i] : goffC[h][i];
            }
            if constexpr (SP2) {
            PG8_LDB(B0, 0, 0); PG8_LDB(B1, 0, 1); PG8_SCHED; PG8_LDA(At, 0, 0); PG8_STAGE_A(PG8_SA(1, 1), a1, 1, goffC);
            PG8_WAIT_V(8); PG8_WAIT_L(0); PG8_BAR; PG8_MMA(0, 0, At, B0); PG8_MMA(0, 1, At, B1); PG8_BAR; PG8_SCHED;
            PG8_LDA(At, 0, 1); PG8_STAGE(PG8_SB(0, 0), b2, voffB); PG8_STAGE(PG8_SB(0, 1), b2 + hstep, voffB); PG8_STAGE_A(PG8_SA(0, 0), a2, 0, goffS);
            PG8_WAIT_V(8); PG8_WAIT_L(0); PG8_BAR; PG8_MMA(1, 0, At, B0); PG8_MMA(1, 1, At, B1); PG8_BAR; PG8_SCHED;
            PG8_LDB(B0, 1, 0); PG8_LDB(B1, 1, 1); PG8_SCHED; PG8_LDA(At, 1, 0); PG8_STAGE_A(PG8_SA(0, 1), a2, 1, goffS);
            PG8_WAIT_V(8); PG8_WAIT_L(0); PG8_BAR; PG8_MMA(0, 0, At, B0); PG8_MMA(0, 1, At, B1); PG8_BAR; PG8_SCHED;
            PG8_LDA(At, 1, 1); PG8_STAGE(PG8_SB(1, 0), b3, voffB); PG8_STAGE(PG8_SB(1, 1), b3 + hstep, voffB); PG8_STAGE_A(PG8_SA(1, 0), a3, 0, goffS);
            PG8_WAIT_V(8); PG8_WAIT_L(0); PG8_BAR; PG8_MMA(1, 0, At, B0); PG8_MMA(1, 1, At, B1); PG8_BAR; PG8_SCHED;
            } else {
            PG8_LDB(B0, 0, 0); PG8_SCHED; PG8_LDA(At, 0, 0); PG8_STAGE_A(PG8_SA(1, 1), a1, 1, goffC);
            PG8_WAIT_L(8); PG8_BAR; PG8_WAIT_L(0); PG8_MMA(0, 0, At, B0); PG8_BAR; PG8_SCHED;
            PG8_LDB(B1, 0, 1); PG8_STAGE(PG8_SB(0, 0), b2, voffB);
            PG8_BAR; PG8_WAIT_L(0); PG8_MMA(0, 1, At, B1); PG8_BAR;
            PG8_LDA(At, 0, 1); PG8_STAGE_A(PG8_SA(0, 0), a2, 0, goffS);
            PG8_BAR; PG8_WAIT_L(0); PG8_MMA(1, 0, At, B0); PG8_BAR; PG8_SCHED;
            PG8_STAGE(PG8_SB(0, 1), b2 + hstep, voffB);
            PG8_WAIT_V(6); PG8_BAR; PG8_MMA(1, 1, At, B1); PG8_BAR;
            PG8_LDB(B0, 1, 0); PG8_SCHED; PG8_LDA(At, 1, 0); PG8_STAGE_A(PG8_SA(0, 1), a2, 1, goffS);
            PG8_WAIT_L(8); PG8_BAR; PG8_WAIT_L(0); PG8_MMA(0, 0, At, B0); PG8_BAR; PG8_SCHED;
            PG8_LDB(B1, 1, 1); PG8_STAGE(PG8_SB(1, 0), b3, voffB);
            PG8_BAR; PG8_WAIT_L(0); PG8_MMA(0, 1, At, B1); PG8_BAR;
            PG8_LDA(At, 1, 1); PG8_STAGE_A(PG8_SA(1, 0), a3, 0, goffS);
            PG8_BAR; PG8_WAIT_L(0); PG8_MMA(1, 0, At, B0); PG8_BAR; PG8_SCHED;
            PG8_STAGE(PG8_SB(1, 1), b3 + hstep, voffB);
            PG8_WAIT_V(6); PG8_BAR; PG8_MMA(1, 1, At, B1); PG8_BAR;
            }
        }
        if constexpr (ALIGN_EPI) { if (wr == 0) PG8_BAR; }
        E(acc, cur, wr, wc, fr, fq);
        if (!has_next) break;
#pragma unroll
        for (int a = 0; a < 2; ++a)
#pragma unroll
            for (int b = 0; b < 2; ++b)
#pragma unroll
                for (int m = 0; m < 4; ++m)
#pragma unroll
                    for (int n = 0; n < 2; ++n) acc[a][b][m][n] = (f32x4){0.f, 0.f, 0.f, 0.f};
        cur = nxt; cA = nA; cB = nB; ++ui;
        if constexpr (GATHER) {
#pragma unroll
            for (int h = 0; h < 2; ++h)
#pragma unroll
                for (int i = 0; i < 2; ++i) goffC[h][i] = goffN[h][i];
        }
        if constexpr (ALIGN_EPI) { if (wr == 1) PG8_BAR; }
    }
    PG8_WAIT_V(0);
    if constexpr (!ALIGN_EPI) { if (wr == 0) PG8_BAR; }
    PG8_BAR;
#undef PG8_SA
#undef PG8_SB
#undef PG8_STAGE
#undef PG8_STAGE_A
#undef PG8_LDA
#undef PG8_LDB
#undef PG8_MMA
#undef PG8_WAIT_V
#undef PG8_WAIT_L
#undef PG8_BAR
#undef PG8_SCHED
}
}

constexpr int NWAVES = 8;
constexpr int DM = 1024, NB = 2, SEQ = 8192, MTOK = NB * SEQ;
constexpr int CTXL = 256, MCTX = NB * CTXL, MALL = MTOK + MCTX;
constexpr int NMODV = 6 * DM;
constexpr int CONVC = 512, CONVW = 31, NHEADS = 8, HD = 64, ATTW = 512;
constexpr int NINC = 2560;
constexpr int NEXP = 16, DEXP = 2048, CAP = 1024, MX = NB * NEXP * CAP;
constexpr int GROWS = SEQ / 64;
constexpr float EPS = 1e-6f;
constexpr float LOG2E = 1.4426950408889634f;

constexpr size_t MiB = 1u << 20;
constexpr size_t WS_CTL = 0, CTL_ZERO_BYTES = 1 * MiB;
constexpr size_t WS_MOD = 1 * MiB;
constexpr size_t WS_AFF = 2 * MiB;
constexpr size_t WS_INV = 3 * MiB;
constexpr size_t WS_TOK = 4 * MiB;
constexpr size_t WS_WT = 4 * MiB + 128 * 1024;
constexpr size_t WS_WIN = 5 * MiB;
constexpr size_t WS_WOUT = 10 * MiB;
constexpr size_t WS_WGU = 12 * MiB;
constexpr size_t WS_WD = 140 * MiB;
constexpr size_t WS_X1 = 204 * MiB;
constexpr size_t WS_YS = 268 * MiB;
constexpr size_t WS_XS = 64 * MiB + 0 * MiB + WS_YS - 64 * MiB;
constexpr size_t WS_H = 332 * MiB;
constexpr size_t WS_U = 365 * MiB;
constexpr size_t WS_Q = 381 * MiB;
constexpr size_t WS_K = 397 * MiB;
constexpr size_t WS_VT = WS_K + 16 * MiB + 512 * 1024;
constexpr size_t WS_MIX = 430 * MiB;
constexpr size_t WS_HID = 332 * MiB;
constexpr size_t WS_H2 = 462 * MiB;
constexpr size_t WS_END = 494 * MiB;
static_assert(WS_VT + (size_t)512 * MALL * 2 <= WS_MIX && WS_HID + (size_t)MX * DEXP * 2 <= WS_H2, "ws map");

constexpr int CW_TMO = 0, CW_CODE = 1;
constexpr int CW_BAR = 4096;
constexpr int CW_WQ = 2048;

constexpr int RING_OFF = 0, RING_BYTES = 131072;
constexpr int LDSCTL_OFF = RING_BYTES, MISC_OFF = LDSCTL_OFF + 320;
constexpr int LDS_BYTES = 163840;
static_assert(MISC_OFF + 128 + 8 * 15 * 32 * 4 <= LDS_BYTES, "LDS map");

#define GAS __attribute__((address_space(1)))
#define LAS __attribute__((address_space(3)))
typedef unsigned short bf16;
typedef unsigned v4u __attribute__((ext_vector_type(4)));
typedef unsigned v2u __attribute__((ext_vector_type(2)));
typedef float f32x4 __attribute__((ext_vector_type(4)));
typedef float f32x16 __attribute__((ext_vector_type(16)));
typedef short bf16x8 __attribute__((ext_vector_type(8)));
typedef GAS unsigned gu32;
#define RLX_AGENT __ATOMIC_RELAXED, __HIP_MEMORY_SCOPE_AGENT
#define LDS_WAIT() asm volatile("s_waitcnt lgkmcnt(0)" ::: "memory")
#define VM_WAIT() asm volatile("s_waitcnt vmcnt(0)" ::: "memory")
__device__ __forceinline__ unsigned f2bf(float f) { unsigned u = __builtin_bit_cast(unsigned, f); return (u + 0x7fffu + ((u >> 16) & 1u)) >> 16; }
__device__ __forceinline__ unsigned pk2(float lo, float hi) { return f2bf(lo) | (f2bf(hi) << 16); }
__device__ __forceinline__ float bf_lo(unsigned w) { return __builtin_bit_cast(float, w << 16); }
__device__ __forceinline__ float bf_hi(unsigned w) { return __builtin_bit_cast(float, w & 0xffff0000u); }
__device__ __forceinline__ float fast_sigmoid(float x) { return __builtin_amdgcn_rcpf(1.0f + __builtin_amdgcn_exp2f(-x * LOG2E)); }

#define XB_TMO      128
#define XB_XCNT(j)  (256  + 64 * (j))
#define XB_XSUB(j)  (1280 + 64 * (j))
#define XB_XGEN(j)  (2304 + 64 * (j))
#define XB_TOP      3328
#define XB_TOPGEN   3392
#define XCD_BAR_WORDS 3456
#define XB_SPIN_CAP (1u << 18)
__device__ __forceinline__ unsigned xb_ld(unsigned* p)              { return __hip_atomic_load(p, __ATOMIC_RELAXED, __HIP_MEMORY_SCOPE_AGENT); }
__device__ __forceinline__ unsigned xb_add(unsigned* p, unsigned v) { return __hip_atomic_fetch_add(p, v, __ATOMIC_RELAXED, __HIP_MEMORY_SCOPE_AGENT); }
__device__ __forceinline__ unsigned xb_xcc_id() { return (unsigned)__builtin_amdgcn_s_getreg((3 << 11) | 20) & 0xFu; }
#define XB_SPIN(cond, bar) do { unsigned _sp = 0; while (cond) { __builtin_amdgcn_s_sleep(1); \
    if ((++_sp & 255u) == 0u) { if (xb_ld(&(bar)[XB_TMO])) break; if (_sp > XB_SPIN_CAP) { atomicAdd(&(bar)[XB_TMO], 1u); break; } } } } while (0)
struct XcdBarrier { unsigned* bar; unsigned x; volatile LAS unsigned* st; };
__device__ __forceinline__ XcdBarrier xcd_barrier_post(unsigned* bar, volatile LAS unsigned* st) {
    XcdBarrier b; b.bar = bar; b.x = xb_xcc_id(); b.st = st;
    if (threadIdx.x == 0) (void)xb_add(&bar[XB_XCNT(b.x)], 1u);
    return b;
}
__device__ __forceinline__ void xcd_barrier_complete(unsigned* bar, unsigned x, unsigned& nloc, unsigned& nx) {
    const unsigned G = gridDim.x * gridDim.y * gridDim.z;
    unsigned sum, cnt, mine, sp = 0u;
    for (;;) {
        sum = 0u; cnt = 0u; mine = 0u;
#pragma unroll
        for (unsigned j = 0; j < 16; ++j) { const unsigned c = xb_ld(&bar[XB_XCNT(j)]); sum += c; cnt += (c > 0u) ? 1u : 0u; mine = (j == x) ? c : mine; }
        if (sum == G) break;
        __builtin_amdgcn_s_sleep(1);
        if ((++sp & 255u) == 0u) { if (xb_ld(&bar[XB_TMO])) break; if (sp > XB_SPIN_CAP) { atomicAdd(&bar[XB_TMO], 1u); break; } }
    }
    nloc = mine > 0u ? mine : 1u; nx = cnt > 0u ? cnt : 1u;
}
__device__ __forceinline__ void xcd_barrier(const XcdBarrier& b) {
    asm volatile("s_waitcnt vmcnt(0)" ::: "memory");
    __syncthreads();
    if (threadIdx.x == 0) {
        unsigned* bar = b.bar;
        __builtin_amdgcn_s_waitcnt(0);
        unsigned nloc = b.st[0], nx = b.st[1];
        if (nloc == 0u) { xcd_barrier_complete(bar, b.x, nloc, nx); b.st[0] = nloc; b.st[1] = nx; }
        const unsigned old = xb_add(&bar[XB_XSUB(b.x)], 1u);
        const unsigned gen = old / nloc;
        if (old + 1u == (gen + 1u) * nloc) {
            __builtin_amdgcn_fence(__ATOMIC_RELEASE, "agent");
            asm volatile("s_waitcnt vmcnt(0)" ::: "memory");
            const unsigned og = xb_add(&bar[XB_TOP], 1u);
            const unsigned tg = og / nx;
            if (og + 1u == (tg + 1u) * nx) xb_add(&bar[XB_TOPGEN], 1u);
            else XB_SPIN(xb_ld(&bar[XB_TOPGEN]) == tg, bar);
            __builtin_amdgcn_fence(__ATOMIC_ACQUIRE, "agent");
            xb_add(&bar[XB_XGEN(b.x)], 1u);
            asm volatile("s_waitcnt vmcnt(0)" ::: "memory");
        } else {
            XB_SPIN(xb_ld(&bar[XB_XGEN(b.x)]) == gen, bar);
            __builtin_amdgcn_fence(__ATOMIC_ACQUIRE, "agent");
            asm volatile("s_waitcnt vmcnt(0)" ::: "memory");
        }
    }
    __syncthreads();
}

struct Args { const float* in[20]; float* out; unsigned char* ws; int ph_lo, ph_hi; };
struct Frame {
    LAS unsigned char* lds;
    volatile LAS unsigned* MISC;
    int tid, lane, wave;
    int vcu, G;
    const Args* a;
};
#define FIN(name, idx) (F.a->in[idx])
#define F_x FIN(x, 0)
#define F_c FIN(c, 1)
#define F_ctx FIN(ctx, 2)
#define F_c_ctx FIN(c_ctx, 3)
#define F_w_mod FIN(w_mod, 4)
#define F_b_mod FIN(b_mod, 5)
#define F_norm_mix_g FIN(norm_mix_g, 6)
#define F_w_in FIN(w_in, 7)
#define F_conv_w FIN(conv_w, 8)
#define F_conv_b FIN(conv_b, 9)
#define F_conv_ln_g FIN(conv_ln_g, 10)
#define F_conv_ln_b FIN(conv_ln_b, 11)
#define F_rpb FIN(rpb, 12)
#define F_w_out FIN(w_out, 13)
#define F_norm_ffn_g FIN(norm_ffn_g, 14)
#define F_w_router FIN(w_router, 15)
#define F_w_gate FIN(w_gate, 16)
#define F_w_up FIN(w_up, 17)
#define F_w_down FIN(w_down, 18)
#define F_norm_final_g FIN(norm_final_g, 19)
#define F_out (F.a->out)
#define WSP(T, off) ((T*)(F.a->ws + (off)))
#define F_MOD WSP(float, WS_MOD)
#define F_AFF WSP(float, WS_AFF)
#define F_INV WSP(int, WS_INV)
#define F_TOK WSP(int, WS_TOK)
#define F_WTS WSP(float, WS_WT)
#define F_X1 WSP(float, WS_X1)
#define F_WIN WSP(bf16, WS_WIN)
#define F_WOUT WSP(bf16, WS_WOUT)
#define F_WGU WSP(bf16, WS_WGU)
#define F_WD WSP(bf16, WS_WD)
#define F_YS WSP(bf16, WS_YS)
#define F_XS WSP(bf16, WS_XS)
#define F_H WSP(bf16, WS_H)
#define F_U WSP(bf16, WS_U)
#define F_Q WSP(bf16, WS_Q)
#define F_K WSP(bf16, WS_K)
#define F_VT WSP(bf16, WS_VT)
#define F_MIX WSP(bf16, WS_MIX)
#define F_HID WSP(bf16, WS_HID)
#define F_H2 WSP(bf16, WS_H2)

template <int CTRL> __device__ __forceinline__ float dpp_mov(float v) { return __builtin_bit_cast(float, __builtin_amdgcn_update_dpp(0, __builtin_bit_cast(int, v), CTRL, 0xF, 0xF, true)); }
__device__ __forceinline__ float row16_sum(float v) { v += dpp_mov<0xB1>(v); v += dpp_mov<0x4E>(v); v += dpp_mov<0x141>(v); v += dpp_mov<0x140>(v); return v; }
__device__ __forceinline__ float row16_max(float v) { v = fmaxf(v, dpp_mov<0xB1>(v)); v = fmaxf(v, dpp_mov<0x4E>(v)); v = fmaxf(v, dpp_mov<0x141>(v)); v = fmaxf(v, dpp_mov<0x140>(v)); return v; }
__device__ __forceinline__ float rdlane(float v, int l) { return __builtin_bit_cast(float, __builtin_amdgcn_readlane(__builtin_bit_cast(int, v), l)); }
__device__ __forceinline__ float wave_sum(float v) {
    v = row16_sum(v);
    return (rdlane(v, 0) + rdlane(v, 16)) + (rdlane(v, 32) + rdlane(v, 48));
}
__device__ __forceinline__ float half_sum(float v, int half) {
    v = row16_sum(v);
    const float lo = rdlane(v, 0) + rdlane(v, 16), hi = rdlane(v, 32) + rdlane(v, 48);
    return half ? hi : lo;
}
__device__ __forceinline__ float wave_max(float v) {
#pragma unroll
    for (int o = 1; o < 64; o <<= 1) v = fmaxf(v, __shfl_xor(v, o));
    return v;
}

__device__ __forceinline__ void transpose_item(const float* W, int N, int k0, int n0, bf16* WT, int Kdst, int drow0, LAS float* scr, int lane) {
#pragma unroll 8
    for (int i = 0; i < 32; ++i) { const int kk = 2 * i + (lane >> 5); scr[kk * 33 + (lane & 31)] = __builtin_nontemporal_load(&W[(size_t)(k0 + kk) * N + n0 + (lane & 31)]); }
    LDS_WAIT(); asm volatile("" ::: "memory");
    const int c = lane & 7;
#pragma unroll
    for (int j = 0; j < 4; ++j) { const int n = (lane >> 3) + 8 * j; const LAS float* s = scr + (8 * c) * 33 + n;
        v4u o; o.x = pk2(s[0 * 33], s[1 * 33]); o.y = pk2(s[2 * 33], s[3 * 33]); o.z = pk2(s[4 * 33], s[5 * 33]); o.w = pk2(s[6 * 33], s[7 * 33]);
        *(GAS v4u*)(WT + (size_t)(drow0 + n) * Kdst + k0 + 8 * c) = o; }
    LDS_WAIT(); asm volatile("" ::: "memory");
}

__device__ __forceinline__ void p0_prologue(Frame& F) {
    {
        LAS float* sl = (LAS float*)(F.lds + RING_OFF);
        LAS float* part = sl + 3 * DM;
        for (int i = F.tid; i < 3 * DM; i += NWAVES * 64) { const int r = i >> 10, k = i & 1023; const float cv = (r < 2) ? F_c[r * DM + k] : F_c_ctx[k]; sl[i] = cv * fast_sigmoid(cv); }
        __syncthreads();
        for (int it = F.vcu; it < NMODV / 64; it += F.G) {
            const int n = it * 64 + F.lane; float a0 = 0.f, a1 = 0.f, a2 = 0.f;
            const int kb = F.wave * 128;
#pragma unroll 8
            for (int k = 0; k < 128; ++k) { const float w = F_w_mod[(size_t)(kb + k) * NMODV + n]; a0 += sl[kb + k] * w; a1 += sl[DM + kb + k] * w; a2 += sl[2 * DM + kb + k] * w; }
            part[(F.wave * 3 + 0) * 64 + F.lane] = a0; part[(F.wave * 3 + 1) * 64 + F.lane] = a1; part[(F.wave * 3 + 2) * 64 + F.lane] = a2;
            __syncthreads();
            if (F.wave < 3) { float s = F_b_mod[n];
#pragma unroll
                for (int w = 0; w < 8; ++w) s += part[(w * 3 + F.wave) * 64 + F.lane];
                F_MOD[F.wave * NMODV + n] = s; }
            __syncthreads();
        }
        __syncthreads();
    }
    LAS float* scr = (LAS float*)(F.lds + RING_OFF + F.wave * 16384);
    const int gw = F.vcu * NWAVES + F.wave, NGW = F.G * NWAVES;
    constexpr int I_IN = (DM / 64) * (NINC / 32);
    constexpr int I_OUT = (DM / 64) * (DM / 32);
    for (int it = gw; it < I_IN + I_OUT; it += NGW) {
        int r = it;
        if (r < I_IN) { const int nblk = NINC / 32, kb = r / nblk, nb = r % nblk, n0 = nb * 32;
            int drow = n0;
            if (n0 < 1024) { const int half = n0 >> 9, rem = n0 & 511; drow = 256 * (rem >> 7) + 128 * half + (rem & 127); }
            transpose_item(F_w_in, NINC, kb * 64, n0, F_WIN, DM, drow, scr, F.lane); continue; }
        r -= I_IN;
        { const int nblk = DM / 32, kb = r / nblk, nb = r % nblk; transpose_item(F_w_out, DM, kb * 64, nb * 32, F_WOUT, DM, nb * 32, scr, F.lane); }
    }
}

constexpr int MOE_I_G = (DM / 64) * (DEXP / 32);
constexpr int MOE_I_D = (DEXP / 64) * (DM / 32);
constexpr int MOE_ITEMS = NEXP * (2 * MOE_I_G + MOE_I_D), MOE_CHUNK = 8, MOE_NCHUNK = MOE_ITEMS / MOE_CHUNK;
__device__ __forceinline__ void moe_item(Frame& F, int r, LAS float* scr) {
    const int e = r / (2 * MOE_I_G + MOE_I_D); r -= e * (2 * MOE_I_G + MOE_I_D);
    if (r < 2 * MOE_I_G) { const int half = r / MOE_I_G; r -= half * MOE_I_G; const int nblk = DEXP / 32, kb = r / nblk, nb = r % nblk, n0 = nb * 32;
        const int drow = 256 * (n0 >> 7) + 128 * half + (n0 & 127);
        transpose_item((half ? F_w_up : F_w_gate) + (size_t)e * DM * DEXP, DEXP, kb * 64, n0, F_WGU + (size_t)e * 2 * DEXP * DM, DM, drow, scr, F.lane); return; }
    r -= 2 * MOE_I_G;
    { const int nblk = DM / 32, kb = r / nblk, nb = r % nblk; transpose_item(F_w_down + (size_t)e * DEXP * DM, DM, kb * 64, nb * 32, F_WD + (size_t)e * DM * DEXP, DEXP, nb * 32, scr, F.lane); }
}
__device__ __forceinline__ void moe_weights(Frame& F, unsigned* counter) {
    LAS float* scr = (LAS float*)(F.lds + RING_OFF + 16384 + F.wave * 8704);
    const int gw = F.vcu * NWAVES + F.wave, NGW = F.G * NWAVES;
    int ch = gw;
    while (ch < MOE_NCHUNK) {
        for (int k = 0; k < MOE_CHUNK; ++k) moe_item(F, ch * MOE_CHUNK + k, scr);
        unsigned nx = 0u;
        if (F.lane == 0) nx = __hip_atomic_fetch_add(counter, 1u, __ATOMIC_RELAXED, __HIP_MEMORY_SCOPE_AGENT);
        ch = NGW + (int)__builtin_amdgcn_readfirstlane(nx);
    }
}

__device__ __forceinline__ void p1_hpass(Frame& F) {
    const int gw = F.vcu * NWAVES + F.wave, NGW = F.G * NWAVES;
    for (int m = gw; m < MALL; m += NGW) {
        const float* xr = (m < MTOK) ? F_x + (size_t)m * DM : F_ctx + (size_t)(m - MTOK) * DM;
        const float* mod = F_MOD + (size_t)((m < MTOK) ? (m >> 13) : 2) * NMODV;
        f32x4 v[4]; float ss = 0.f;
#pragma unroll
        for (int j = 0; j < 4; ++j) { v[j] = *(const GAS f32x4*)(xr + 4 * F.lane + 256 * j); ss += (v[j].x * v[j].x + v[j].y * v[j].y) + (v[j].z * v[j].z + v[j].w * v[j].w); }
        const float rstd = 1.0f / sqrtf(wave_sum(ss) * (1.0f / DM) + EPS);
        GAS v2u* o = (GAS v2u*)(F_H + (size_t)m * DM);
#pragma unroll
        for (int j = 0; j < 4; ++j) { const int col = 4 * F.lane + 256 * j;
            const f32x4 g = *(const GAS f32x4*)(F_norm_mix_g + col), sh = *(const GAS f32x4*)(mod + col), sc = *(const GAS f32x4*)(mod + DM + col);
            const f32x4 h = v[j] * rstd * g * (1.0f + sc) + sh;
            v2u w; w.x = pk2(h.x, h.y); w.y = pk2(h.z, h.w); o[F.lane + 64 * j] = w; }
    }
}

struct InProjOrder {
    int vcu, G; const char *H, *WIN;
    __device__ __forceinline__ bool next(int i, pg8::Unit& u) const {
        const size_t tstep = (size_t)256 * DM * 2;
        int pm, pn, kind;
        if (G == 256) {
            const int x = vcu >> 5, s = vcu & 31;
            if (i < 2) { pm = 32 * i + 4 * x + (s & 3); pn = s >> 2; kind = pn < 4 ? 0 : (pn < 6 ? 1 : 2); }
            else if (i == 2) {
                if (s < 16) { kind = 3; pm = s & 1; pn = 8 * x + (s >> 1); }
                else if (s == 16) { if (x < 4) { kind = 3; pm = x & 1; pn = 64 + (x >> 1); } else { kind = 2; pm = 64 + ((x - 4) >> 1); pn = 6 + ((x - 4) & 1); } }
                else return false;
            } else return false;
        } else {
            const int L = i * G + vcu;
            if (L < 512) { pm = L >> 3; pn = L & 7; kind = pn < 4 ? 0 : (pn < 6 ? 1 : 2); }
            else if (L < 516) { kind = 2; pm = 64 + ((L - 512) >> 1); pn = 6 + ((L - 512) & 1); }
            else if (L < 648) { kind = 3; pm = (L - 516) & 1; pn = (L - 516) >> 1; }
            else return false;
        }
        u.pm = pm; u.pn = pn; u.kind = kind;
        if (kind == 3) { u.A = WIN + (size_t)(8 + pm) * tstep; u.B = H + (size_t)pn * tstep; }
        else { u.A = H + (size_t)pm * tstep; u.B = WIN + (size_t)pn * tstep; }
        return true;
    }
};
struct EpiInProj {
    static constexpr bool PERM = true;
    bf16 *U, *Q, *Kb, *Vt; float qscale;
    __device__ __forceinline__ void operator()(const pg8::f32x4 (&acc)[2][2][4][2], const pg8::Unit& u, int wr, int wc, int fr, int fq) const {
        const int row0 = u.pm * 256 + wr * 64 + fr;
        if (u.kind == 0) {
            const int col0 = u.pn * 128 + wc * 32 + 8 * fq;
#pragma unroll
            for (int ai = 0; ai < 2; ++ai)
#pragma unroll
                for (int m = 0; m < 4; ++m) {
                    float v[8];
#pragma unroll
                    for (int n = 0; n < 2; ++n)
#pragma unroll
                        for (int i = 0; i < 4; ++i) v[4 * n + i] = acc[ai][0][m][n][i] * fast_sigmoid(acc[ai][1][m][n][i]);
                    v4u w; w.x = pg8::cvt_pk_bf16(v[0], v[1]); w.y = pg8::cvt_pk_bf16(v[2], v[3]); w.z = pg8::cvt_pk_bf16(v[4], v[5]); w.w = pg8::cvt_pk_bf16(v[6], v[7]);
                    *(v4u*)(U + (size_t)(row0 + ai * 128 + m * 16) * CONVC + col0) = w; }
        } else {
            bf16* base; int ldc, colt; float sc = 1.f;
            if (u.kind == 1) { base = Q; ldc = ATTW; colt = (u.pn - 4) * 256; sc = qscale; }
            else if (u.kind == 2) { base = Kb; ldc = ATTW; colt = (u.pn - 6) * 256; }
            else { base = Vt; ldc = MALL; colt = u.pn * 256; }
            const int col0 = colt + wc * 32 + 8 * fq;
#pragma unroll
            for (int ai = 0; ai < 2; ++ai)
#pragma unroll
                for (int m = 0; m < 4; ++m) { bf16* rowp = base + (size_t)(row0 + ai * 128 + m * 16) * ldc + col0;
#pragma unroll
                    for (int bj = 0; bj < 2; ++bj) { const pg8::f32x4 v0 = acc[ai][bj][m][0] * sc, v1 = acc[ai][bj][m][1] * sc;
                        v4u w; w.x = pg8::cvt_pk_bf16(v0[0], v0[1]); w.y = pg8::cvt_pk_bf16(v0[2], v0[3]); w.z = pg8::cvt_pk_bf16(v1[0], v1[1]); w.w = pg8::cvt_pk_bf16(v1[2], v1[3]);
                        *(v4u*)(rowp + bj * 128) = w; } }
        }
    }
};

constexpr int P3_Y_OFF = 0;
constexpr int P3_BIAS_OFF = MISC_OFF + 128;
constexpr float ATT_THR = 8.0f;

__device__ __forceinline__ void attn_wave(Frame& F, int b, int r) {
    const int lane = F.lane, head = F.wave, q32 = lane & 31, hh = lane >> 5;
    const LAS float* bt = (const LAS float*)(F.lds + P3_BIAS_OFF) + head * 15 * 32;
    const int tok0 = b * SEQ + r * 64;
    bf16x8 Bq[2][4];
#pragma unroll
    for (int qt = 0; qt < 2; ++qt)
#pragma unroll
        for (int ds = 0; ds < 4; ++ds) Bq[qt][ds] = *(const GAS bf16x8*)(F_Q + (size_t)(tok0 + 32 * qt + q32) * ATTW + head * HD + 16 * ds + 8 * hh);
    f32x16 O[2][2];
#pragma unroll
    for (int a = 0; a < 2; ++a)
#pragma unroll
        for (int c = 0; c < 2; ++c)
#pragma unroll
            for (int i = 0; i < 16; ++i) O[a][c][i] = 0.f;
    float mref[2] = {-1e30f, -1e30f}, lsum[2] = {0.f, 0.f};
    const int pi = (q32 & 0x13) | ((q32 & 4) << 1) | ((q32 & 8) >> 1);
    int r0 = r - 4; r0 = r0 < 0 ? 0 : (r0 > GROWS - 8 ? GROWS - 8 : r0);
    const bf16* Kh = F_K + head * HD + 8 * hh;
    const bf16* Vh = F_VT + (size_t)(head * HD + q32) * MALL + 8 * hh;
    for (int t = 0; t < 24; ++t) {
        int ktok0, drow = 0, half = 0; const bool local = t >= 8;
        if (!local) ktok0 = MTOK + b * CTXL + 32 * t;
        else { const int j = (t - 8) >> 1; half = (t - 8) & 1; const int kr = r0 + j; drow = kr - r + 7; ktok0 = b * SEQ + kr * 64 + 32 * half; }
        bf16x8 Ak[4], Av[2][2];
#pragma unroll
        for (int ds = 0; ds < 4; ++ds) Ak[ds] = *(const GAS bf16x8*)(Kh + (size_t)(ktok0 + pi) * ATTW + 16 * ds);
#pragma unroll
        for (int dt = 0; dt < 2; ++dt)
#pragma unroll
            for (int s = 0; s < 2; ++s) Av[dt][s] = *(const GAS bf16x8*)(Vh + (size_t)(32 * dt) * MALL + ktok0 + 16 * s);
        f32x16 S[2];
        if (local) {
#pragma unroll
            for (int qt = 0; qt < 2; ++qt) { const int qc = 32 * qt + q32; int c0 = qc - 8; c0 = c0 < 0 ? 0 : (c0 > 48 ? 48 : c0);
#pragma unroll
                for (int rr = 0; rr < 16; ++rr) { const int kc = 32 * half + 16 * (rr >> 3) + 8 * hh + (rr & 7); const bool valid = (kc >= c0) && (kc < c0 + 16);
                    int delta = kc - qc + 15; delta = valid ? delta : 0;
                    const float bv = bt[drow * 32 + delta]; S[qt][rr] = valid ? bv : -1e30f; } }
        } else {
#pragma unroll
            for (int qt = 0; qt < 2; ++qt)
#pragma unroll
                for (int rr = 0; rr < 16; ++rr) S[qt][rr] = 0.f;
        }
#pragma unroll
        for (int qt = 0; qt < 2; ++qt)
#pragma unroll
            for (int ds = 0; ds < 4; ++ds) S[qt] = __builtin_amdgcn_mfma_f32_32x32x16_bf16(Ak[ds], Bq[qt][ds], S[qt], 0, 0, 0);
#pragma unroll
        for (int qt = 0; qt < 2; ++qt) {
            float tm = S[qt][0];
#pragma unroll
            for (int rr = 1; rr < 16; ++rr) tm = fmaxf(tm, S[qt][rr]);
            tm = fmaxf(tm, __shfl_xor(tm, 32));
            if (__any(tm > mref[qt] + ATT_THR)) {
                const float mn = fmaxf(mref[qt], tm), sc = __builtin_amdgcn_exp2f(mref[qt] - mn);
                mref[qt] = mn; lsum[qt] *= sc;
#pragma unroll
                for (int i = 0; i < 16; ++i) { O[0][qt][i] *= sc; O[1][qt][i] *= sc; }
            }
            float p[16]; float ps = 0.f;
#pragma unroll
            for (int rr = 0; rr < 16; ++rr) { p[rr] = __builtin_amdgcn_exp2f(S[qt][rr] - mref[qt]); ps += p[rr]; }
            lsum[qt] += ps;
            bf16x8 Bp[2];
#pragma unroll
            for (int s = 0; s < 2; ++s) { v4u w; w.x = pg8::cvt_pk_bf16(p[8 * s + 0], p[8 * s + 1]); w.y = pg8::cvt_pk_bf16(p[8 * s + 2], p[8 * s + 3]); w.z = pg8::cvt_pk_bf16(p[8 * s + 4], p[8 * s + 5]); w.w = pg8::cvt_pk_bf16(p[8 * s + 6], p[8 * s + 7]);
                Bp[s] = __builtin_bit_cast(bf16x8, w); }
#pragma unroll
            for (int dt = 0; dt < 2; ++dt)
#pragma unroll
                for (int s = 0; s < 2; ++s) O[dt][qt] = __builtin_amdgcn_mfma_f32_32x32x16_bf16(Av[dt][s], Bp[s], O[dt][qt], 0, 0, 0);
        }
    }
#pragma unroll
    for (int qt = 0; qt < 2; ++qt) {
        const float lt = lsum[qt] + __shfl_xor(lsum[qt], 32), inv = 1.0f / lt;
        bf16* orow = F_MIX + (size_t)(tok0 + 32 * qt + q32) * DM + CONVC + head * HD + 4 * hh;
#pragma unroll
        for (int dt = 0; dt < 2; ++dt)
#pragma unroll
            for (int g4 = 0; g4 < 4; ++g4) { v2u w; w.x = pg8::cvt_pk_bf16(O[dt][qt][4 * g4 + 0] * inv, O[dt][qt][4 * g4 + 1] * inv); w.y = pg8::cvt_pk_bf16(O[dt][qt][4 * g4 + 2] * inv, O[dt][qt][4 * g4 + 3] * inv);
                *(GAS v2u*)(orow + 32 * dt + 8 * g4) = w; }
    }
}

typedef float f32x2 __attribute__((ext_vector_type(2)));
__device__ __forceinline__ void conv_unit(Frame& F, int b, int r) {
    const int lane = F.lane, w = F.wave;
    const int cp = F.tid & 255, th = F.tid >> 8;
    LAS float* yb = (LAS float*)(F.lds + P3_Y_OFF);
    const float *cw = F_conv_w, *cb = F_conv_b, *lg = F_conv_ln_g, *lb = F_conv_ln_b;
    asm volatile("" : "+s"(cw), "+s"(cb), "+s"(lg), "+s"(lb));
    {
        const int t0 = r * 64 + 32 * th - 15;
        f32x2 in[62];
        const bf16* up = F_U + (size_t)b * SEQ * CONVC + 2 * cp;
#pragma unroll
        for (int k = 0; k < 62; ++k) { const int tt = t0 + k; unsigned wv = 0u; if (tt >= 0 && tt < SEQ) wv = *(const GAS unsigned*)(up + (size_t)tt * CONVC); in[k] = (f32x2){bf_lo(wv), bf_hi(wv)}; }
        f32x2 wj[CONVW];
#pragma unroll
        for (int j = 0; j < CONVW; ++j) wj[j] = *(const GAS f32x2*)(cw + j * CONVC + 2 * cp);
        const f32x2 bias = *(const GAS f32x2*)(cb + 2 * cp);
#pragma unroll
        for (int t = 0; t < 32; ++t) { f32x2 a = bias;
#pragma unroll
            for (int j = 0; j < CONVW; ++j) a = wj[j] * in[t + j] + a;
            *(LAS f32x2*)(yb + (32 * th + t) * CONVC + 2 * cp) = a; }
    }
    __syncthreads();
    const f32x4 g0 = *(const GAS f32x4*)(lg + 8 * lane), g1 = *(const GAS f32x4*)(lg + 8 * lane + 4);
    const f32x4 b0 = *(const GAS f32x4*)(lb + 8 * lane), b1 = *(const GAS f32x4*)(lb + 8 * lane + 4);
#pragma unroll 2
    for (int k = 0; k < 8; ++k) { const int tk = 8 * w + k;
        f32x4 y0 = *(const LAS f32x4*)(yb + tk * CONVC + 8 * lane), y1 = *(const LAS f32x4*)(yb + tk * CONVC + 8 * lane + 4);
        const float s = wave_sum((y0.x + y0.y) + (y0.z + y0.w) + (y1.x + y1.y) + (y1.z + y1.w));
        const float mean = s * (1.0f / CONVC);
        y0 = y0 - mean; y1 = y1 - mean;
        const float q = wave_sum((y0.x * y0.x + y0.y * y0.y) + (y0.z * y0.z + y0.w * y0.w) + (y1.x * y1.x + y1.y * y1.y) + (y1.z * y1.z + y1.w * y1.w));
        const float rstd = 1.0f / sqrtf(q * (1.0f / CONVC) + EPS);
        y0 = y0 * rstd * g0 + b0; y1 = y1 * rstd * g1 + b1;
        v4u wv; wv.x = pk2(y0.x * fast_sigmoid(y0.x), y0.y * fast_sigmoid(y0.y)); wv.y = pk2(y0.z * fast_sigmoid(y0.z), y0.w * fast_sigmoid(y0.w));
        wv.z = pk2(y1.x * fast_sigmoid(y1.x), y1.y * fast_sigmoid(y1.y)); wv.w = pk2(y1.z * fast_sigmoid(y1.z), y1.w * fast_sigmoid(y1.w));
        *(GAS v4u*)(F_MIX + (size_t)(b * SEQ + r * 64 + tk) * DM + 8 * lane) = wv; }
    __syncthreads();
}

__device__ __forceinline__ void p3_mixers(Frame& F) {
    LAS float* bt = (LAS float*)(F.lds + P3_BIAS_OFF);
    for (int i = F.tid; i < NHEADS * 15 * 32; i += NWAVES * 64) { const int c = i & 31, hr = i >> 5; bt[i] = (c < 31) ? F_rpb[hr * 31 + c] * LOG2E : 0.f; }
    __syncthreads();
    for (int u = F.vcu; u < NB * GROWS; u += F.G) {
        const int b = u / GROWS, r = u % GROWS;
#ifndef PROBE_ATTN
#define PROBE_ATTN 1
#endif
#ifndef PROBE_CONV
#define PROBE_CONV 1
#endif
#pragma unroll 1
        for (int rp = 0; rp < PROBE_ATTN; ++rp) attn_wave(F, b, r);
        asm volatile("" ::: "memory"); __builtin_amdgcn_sched_barrier(0); __syncthreads(); asm volatile("" ::: "memory");
#pragma unroll 1
        for (int rp = 0; rp < PROBE_CONV; ++rp) conv_unit(F, b, r);
    }
#ifdef PROBE_CONV2
    for (int u = F.vcu; u < NB * GROWS; u += F.G) { asm volatile("" ::: "memory"); conv_unit(F, u / GROWS, u % GROWS); }
#endif
}

struct OutProjOrder {
    int vcu, G; const char *MIX, *WOUT;
    __device__ __forceinline__ bool next(int i, pg8::Unit& u) const {
        const size_t tstep = (size_t)256 * DM * 2;
        int pm, pn;
        if (G == 256) { if (i > 0) return false; const int x = vcu >> 5, s = vcu & 31; pm = 8 * x + (s & 7); pn = s >> 3; }
        else { const int L = i * G + vcu; if (L >= 256) return false; pm = L >> 2; pn = L & 3; }
        u.pm = pm; u.pn = pn; u.kind = 0; u.A = MIX + (size_t)pm * tstep; u.B = WOUT + (size_t)pn * tstep; return true;
    }
};
struct EpiOutProj {
    static constexpr bool PERM = false;
    const float* x; const float* MOD; float* X1;
    __device__ __forceinline__ void operator()(const pg8::f32x4 (&acc)[2][2][4][2], const pg8::Unit& u, int wr, int wc, int fr, int fq) const {
        const int row0 = u.pm * 256 + wr * 64 + fr, col0 = u.pn * 256 + wc * 32 + 4 * fq;
        const float* g1 = MOD + (size_t)(u.pm >> 5) * NMODV + 2 * DM;
        pg8::f32x4 gv[2][2];
#pragma unroll
        for (int bj = 0; bj < 2; ++bj)
#pragma unroll
            for (int n = 0; n < 2; ++n) gv[bj][n] = *(const pg8::f32x4*)(g1 + col0 + bj * 128 + n * 16);
#pragma unroll
        for (int ai = 0; ai < 2; ++ai)
#pragma unroll
            for (int m = 0; m < 4; ++m) { const size_t off = (size_t)(row0 + ai * 128 + m * 16) * DM + col0;
#pragma unroll
                for (int bj = 0; bj < 2; ++bj)
#pragma unroll
                    for (int n = 0; n < 2; ++n) { const pg8::f32x4 xv = *(const pg8::f32x4*)(x + off + bj * 128 + n * 16);
                        *(pg8::f32x4*)(X1 + off + bj * 128 + n * 16) = xv + gv[bj][n] * acc[ai][bj][m][n]; } }
    }
};

__device__ __forceinline__ void p5_router(Frame& F) {
    LAS f32x4* wl = (LAS f32x4*)(F.lds + RING_OFF);
    for (int idx = F.tid; idx < DM * 4; idx += NWAVES * 64) { const int c = idx >> 2, q = idx & 3; const f32x4 v = *(const GAS f32x4*)(F_w_router + c * NEXP + 4 * q);
        const int j = c >> 8, l = (c & 255) >> 2, i = c & 3; wl[((j * 4 + i) * 4 + q) * 64 + l] = v; }
    __syncthreads();
    const int gw = F.vcu * NWAVES + F.wave, NGW = F.G * NWAVES, lane = F.lane;
    for (int qd = gw; qd < MTOK / 4; qd += NGW) {
        const int m0 = 4 * qd, b = m0 >> 13;
        const float* mod = F_MOD + (size_t)b * NMODV;
        f32x4 v[4][4];
#pragma unroll
        for (int tk = 0; tk < 4; ++tk)
#pragma unroll
            for (int j = 0; j < 4; ++j) v[tk][j] = *(const GAS f32x4*)(F_X1 + (size_t)(m0 + tk) * DM + 4 * lane + 256 * j);
        float rstd[4];
#pragma unroll
        for (int tk = 0; tk < 4; ++tk) { float ss = 0.f;
#pragma unroll
            for (int j = 0; j < 4; ++j) ss += (v[tk][j].x * v[tk][j].x + v[tk][j].y * v[tk][j].y) + (v[tk][j].z * v[tk][j].z + v[tk][j].w * v[tk][j].w);
            rstd[tk] = 1.0f / sqrtf(wave_sum(ss) * (1.0f / DM) + EPS); }
        float lg[64];
#pragma unroll
        for (int e = 0; e < 64; ++e) lg[e] = 0.f;
#pragma unroll
        for (int j = 0; j < 4; ++j) { const int col = 4 * lane + 256 * j;
            const f32x4 g = *(const GAS f32x4*)(F_norm_ffn_g + col), sh = *(const GAS f32x4*)(mod + 3 * DM + col), sc = *(const GAS f32x4*)(mod + 4 * DM + col);
            const f32x4 gs = g * (1.0f + sc);
#pragma unroll
            for (int tk = 0; tk < 4; ++tk) { v[tk][j] = v[tk][j] * rstd[tk] * gs + sh;
                v2u w; w.x = pk2(v[tk][j].x, v[tk][j].y); w.y = pk2(v[tk][j].z, v[tk][j].w); ((GAS v2u*)(F_H2 + (size_t)(m0 + tk) * DM))[lane + 64 * j] = w; }
#pragma unroll
            for (int i = 0; i < 4; ++i) {
#pragma unroll
                for (int q = 0; q < 4; ++q) { const f32x4 wv = wl[((j * 4 + i) * 4 + q) * 64 + lane];
#pragma unroll
                    for (int tk = 0; tk < 4; ++tk) { const float hv = v[tk][j][i];
                        lg[tk * 16 + 4 * q + 0] += hv * wv.x; lg[tk * 16 + 4 * q + 1] += hv * wv.y; lg[tk * 16 + 4 * q + 2] += hv * wv.z; lg[tk * 16 + 4 * q + 3] += hv * wv.w; } }
                __builtin_amdgcn_sched_barrier(0); } }
#pragma unroll
        for (int w = 32; w >= 1; w >>= 1) {
#pragma unroll
            for (int i = 0; i < w; ++i) { const bool up = (lane & w) != 0; const float send = up ? lg[i] : lg[i + w], keep = up ? lg[i + w] : lg[i]; lg[i] = keep + __shfl_xor(send, w); } }
        const float logit = lg[0];
        const float mx = row16_max(logit), p = __expf(logit - mx), den = row16_sum(p);
        const int tk = lane >> 4, e = lane & 15, t = (m0 + tk) & (SEQ - 1);
        F_AFF[(size_t)(b * NEXP + e) * SEQ + t] = p / den;
    }
}

__device__ __forceinline__ int block_excl_scan(int v, LAS int* sc, int tid, int lane, int wave, int& total) {
    int inc = v;
#pragma unroll
    for (int o = 1; o < 64; o <<= 1) { const int t = __shfl_up(inc, o); if (lane >= o) inc += t; }
    __syncthreads();
    if (lane == 63) sc[wave] = inc;
    __syncthreads();
    int base = 0, tot = 0;
#pragma unroll
    for (int w = 0; w < 8; ++w) { const int c = sc[w]; if (w < wave) base += c; tot += c; }
    total = tot;
    return base + inc - v;
}
__device__ __forceinline__ void p6_topk(Frame& F) {
    LAS int* hist = (LAS int*)(F.lds + RING_OFF);
    LAS int* sel = hist + 256;
    LAS int* sc = hist + 264;
    for (int be = blockIdx.x; be < NB * NEXP; be += F.G) {
        const int b = be >> 4, e = be & 15;
        const float* a = F_AFF + (size_t)be * SEQ + 16 * F.tid;
        unsigned v[16];
#pragma unroll
        for (int j = 0; j < 4; ++j) { const v4u q = *(const GAS v4u*)(a + 4 * j); v[4 * j] = q.x; v[4 * j + 1] = q.y; v[4 * j + 2] = q.z; v[4 * j + 3] = q.w; }
        unsigned prefix = 0u, mask = 0u; int kk = CAP;
#pragma unroll 1
        for (int pass = 0; pass < 4; ++pass) { const int shift = 24 - 8 * pass;
            __syncthreads();
            if (F.tid < 256) hist[F.tid] = 0;
            __syncthreads();
#pragma unroll
            for (int j = 0; j < 16; ++j) if ((v[j] & mask) == prefix) __hip_atomic_fetch_add(&hist[(v[j] >> shift) & 255u], 1, __ATOMIC_RELAXED, __HIP_MEMORY_SCOPE_WORKGROUP);
            __syncthreads();
            if (F.wave == 0) {
                int c[4]; int s4 = 0;
#pragma unroll
                for (int j = 0; j < 4; ++j) { c[j] = hist[4 * F.lane + j]; s4 += c[j]; }
                int suf = s4;
#pragma unroll
                for (int o = 1; o < 64; o <<= 1) { const int t = __shfl_down(suf, o); if (F.lane + o < 64) suf += t; }
                int above = suf - s4;
#pragma unroll
                for (int j = 3; j >= 0; --j) { if (above < kk && kk <= above + c[j]) { sel[0] = 4 * F.lane + j; sel[1] = kk - above; } above += c[j]; }
            }
            __syncthreads();
            prefix |= (unsigned)sel[0] << shift; mask |= 255u << shift; kk = sel[1];
        }
        const unsigned T = prefix; const int need_eq = kk;
        int ceq = 0;
#pragma unroll
        for (int j = 0; j < 16; ++j) ceq += (v[j] == T) ? 1 : 0;
        int tot; int eqb = block_excl_scan(ceq, sc, F.tid, F.lane, F.wave, tot);
        unsigned selm = 0u; int csel = 0;
#pragma unroll
        for (int j = 0; j < 16; ++j) { bool s = v[j] > T; if (v[j] == T) { s = eqb < need_eq; ++eqb; } if (s) { selm |= 1u << j; ++csel; } }
        int slot = block_excl_scan(csel, sc, F.tid, F.lane, F.wave, tot);
        const int obase = (e * 2 + b) * CAP;
        int iv[16];
#pragma unroll
        for (int j = 0; j < 16; ++j) { const bool s = (selm >> j) & 1u; iv[j] = s ? slot : -1;
            if (s) { F_TOK[obase + slot] = 16 * F.tid + j; F_WTS[obase + slot] = __builtin_bit_cast(float, v[j]); ++slot; } }
        int* ip = F_INV + (size_t)be * SEQ + 16 * F.tid;
#pragma unroll
        for (int j = 0; j < 4; ++j) *(GAS v4u*)(ip + 4 * j) = (v4u){(unsigned)iv[4 * j], (unsigned)iv[4 * j + 1], (unsigned)iv[4 * j + 2], (unsigned)iv[4 * j + 3]};
        __syncthreads();
    }
}

struct GateUpOrder {
    int vcu, G; const char *H2, *WGU; const int* TOK;
    __device__ __forceinline__ bool next(int i, pg8::Unit& u) const {
        int e, pml, pn;
        if (G == 256) { if (i >= 8) return false; const int x = vcu >> 5, s = vcu & 31; e = 2 * x + (i >> 2); pml = s & 7; pn = 4 * (i & 3) + (s >> 3); }
        else { const int L = i * G + vcu; if (L >= 2048) return false; e = L >> 7; pml = L & 7; pn = (L >> 3) & 15; }
        u.pm = e * 8 + pml; u.pn = pn; u.kind = 0;
        u.A = H2; u.B = WGU + ((size_t)e * 2 * DEXP + (size_t)pn * 256) * DM * 2; return true;
    }
    __device__ __forceinline__ const int* rows(const pg8::Unit& u) const { return TOK + u.pm * 256; }
    __device__ __forceinline__ int row_base(const pg8::Unit& u) const { return ((u.pm >> 2) & 1) * SEQ; }
};
struct EpiSwiGLU {
    static constexpr bool PERM = true;
    bf16* HID;
    __device__ __forceinline__ void operator()(const pg8::f32x4 (&acc)[2][2][4][2], const pg8::Unit& u, int wr, int wc, int fr, int fq) const {
        const int row0 = u.pm * 256 + wr * 64 + fr, col0 = u.pn * 128 + wc * 32 + 8 * fq;
#pragma unroll
        for (int ai = 0; ai < 2; ++ai)
#pragma unroll
            for (int m = 0; m < 4; ++m) {
                float v[8];
#pragma unroll
                for (int n = 0; n < 2; ++n)
#pragma unroll
                    for (int i = 0; i < 4; ++i) { const float g = acc[ai][0][m][n][i]; v[4 * n + i] = g * fast_sigmoid(g) * acc[ai][1][m][n][i]; }
                v4u w; w.x = pg8::cvt_pk_bf16(v[0], v[1]); w.y = pg8::cvt_pk_bf16(v[2], v[3]); w.z = pg8::cvt_pk_bf16(v[4], v[5]); w.w = pg8::cvt_pk_bf16(v[6], v[7]);
                *(v4u*)(HID + (size_t)(row0 + ai * 128 + m * 16) * DEXP + col0) = w; }
    }
};
struct DownOrder {
    int vcu, G; const char *HID, *WD;
    __device__ __forceinline__ bool next(int i, pg8::Unit& u) const {
        int e, pml, pn;
        if (G == 256) { if (i >= 2) return false; const int x = vcu >> 5, s = vcu & 31; e = 2 * x + i; pml = s & 7; pn = s >> 3; }
        else { const int L = i * G + vcu; if (L >= 512) return false; e = L >> 5; pml = L & 7; pn = (L >> 3) & 3; }
        u.pm = e * 8 + pml; u.pn = pn; u.kind = 0;
        u.A = HID + (size_t)u.pm * 256 * DEXP * 2; u.B = WD + ((size_t)e * DM + (size_t)pn * 256) * DEXP * 2; return true;
    }
};
struct EpiDown {
    static constexpr bool PERM = true;
    bf16* YS; const float* WTS;
    __device__ __forceinline__ void operator()(const pg8::f32x4 (&acc)[2][2][4][2], const pg8::Unit& u, int wr, int wc, int fr, int fq) const {
        const int row0 = u.pm * 256 + wr * 64 + fr, col0 = u.pn * 256 + wc * 32 + 8 * fq;
#pragma unroll
        for (int ai = 0; ai < 2; ++ai)
#pragma unroll
            for (int m = 0; m < 4; ++m) { const int row = row0 + ai * 128 + m * 16; const float wt = WTS[row]; bf16* rowp = YS + (size_t)row * DM + col0;
#pragma unroll
                for (int bj = 0; bj < 2; ++bj) { const pg8::f32x4 v0 = acc[ai][bj][m][0] * wt, v1 = acc[ai][bj][m][1] * wt;
                    v4u w; w.x = pg8::cvt_pk_bf16(v0[0], v0[1]); w.y = pg8::cvt_pk_bf16(v0[2], v0[3]); w.z = pg8::cvt_pk_bf16(v1[0], v1[1]); w.w = pg8::cvt_pk_bf16(v1[2], v1[3]);
                    *(v4u*)(rowp + bj * 128) = w; } }
    }
};

__device__ __forceinline__ void p9_final(Frame& F) {
    const int gw = F.vcu * NWAVES + F.wave, NGW = F.G * NWAVES, lane = F.lane, half = lane >> 5, l32 = lane & 31;
    for (int pr = gw; pr < MTOK / 2; pr += NGW) {
        const int m = 2 * pr + half, b = m >> 13, t = m & (SEQ - 1);
        const float* mod = F_MOD + (size_t)b * NMODV;
        int slotv = -1;
        if (l32 < 16) slotv = F_INV[(size_t)(b * NEXP + l32) * SEQ + t];
        f32x4 v[8], sum[8];
#pragma unroll
        for (int j = 0; j < 8; ++j) { v[j] = *(const GAS f32x4*)(F_X1 + (size_t)m * DM + 4 * l32 + 128 * j); sum[j] = (f32x4){0.f, 0.f, 0.f, 0.f}; }
        const unsigned long long bal = __ballot(slotv >= 0);
        unsigned my16 = (unsigned)(bal >> (32 * half)) & 0xffffu;
        const int cnt = __popc(my16), ocnt = __popc((unsigned)(bal >> (32 * (1 - half))) & 0xffffu);
        const int maxcnt = cnt > ocnt ? cnt : ocnt;
        for (int k0 = 0; k0 < maxcnt; k0 += 4) {
            v2u rows[4][8]; bool val[4];
#pragma unroll
            for (int kk = 0; kk < 4; ++kk) { val[kk] = my16 != 0u; const int e = val[kk] ? (__ffs(my16) - 1) : 0; my16 &= my16 - 1u;
                const int sl = __shfl(slotv, 32 * half + e);
                const GAS v2u* yr = (const GAS v2u*)(F_YS + (size_t)((e * 2 + b) * CAP + (sl < 0 ? 0 : sl)) * DM) + l32;
#pragma unroll
                for (int j = 0; j < 8; ++j) rows[kk][j] = val[kk] ? yr[32 * j] : (v2u){0u, 0u}; }
#pragma unroll
            for (int kk = 0; kk < 4; ++kk)
#pragma unroll
                for (int j = 0; j < 8; ++j) { const v2u w = rows[kk][j]; sum[j].x += bf_lo(w.x); sum[j].y += bf_hi(w.x); sum[j].z += bf_lo(w.y); sum[j].w += bf_hi(w.y); }
        }
        float ss = 0.f;
#pragma unroll
        for (int j = 0; j < 8; ++j) { const int col = 4 * l32 + 128 * j; const f32x4 g2 = *(const GAS f32x4*)(mod + 5 * DM + col);
            v[j] = v[j] + g2 * sum[j]; ss += (v[j].x * v[j].x + v[j].y * v[j].y) + (v[j].z * v[j].z + v[j].w * v[j].w); }
        const float rstd = 1.0f / sqrtf(half_sum(ss, half) * (1.0f / DM) + EPS);
#pragma unroll
        for (int j = 0; j < 8; ++j) { const int col = 4 * l32 + 128 * j; const f32x4 g = *(const GAS f32x4*)(F_norm_final_g + col);
            *(GAS f32x4*)(F_out + (size_t)m * DM + col) = v[j] * rstd * g; }
    }
}

__device__ __forceinline__ void p5_router_old(Frame& F) {
    LAS f32x4* wl = (LAS f32x4*)(F.lds + RING_OFF);
    for (int idx = F.tid; idx < DM * 4; idx += NWAVES * 64) { const int c = idx >> 2, q = idx & 3; const f32x4 v = *(const GAS f32x4*)(F_w_router + c * NEXP + 4 * q);
        const int j = c >> 8, l = (c & 255) >> 2, i = c & 3; wl[((j * 4 + i) * 4 + q) * 64 + l] = v; }
    __syncthreads();
    const int gw = F.vcu * NWAVES + F.wave, NGW = F.G * NWAVES;
    for (int m = gw; m < MTOK; m += NGW) {
        const int b = m >> 13, t = m & (SEQ - 1);
        const float* mod = F_MOD + (size_t)b * NMODV;
        f32x4 v[4]; float ss = 0.f;
#pragma unroll
        for (int j = 0; j < 4; ++j) { v[j] = *(const GAS f32x4*)(F_X1 + (size_t)m * DM + 4 * F.lane + 256 * j); ss += (v[j].x * v[j].x + v[j].y * v[j].y) + (v[j].z * v[j].z + v[j].w * v[j].w); }
        const float rstd = 1.0f / sqrtf(wave_sum(ss) * (1.0f / DM) + EPS);
        GAS v2u* o = (GAS v2u*)(F_H2 + (size_t)m * DM);
        float lg[16];
#pragma unroll
        for (int e = 0; e < 16; ++e) lg[e] = 0.f;
#pragma unroll
        for (int j = 0; j < 4; ++j) { const int col = 4 * F.lane + 256 * j;
            const f32x4 g = *(const GAS f32x4*)(F_norm_ffn_g + col), sh = *(const GAS f32x4*)(mod + 3 * DM + col), sc = *(const GAS f32x4*)(mod + 4 * DM + col);
            const f32x4 h = v[j] * rstd * g * (1.0f + sc) + sh;
            v2u w; w.x = pk2(h.x, h.y); w.y = pk2(h.z, h.w); o[F.lane + 64 * j] = w;
#pragma unroll
            for (int i = 0; i < 4; ++i) {
#pragma unroll
                for (int q = 0; q < 4; ++q) { const f32x4 wv = wl[((j * 4 + i) * 4 + q) * 64 + F.lane];
                    lg[4 * q + 0] += h[i] * wv.x; lg[4 * q + 1] += h[i] * wv.y; lg[4 * q + 2] += h[i] * wv.z; lg[4 * q + 3] += h[i] * wv.w; }
                __builtin_amdgcn_sched_barrier(0); } }
        float mx = -1e30f;
#pragma unroll
        for (int e = 0; e < 16; ++e) { lg[e] = wave_sum(lg[e]); mx = fmaxf(mx, lg[e]); }
        float den = 0.f;
#pragma unroll
        for (int e = 0; e < 16; ++e) { lg[e] = __expf(lg[e] - mx); den += lg[e]; }
        float mine = 0.f;
#pragma unroll
        for (int e = 0; e < 16; ++e) mine = (F.lane == e) ? lg[e] : mine;
        if (F.lane < 16) F_AFF[(size_t)(b * NEXP + F.lane) * SEQ + t] = mine / den;
    }
}


__device__ __forceinline__ void p9_final_old(Frame& F) {
    const int gw = F.vcu * NWAVES + F.wave, NGW = F.G * NWAVES;
    for (int m = gw; m < MTOK; m += NGW) {
        const int b = m >> 13, t = m & (SEQ - 1);
        const float* mod = F_MOD + (size_t)b * NMODV;
        int slotv = -1;
        if (F.lane < 16) slotv = F_INV[(size_t)(b * NEXP + F.lane) * SEQ + t];
        f32x4 v[4], sum[4];
#pragma unroll
        for (int j = 0; j < 4; ++j) { v[j] = *(const GAS f32x4*)(F_X1 + (size_t)m * DM + 4 * F.lane + 256 * j); sum[j] = (f32x4){0.f, 0.f, 0.f, 0.f}; }
#pragma unroll
        for (int e = 0; e < 16; ++e) { const int sl = __builtin_amdgcn_readlane(slotv, e);
            if (sl >= 0) { const GAS v2u* yr = (const GAS v2u*)(F_YS + (size_t)((e * 2 + b) * CAP + sl) * DM);
#pragma unroll
                for (int j = 0; j < 4; ++j) { const v2u w = yr[F.lane + 64 * j]; sum[j].x += bf_lo(w.x); sum[j].y += bf_hi(w.x); sum[j].z += bf_lo(w.y); sum[j].w += bf_hi(w.y); } } }
        float ss = 0.f;
#pragma unroll
        for (int j = 0; j < 4; ++j) { const int col = 4 * F.lane + 256 * j; const f32x4 g2 = *(const GAS f32x4*)(mod + 5 * DM + col);
            v[j] = v[j] + g2 * sum[j]; ss += (v[j].x * v[j].x + v[j].y * v[j].y) + (v[j].z * v[j].z + v[j].w * v[j].w); }
        const float rstd = 1.0f / sqrtf(wave_sum(ss) * (1.0f / DM) + EPS);
#pragma unroll
        for (int j = 0; j < 4; ++j) { const int col = 4 * F.lane + 256 * j; const f32x4 g = *(const GAS f32x4*)(F_norm_final_g + col);
            *(GAS f32x4*)(F_out + (size_t)m * DM + col) = v[j] * rstd * g; }
    }
}


#ifdef USE_XS
__device__ __forceinline__ void p6b_gather(Frame& F) {
    const int gw = F.vcu * NWAVES + F.wave, NGW = F.G * NWAVES;
    for (int R = gw; R < MX; R += NGW) {
        const int b = (R >> 10) & 1, t = F_TOK[R];
        const GAS v4u* s = (const GAS v4u*)(F_H2 + (size_t)(b * SEQ + t) * DM); GAS v4u* d = (GAS v4u*)(F_XS + (size_t)R * DM);
        const v4u a = s[F.lane], c = s[F.lane + 64]; d[F.lane] = a; d[F.lane + 64] = c;
    }
}
struct GateUpOrderXS {
    int vcu, G; const char *XS, *WGU;
    __device__ __forceinline__ bool next(int i, pg8::Unit& u) const {
        int e, pml, pn;
        if (G == 256) { if (i >= 8) return false; const int x = vcu >> 5, s = vcu & 31; e = 2 * x + (i >> 2); pml = s & 7; pn = 4 * (i & 3) + (s >> 3); }
        else { const int L = i * G + vcu; if (L >= 2048) return false; e = L >> 7; pml = L & 7; pn = (L >> 3) & 15; }
        u.pm = e * 8 + pml; u.pn = pn; u.kind = 0;
        u.A = XS + (size_t)u.pm * 256 * DM * 2; u.B = WGU + ((size_t)e * 2 * DEXP + (size_t)pn * 256) * DM * 2; return true;
    }
};
#endif
constexpr int N_PHASES = 9;
__global__ void __launch_bounds__(NWAVES * 64, 2) mk_fwd(Args args) {
    extern __shared__ __attribute__((aligned(16))) unsigned char lds[];
    Frame F;
    F.lds = (LAS unsigned char*)lds;
    F.MISC = (volatile LAS unsigned*)(F.lds + MISC_OFF);
    F.tid = threadIdx.x; F.lane = F.tid & 63; F.wave = __builtin_amdgcn_readfirstlane(F.tid >> 6);
    F.G = gridDim.x; { const int bx = blockIdx.x; F.vcu = (F.G % 8 == 0) ? (bx % 8) * (F.G / 8) + bx / 8 : bx; }
    F.a = &args;
    gu32* ctl = (gu32*)(args.ws + WS_CTL);
    for (int u = F.tid; u < (MISC_OFF + 128 - LDSCTL_OFF) / 4; u += NWAVES * 64) ((LAS unsigned*)(F.lds + LDSCTL_OFF))[u] = 0u;
    __syncthreads();
    const int lo = args.ph_lo, hi = args.ph_hi;
    const bool multi = (hi - lo) > 1;
    XcdBarrier bar; bar.bar = (unsigned*)(ctl + CW_BAR); bar.x = 0; bar.st = nullptr;
    if (multi) bar = xcd_barrier_post((unsigned*)(ctl + CW_BAR), F.MISC + 8);
#ifndef PH_MASK
#define PH_MASK 0xFFFF
#endif
#define IN(k) ((((PH_MASK) >> (k)) & 1) && lo <= (k) && (k) < hi)
#define SEAM(k) do { if (IN(k) && IN((k) + 1)) xcd_barrier(bar); } while (0)

#ifndef PROBE_REP
#define PROBE_REP 0
#endif
#define NREP(k) (1 + (((PROBE_REP) >> (k)) & 1))
#define PHASE(k, ...) if (IN(k)) { for (int rep_ = 0; rep_ < NREP(k); ++rep_) { __VA_ARGS__; if (rep_ + 1 < NREP(k)) xcd_barrier(bar); } SEAM(k); }
    PHASE(0, p0_prologue(F))
    PHASE(1, p1_hpass(F))
    PHASE(2, { InProjOrder S{F.vcu, F.G, (const char*)F_H, (const char*)F_WIN};
               EpiInProj E{F_U, F_Q, F_K, F_VT, 0.125f * LOG2E};
               pg8::gemm_phase<EpiInProj, InProjOrder>(F.lds + RING_OFF, DM, S, E); })
    PHASE(3, p3_mixers(F))
    PHASE(4, { OutProjOrder S{F.vcu, F.G, (const char*)F_MIX, (const char*)F_WOUT};
               EpiOutProj E{F_x, F_MOD, F_X1};
               pg8::gemm_phase<EpiOutProj, OutProjOrder>(F.lds + RING_OFF, DM, S, E); })
#ifdef OLD_P5
    PHASE(5, p5_router_old(F))
#else
    PHASE(5, p5_router(F))
#endif
    PHASE(6, { p6_topk(F); moe_weights(F, (unsigned*)(ctl + CW_WQ)); })
#ifdef USE_XS
    if (IN(7)) { p6b_gather(F); xcd_barrier(bar); }
    PHASE(7, { GateUpOrderXS S{F.vcu, F.G, (const char*)F_XS, (const char*)F_WGU};
               EpiSwiGLU E{F_HID};
               pg8::gemm_phase<EpiSwiGLU, GateUpOrderXS>(F.lds + RING_OFF, DM, S, E); })
#else
    PHASE(7, { GateUpOrder S{F.vcu, F.G, (const char*)F_H2, (const char*)F_WGU, F_TOK};
               EpiSwiGLU E{F_HID};
               pg8::gemm_phase<EpiSwiGLU, GateUpOrder, true>(F.lds + RING_OFF, DM, S, E); })
#endif
    PHASE(8, { DownOrder S{F.vcu, F.G, (const char*)F_HID, (const char*)F_WD};
               EpiDown E{F_YS, F_WTS};
               pg8::gemm_phase<EpiDown, DownOrder>(F.lds + RING_OFF, DEXP, S, E); })
#ifdef OLD_P9
    PHASE(9, p9_final_old(F))
#else
    PHASE(9, p9_final(F))
#endif
#undef IN
#undef SEAM
}

extern "C" void kernel_launch(void* const* d_in, const int* in_sizes, int n_in, void* d_out, int out_size, void* d_ws, size_t ws_size, hipStream_t stream) {
    static int grid = 0;
    if (grid == 0) {
        if (n_in != 20 || out_size != MTOK * DM || ws_size < WS_END) { fprintf(stderr, "kernel_launch: unexpected shapes (n_in %d out %d ws %zu)\n", n_in, out_size, ws_size); grid = -1; return; }
        int dev = 0, cus = 0, per_cu = 0;
        if (hipGetDevice(&dev) != hipSuccess || hipDeviceGetAttribute(&cus, hipDeviceAttributeMultiprocessorCount, dev) != hipSuccess) { grid = -1; return; }
        if (hipFuncSetAttribute((const void*)mk_fwd, hipFuncAttributeMaxDynamicSharedMemorySize, LDS_BYTES) != hipSuccess) { fprintf(stderr, "kernel_launch: hipFuncSetAttribute failed\n"); grid = -1; return; }
        if (hipOccupancyMaxActiveBlocksPerMultiprocessor(&per_cu, (const void*)mk_fwd, NWAVES * 64, LDS_BYTES) != hipSuccess || per_cu < 1) { fprintf(stderr, "kernel_launch: occupancy query says %d\n", per_cu); per_cu = 1; }
        (void)hipGetLastError();
        grid = cus;
    }
    if (grid < 0) return;
    (void)hipMemsetAsync((char*)d_ws + WS_CTL, 0, CTL_ZERO_BYTES, stream);
    Args a{};
    for (int i = 0; i < 20; ++i) a.in[i] = (const float*)d_in[i];
    a.out = (float*)d_out; a.ws = (unsigned char*)d_ws;
#if MK_ONE_LAUNCH
    a.ph_lo = 0; a.ph_hi = N_PHASES + 1;
    hipLaunchKernelGGL(mk_fwd, dim3(grid), dim3(NWAVES * 64), LDS_BYTES, stream, a);
#else
    for (int p = 0; p <= N_PHASES; ++p) { a.ph_lo = p; a.ph_hi = p + 1; hipLaunchKernelGGL(mk_fwd, dim3(grid), dim3(NWAVES * 64), LDS_BYTES, stream, a); }
#endif
}
```

```cpp
#include <hip/hip_runtime.h>
#include <cstdio>
#include <cstdint>

#ifndef MK_ONE_LAUNCH
#define MK_ONE_LAUNCH 1
#endif

namespace pg8 {
#define PG8_LAS __attribute__((address_space(3)))
typedef unsigned short bf16_t;
typedef short bf16x8 __attribute__((ext_vector_type(8)));
typedef float f32x4 __attribute__((ext_vector_type(4)));
typedef unsigned u32x4 __attribute__((ext_vector_type(4)));
constexpr int BM = 256, BK = 64, HALF = 128, HTB = HALF * BK * 2, STAGE_BYTES = 8 * HTB;
constexpr int WSCALE_WORD = 0x7a7a7a7a;
constexpr int GIDX_OFF = 147456;

__host__ __device__ __forceinline__ int lds_byte(int r, int c) { const int st = (r >> 4) * 2 + (c >> 5), rr = r & 15, cc = c & 31, ob = rr * 64 + cc * 2; return st * 1024 + (ob ^ (((ob >> 9) & 1) << 5)); }
__host__ __device__ __forceinline__ void stage_rc(int b, int& R, int& C) { const int st = b / 1024, sb = b % 1024, swz = sb ^ (((sb >> 9) & 1) << 5); R = (st >> 1) * 16 + swz / 64; C = (st & 1) * 32 + (swz % 64) / 2; }
__host__ __device__ __forceinline__ int perm32(int rho) { const int n = rho >> 4, i = rho & 15; return 8 * (i >> 2) + 4 * n + (i & 3); }

struct Unit { int pm, pn, kind; const char* A; const char* B; };

__device__ __forceinline__ unsigned cvt_pk_bf16(float lo, float hi) { unsigned r; asm volatile("v_cvt_pk_bf16_f32 %0, %1, %2" : "=v"(r) : "v"(lo), "v"(hi)); return r; }

typedef int v8i __attribute__((ext_vector_type(8)));
typedef int v4i __attribute__((ext_vector_type(4)));
struct NoSide { static constexpr bool ON = false; __device__ __forceinline__ bool has(int) const { return false; } __device__ __forceinline__ const void* src(int) const { return nullptr; } __device__ __forceinline__ unsigned row_stride_bytes() const { return 0u; } __device__ __forceinline__ void finish(int, const f32x4 (&)[8]) const {} };
template <class Epi, class Sched, bool GATHER = false, bool FP8 = false, bool ALIGN_EPI = true, bool SP2 = true, class Side = NoSide>
__device__ __forceinline__ void gemm_phase(PG8_LAS unsigned char* lds, const int KB, const Sched& S, const Epi& E, const Side& SD = Side()) {
    const int tid = threadIdx.x, wid = __builtin_amdgcn_readfirstlane(tid >> 6), lane = tid & 63, wr = wid >> 2, wc = wid & 3, fr = lane & 15, fq = lane >> 4;
    const int nt = KB / 128;
    unsigned voffA[2], voffB[2];
#pragma unroll
    for (int i = 0; i < 2; ++i) { int R, C; stage_rc(tid * 16 + i * 8192, R, C); const int Rb = Epi::PERM ? ((R & ~31) + perm32(R & 31)) : R;
        voffA[i] = (unsigned)(R * KB + C * 2); voffB[i] = (unsigned)(Rb * KB + C * 2); }
    const size_t kstep = (size_t)(BK * 2);
    const size_t hstep = (size_t)HALF * KB;
    const unsigned ldsw = (unsigned)wid * 1024u;
    const int aoff = FP8 ? lds_byte(wr * 64 + fr, fq * 16) : lds_byte(wr * 64 + fr, fq * 8), boff = FP8 ? lds_byte(wc * 32 + fr, fq * 16) : lds_byte(wc * 32 + fr, fq * 8);
#define PG8_SA(b, h) (((b) * 2 + (h)) * HTB)
#define PG8_SB(b, h) ((4 + (b) * 2 + (h)) * HTB)
#define PG8_STAGE(bufoff, gbase, voff) do { _Pragma("unroll") for (int _i = 0; _i < 2; ++_i) \
        __builtin_amdgcn_global_load_lds((const unsigned*)((const char*)(gbase) + (voff)[_i]), (PG8_LAS unsigned*)(lds + (bufoff) + ldsw + _i * 8192), 16, 0, 0); } while (0)
#define PG8_STAGE_A(bufoff, kptr, h, goff) do { _Pragma("unroll") for (int _i = 0; _i < 2; ++_i) \
        __builtin_amdgcn_global_load_lds((const unsigned*)((const char*)(kptr) + (GATHER ? (goff)[h][_i] : (voffA[_i] + (unsigned)((h) * hstep)))), (PG8_LAS unsigned*)(lds + (bufoff) + ldsw + _i * 8192), 16, 0, 0); } while (0)
#define PG8_LD16(p) (*(const PG8_LAS v4i*)(p))
#define PG8_LDA(dst, b, h) do { if constexpr (FP8) { _Pragma("unroll") for (int m = 0; m < 4; ++m) { const v4i lo_ = PG8_LD16(lds + PG8_SA(b, h) + aoff + m * 2048), hi_ = PG8_LD16(lds + PG8_SA(b, h) + aoff + m * 2048 + 16); \
            dst##8[m] = __builtin_shufflevector(lo_, hi_, 0, 1, 2, 3, 4, 5, 6, 7); } } \
        else { _Pragma("unroll") for (int m = 0; m < 4; ++m) _Pragma("unroll") for (int k = 0; k < 2; ++k) dst[m][k] = *(const PG8_LAS bf16x8*)(lds + PG8_SA(b, h) + aoff + m * 2048 + k * 1024); } } while (0)
#define PG8_LDB(dst, b, h) do { if constexpr (FP8) { _Pragma("unroll") for (int n = 0; n < 2; ++n) { const v4i lo_ = PG8_LD16(lds + PG8_SB(b, h) + boff + n * 2048), hi_ = PG8_LD16(lds + PG8_SB(b, h) + boff + n * 2048 + 16); \
            dst##8[n] = __builtin_shufflevector(lo_, hi_, 0, 1, 2, 3, 4, 5, 6, 7); } } \
        else { _Pragma("unroll") for (int n = 0; n < 2; ++n) _Pragma("unroll") for (int k = 0; k < 2; ++k) dst[n][k] = *(const PG8_LAS bf16x8*)(lds + PG8_SB(b, h) + boff + n * 2048 + k * 1024); } } while (0)
#define PG8_MMA(ai, bj, At, Bt) do { __builtin_amdgcn_s_setprio(1); _Pragma("unroll") for (int m = 0; m < 4; ++m) _Pragma("unroll") for (int n = 0; n < 2; ++n) { \
        if constexpr (FP8) { asm volatile("v_mfma_scale_f32_16x16x128_f8f6f4 %0, %1, %2, %0, %3, %4 op_sel_hi:[0,0,0]" : "+v"(acc[ai][bj][m][n]) : "v"(Bt##8[n]), "v"(At##8[m]), "v"(wsc_), "v"(one_)); } \
        else { _Pragma("unroll") for (int k = 0; k < 2; ++k) acc[ai][bj][m][n] = __builtin_amdgcn_mfma_f32_16x16x32_bf16(Bt[n][k], At[m][k], acc[ai][bj][m][n], 0, 0, 0); } } \
        __builtin_amdgcn_s_setprio(0); } while (0)
#define PG8_WAIT_V(n) asm volatile("s_waitcnt vmcnt(" #n ")" ::: "memory")
#define PG8_WAIT_L(n) asm volatile("s_waitcnt lgkmcnt(" #n ")" ::: "memory")
#define PG8_BAR __builtin_amdgcn_s_barrier()
#define PG8_SCHED __builtin_amdgcn_sched_barrier(0)
    Unit cur, nxt; int ui = 0;
    if (!S.next(0, cur)) return;
    f32x4 acc[2][2][4][2];
#pragma unroll
    for (int a = 0; a < 2; ++a)
#pragma unroll
        for (int b = 0; b < 2; ++b)
#pragma unroll
            for (int m = 0; m < 4; ++m)
#pragma unroll
                for (int n = 0; n < 2; ++n) acc[a][b][m][n] = (f32x4){0.f, 0.f, 0.f, 0.f};
    bf16x8 At[4][2], B0[2][2], B1[2][2];
    v8i At8[4], B08[2], B18[2];
    int wsc_ = WSCALE_WORD, one_ = 0x7f7f7f7f; asm volatile("" : "+v"(wsc_), "+v"(one_));
    const char* cA = cur.A; const char* cB = cur.B;
    unsigned goffC[2][2] = {{0u, 0u}, {0u, 0u}};
    if constexpr (GATHER) {
#pragma unroll
        for (int h = 0; h < 2; ++h)
#pragma unroll
            for (int i = 0; i < 2; ++i) { int R_, C_; stage_rc(tid * 16 + i * 8192, R_, C_); goffC[h][i] = (unsigned)((S.row_base(cur) + S.rows(cur)[h * HALF + R_]) * KB + C_ * 2); }
    }
    if constexpr (SP2) {
        PG8_STAGE(PG8_SB(0, 0), cB, voffB); PG8_STAGE(PG8_SB(0, 1), cB + hstep, voffB); PG8_STAGE_A(PG8_SA(0, 0), cA, 0, goffC); PG8_STAGE_A(PG8_SA(0, 1), cA, 1, goffC);
        if (wr == 1) PG8_BAR;
        PG8_WAIT_V(2); PG8_BAR;
        PG8_STAGE(PG8_SB(1, 0), cB + kstep, voffB); PG8_STAGE_A(PG8_SA(1, 0), cA + kstep, 0, goffC); PG8_STAGE(PG8_SB(1, 1), cB + hstep + kstep, voffB);
        PG8_WAIT_V(6); PG8_BAR;
    } else {
        PG8_STAGE(PG8_SB(0, 0), cB, voffB); PG8_STAGE_A(PG8_SA(0, 0), cA, 0, goffC); PG8_STAGE(PG8_SB(0, 1), cB + hstep, voffB); PG8_STAGE_A(PG8_SA(0, 1), cA, 1, goffC);
        if (wr == 1) PG8_BAR;
        PG8_WAIT_V(4); PG8_BAR;
        PG8_STAGE(PG8_SB(1, 0), cB + kstep, voffB); PG8_STAGE_A(PG8_SA(1, 0), cA + kstep, 0, goffC); PG8_STAGE(PG8_SB(1, 1), cB + hstep + kstep, voffB);
        PG8_WAIT_V(6); PG8_BAR;
    }
    for (;;) {
        const bool has_next = S.next(ui + 1, nxt);
        const char* nA = has_next ? nxt.A : cA; const char* nB = has_next ? nxt.B : cB;
        if constexpr (GATHER) {
            if (has_next && wid < 4) __builtin_amdgcn_global_load_lds((const unsigned*)(S.rows(nxt) + tid), (PG8_LAS unsigned*)(lds + GIDX_OFF + ((ui + 1) & 1) * 1024 + wid * 256), 4, 0, 0);
        }
#pragma unroll 1
        for (int t = 0; t < nt; t += 2) {
            const bool last = (t == nt - 2);
            const char* a1 = cA + (size_t)(t + 1) * kstep;
            const char* a2 = last ? nA : cA + (size_t)(t + 2) * kstep; const char* b2 = last ? nB : cB + (size_t)(t + 2) * kstep;
            const char* a3 = a2 + kstep; const char* b3 = b2 + kstep;
            if constexpr (SP2) {
            PG8_LDB(B0, 0, 0); PG8_LDB(B1, 0, 1); PG8_SCHED; PG8_LDA(At, 0, 0); PG8_STAGE_A(PG8_SA(1, 1), a1, 1, goffC);
            if constexpr (GATHER) { if (last && has_next) { const PG8_LAS int* mb = (const PG8_LAS int*)(lds + GIDX_OFF + ((ui + 1) & 1) * 1024); const int rb = S.row_base(nxt);
                _Pragma("unroll") for (int h = 0; h < 2; ++h) _Pragma("unroll") for (int i = 0; i < 2; ++i) { int R_, C_; stage_rc(tid * 16 + i * 8192, R_, C_); goffC[h][i] = (unsigned)((rb + mb[h * HALF + R_]) * KB + C_ * 2); } } }
            PG8_WAIT_V(8); PG8_WAIT_L(0); PG8_BAR; PG8_MMA(0, 0, At, B0); PG8_MMA(0, 1, At, B1); PG8_BAR; PG8_SCHED;
            PG8_LDA(At, 0, 1); PG8_STAGE(PG8_SB(0, 0), b2, voffB); PG8_STAGE(PG8_SB(0, 1), b2 + hstep, voffB); PG8_STAGE_A(PG8_SA(0, 0), a2, 0, goffC);
            PG8_WAIT_V(8); PG8_WAIT_L(0); PG8_BAR; PG8_MMA(1, 0, At, B0); PG8_MMA(1, 1, At, B1); PG8_BAR; PG8_SCHED;
            PG8_LDB(B0, 1, 0); PG8_LDB(B1, 1, 1); PG8_SCHED; PG8_LDA(At, 1, 0); PG8_STAGE_A(PG8_SA(0, 1), a2, 1, goffC);
            PG8_WAIT_V(8); PG8_WAIT_L(0); PG8_BAR; PG8_MMA(0, 0, At, B0); PG8_MMA(0, 1, At, B1); PG8_BAR; PG8_SCHED;
            PG8_LDA(At, 1, 1); PG8_STAGE(PG8_SB(1, 0), b3, voffB); PG8_STAGE(PG8_SB(1, 1), b3 + hstep, voffB); PG8_STAGE_A(PG8_SA(1, 0), a3, 0, goffC);
            PG8_WAIT_V(8); PG8_WAIT_L(0); PG8_BAR; PG8_MMA(1, 0, At, B0); PG8_MMA(1, 1, At, B1); PG8_BAR; PG8_SCHED;
            } else {
            PG8_LDB(B0, 0, 0); PG8_SCHED; PG8_LDA(At, 0, 0); PG8_STAGE_A(PG8_SA(1, 1), a1, 1, goffC);
            if constexpr (GATHER) { if (last && has_next) { const PG8_LAS int* mb = (const PG8_LAS int*)(lds + GIDX_OFF + ((ui + 1) & 1) * 1024); const int rb = S.row_base(nxt);
                _Pragma("unroll") for (int h = 0; h < 2; ++h) _Pragma("unroll") for (int i = 0; i < 2; ++i) { int R_, C_; stage_rc(tid * 16 + i * 8192, R_, C_); goffC[h][i] = (unsigned)((rb + mb[h * HALF + R_]) * KB + C_ * 2); } } }
            PG8_WAIT_L(8); PG8_BAR; PG8_WAIT_L(0); PG8_MMA(0, 0, At, B0); PG8_BAR; PG8_SCHED;
            PG8_LDB(B1, 0, 1); PG8_STAGE(PG8_SB(0, 0), b2, voffB);
            PG8_BAR; PG8_WAIT_L(0); PG8_MMA(0, 1, At, B1); PG8_BAR;
            PG8_LDA(At, 0, 1); PG8_STAGE_A(PG8_SA(0, 0), a2, 0, goffC);
            PG8_BAR; PG8_WAIT_L(0); PG8_MMA(1, 0, At, B0); PG8_BAR; PG8_SCHED;
            PG8_STAGE(PG8_SB(0, 1), b2 + hstep, voffB);
            PG8_WAIT_V(6); PG8_BAR; PG8_MMA(1, 1, At, B1); PG8_BAR;
            PG8_LDB(B0, 1, 0); PG8_SCHED; PG8_LDA(At, 1, 0); PG8_STAGE_A(PG8_SA(0, 1), a2, 1, goffC);
            PG8_WAIT_L(8); PG8_BAR; PG8_WAIT_L(0); PG8_MMA(0, 0, At, B0); PG8_BAR; PG8_SCHED;
            PG8_LDB(B1, 1, 1); PG8_STAGE(PG8_SB(1, 0), b3, voffB);
            PG8_BAR; PG8_WAIT_L(0); PG8_MMA(0, 1, At, B1); PG8_BAR;
            PG8_LDA(At, 1, 1); PG8_STAGE_A(PG8_SA(1, 0), a3, 0, goffC);
            PG8_BAR; PG8_WAIT_L(0); PG8_MMA(1, 0, At, B0); PG8_BAR; PG8_SCHED;
            PG8_STAGE(PG8_SB(1, 1), b3 + hstep, voffB);
            PG8_WAIT_V(6); PG8_BAR; PG8_MMA(1, 1, At, B1); PG8_BAR;
            }
        }
        if constexpr (ALIGN_EPI) { if (wr == 0) PG8_BAR; }
        if constexpr (FP8) {
#pragma unroll
            for (int b_ = 0; b_ < 2; ++b_) asm volatile("s_nop 15\n\ts_nop 15" : "+v"(acc[1][b_][0][0]), "+v"(acc[1][b_][0][1]), "+v"(acc[1][b_][1][0]), "+v"(acc[1][b_][1][1]), "+v"(acc[1][b_][2][0]), "+v"(acc[1][b_][2][1]), "+v"(acc[1][b_][3][0]), "+v"(acc[1][b_][3][1]));
        }
        if constexpr (Side::ON) {
            E.half(acc, cur, wr, wc, fr, fq, 0); asm volatile("" ::: "memory"); __builtin_amdgcn_sched_barrier(0);
            const bool son = SD.has(ui); const char* sp = son ? (const char*)SD.src(ui) : nullptr; const unsigned sst = SD.row_stride_bytes();
            if (son) {
#define PG8_SLD(R, r) asm volatile("global_load_dwordx4 %0, %1, off nt" : "=v"(R) : "v"(sp + (size_t)(r) * sst) : "memory")
                PG8_SLD(acc[0][0][0][0], 0); PG8_SLD(acc[0][0][0][1], 1); PG8_SLD(acc[0][0][1][0], 2); PG8_SLD(acc[0][0][1][1], 3);
                PG8_SLD(acc[0][0][2][0], 4); PG8_SLD(acc[0][0][2][1], 5); PG8_SLD(acc[0][0][3][0], 6); PG8_SLD(acc[0][0][3][1], 7);
#undef PG8_SLD
            }
            __builtin_amdgcn_sched_barrier(0);
            E.half(acc, cur, wr, wc, fr, fq, 1);
            if (son) {
                asm volatile("s_waitcnt vmcnt(0)" : "+v"(acc[0][0][0][0]), "+v"(acc[0][0][0][1]), "+v"(acc[0][0][1][0]), "+v"(acc[0][0][1][1]), "+v"(acc[0][0][2][0]), "+v"(acc[0][0][2][1]), "+v"(acc[0][0][3][0]), "+v"(acc[0][0][3][1]) :: "memory");
                const f32x4 sv_[8] = {acc[0][0][0][0], acc[0][0][0][1], acc[0][0][1][0], acc[0][0][1][1], acc[0][0][2][0], acc[0][0][2][1], acc[0][0][3][0], acc[0][0][3][1]};
                SD.finish(ui, sv_);
            }
        }
        else E(acc, cur, wr, wc, fr, fq);
        if (!has_next) break;
#pragma unroll
        for (int a = 0; a < 2; ++a)
#pragma unroll
            for (int b = 0; b < 2; ++b)
#pragma unroll
                for (int m = 0; m < 4; ++m)
#pragma unroll
                    for (int n = 0; n < 2; ++n) acc[a][b][m][n] = (f32x4){0.f, 0.f, 0.f, 0.f};
        cur = nxt; cA = nA; cB = nB; ++ui;
        if constexpr (ALIGN_EPI) { if (wr == 1) PG8_BAR; }
    }
    PG8_WAIT_V(0);
    if constexpr (!ALIGN_EPI) { if (wr == 0) PG8_BAR; }
    PG8_BAR;
#undef PG8_SA
#undef PG8_SB
#undef PG8_STAGE
#undef PG8_STAGE_A
#undef PG8_LDA
#undef PG8_LDB
#undef PG8_MMA
#undef PG8_LD16
#undef PG8_WAIT_V
#undef PG8_WAIT_L
#undef PG8_BAR
#undef PG8_SCHED
}
}

constexpr int NWAVES = 8;
constexpr int DM = 1024, NB = 2, SEQ = 8192, MTOK = NB * SEQ;
constexpr int CTXL = 256, MCTX = NB * CTXL, MALL = MTOK + MCTX;
constexpr int NMODV = 6 * DM;
constexpr int CONVC = 512, CONVW = 31, NHEADS = 8, HD = 64, ATTW = 512;
constexpr int NINC = 2560;
constexpr int NEXP = 16, DEXP = 2048, CAP = 1024, MX = NB * NEXP * CAP;
constexpr int GROWS = SEQ / 64;
constexpr int KTILES = SEQ / 32 + CTXL / 32;
constexpr float EPS = 1e-6f;
constexpr float LOG2E = 1.4426950408889634f;

constexpr size_t MiB = 1u << 20;
constexpr size_t WS_CTL = 0, CTL_ZERO_BYTES = 32 * 1024;
constexpr size_t WS_MOD = 1 * MiB;
constexpr size_t WS_AFF = 2 * MiB;
constexpr size_t WS_INV = 3 * MiB;
constexpr size_t WS_TOK = 4 * MiB;
constexpr size_t WS_WT = 4 * MiB + 128 * 1024;
constexpr size_t WS_WIN = 5 * MiB;
constexpr size_t WS_WOUT = 10 * MiB;
constexpr size_t WS_WGU = 12 * MiB;
constexpr size_t WS_WD = 140 * MiB;
constexpr size_t WS_X1 = 204 * MiB;
constexpr size_t WS_YS = 268 * MiB;
constexpr size_t WS_H = 332 * MiB;
constexpr size_t WS_H8 = 240 * MiB;
constexpr size_t WS_WQKV8 = 7 * MiB;
constexpr size_t WS_U = 365 * MiB;
constexpr size_t WS_Q = 381 * MiB;
constexpr size_t WS_K = 397 * MiB;
constexpr size_t WS_VT = WS_K + 16 * MiB + 512 * 1024;
constexpr size_t WS_MIX = 430 * MiB;
constexpr size_t WS_HID = 332 * MiB;
constexpr size_t WS_H2 = 462 * MiB;
constexpr size_t WS_END = 494 * MiB;
static_assert(WS_VT + (size_t)512 * MALL * 2 <= WS_MIX && WS_HID + (size_t)MX * DEXP * 2 <= WS_H2, "ws map");

constexpr int CW_TMO = 0, CW_CODE = 1;
constexpr int CW_BAR = 4096;
constexpr int CW_WQ = 2048;
constexpr int CW_ARR3 = 2304, CW_ARR4 = 3072, CW_ARRS = 8;
constexpr int CW_ARR0 = 2112, CW_ARR5 = 2176;

constexpr int RING_OFF = 0, RING_BYTES = 131072;
constexpr int LDSCTL_OFF = RING_BYTES, MISC_OFF = LDSCTL_OFF + 320;
constexpr int LDS_BYTES = 163840;
static_assert(MISC_OFF + 128 + 8 * 15 * 32 * 4 <= LDS_BYTES, "LDS map");

#define GAS __attribute__((address_space(1)))
#define LAS __attribute__((address_space(3)))
typedef unsigned short bf16;
typedef unsigned v4u __attribute__((ext_vector_type(4)));
typedef unsigned v2u __attribute__((ext_vector_type(2)));
typedef float f32x4 __attribute__((ext_vector_type(4)));
typedef float f32x16 __attribute__((ext_vector_type(16)));
typedef float f32x2 __attribute__((ext_vector_type(2)));
typedef short bf16x8 __attribute__((ext_vector_type(8)));
typedef GAS unsigned gu32;
#define RLX_AGENT __ATOMIC_RELAXED, __HIP_MEMORY_SCOPE_AGENT
#define LDS_WAIT() asm volatile("s_waitcnt lgkmcnt(0)" ::: "memory")
#define VM_WAIT() asm volatile("s_waitcnt vmcnt(0)" ::: "memory")
__device__ __forceinline__ unsigned f2bf(float f) { unsigned u = __builtin_bit_cast(unsigned, f); return (u + 0x7fffu + ((u >> 16) & 1u)) >> 16; }
__device__ __forceinline__ unsigned pk2(float lo, float hi) { return f2bf(lo) | (f2bf(hi) << 16); }
__device__ __forceinline__ float bf_lo(unsigned w) { return __builtin_bit_cast(float, w << 16); }
__device__ __forceinline__ float bf_hi(unsigned w) { return __builtin_bit_cast(float, w & 0xffff0000u); }
__device__ __forceinline__ unsigned pk4_fp8(float a, float b, float c, float d) { int w = 0; w = __builtin_amdgcn_cvt_pk_fp8_f32(a, b, w, false); w = __builtin_amdgcn_cvt_pk_fp8_f32(c, d, w, true); return (unsigned)w; }
__device__ __forceinline__ float clamp448(float x) { return __builtin_fminf(__builtin_fmaxf(x, -448.f), 448.f); }
__device__ __forceinline__ float fast_sigmoid(float x) { return __builtin_amdgcn_rcpf(1.0f + __builtin_amdgcn_exp2f(-x * LOG2E)); }

#define XB_TMO      128
#define XB_XCNT(j)  (256  + 64 * (j))
#define XB_XSUB(j)  (1280 + 64 * (j))
#define XB_XGEN(j)  (2304 + 64 * (j))
#define XB_TOP      3328
#define XB_TOPGEN   3392
#define XCD_BAR_WORDS 3456
#define XB_SPIN_CAP (1u << 18)
__device__ __forceinline__ unsigned xb_ld(unsigned* p)              { return __hip_atomic_load(p, __ATOMIC_RELAXED, __HIP_MEMORY_SCOPE_AGENT); }
__device__ __forceinline__ unsigned xb_add(unsigned* p, unsigned v) { return __hip_atomic_fetch_add(p, v, __ATOMIC_RELAXED, __HIP_MEMORY_SCOPE_AGENT); }
__device__ __forceinline__ unsigned xb_xcc_id() { return (unsigned)__builtin_amdgcn_s_getreg((3 << 11) | 20) & 0xFu; }
#define XB_SPIN(cond, bar) do { unsigned _sp = 0; while (cond) { __builtin_amdgcn_s_sleep(1); \
    if ((++_sp & 255u) == 0u) { if (xb_ld(&(bar)[XB_TMO])) break; if (_sp > XB_SPIN_CAP) { atomicAdd(&(bar)[XB_TMO], 1u); break; } } } } while (0)
struct XcdBarrier { unsigned* bar; unsigned x; volatile LAS unsigned* st; };
__device__ __forceinline__ XcdBarrier xcd_barrier_post(unsigned* bar, volatile LAS unsigned* st) {
    XcdBarrier b; b.bar = bar; b.x = xb_xcc_id(); b.st = st;
    if (threadIdx.x == 0) (void)xb_add(&bar[XB_XCNT(b.x)], 1u);
    return b;
}
__device__ __forceinline__ void xcd_barrier_complete(unsigned* bar, unsigned x, unsigned& nloc, unsigned& nx) {
    const unsigned G = gridDim.x * gridDim.y * gridDim.z;
    unsigned sum, cnt, mine, sp = 0u;
    for (;;) {
        sum = 0u; cnt = 0u; mine = 0u;
#pragma unroll
        for (unsigned j = 0; j < 16; ++j) { const unsigned c = xb_ld(&bar[XB_XCNT(j)]); sum += c; cnt += (c > 0u) ? 1u : 0u; mine = (j == x) ? c : mine; }
        if (sum == G) break;
        __builtin_amdgcn_s_sleep(1);
        if ((++sp & 255u) == 0u) { if (xb_ld(&bar[XB_TMO])) break; if (sp > XB_SPIN_CAP) { atomicAdd(&bar[XB_TMO], 1u); break; } }
    }
    nloc = mine > 0u ? mine : 1u; nx = cnt > 0u ? cnt : 1u;
}
__device__ __forceinline__ void xcd_barrier(const XcdBarrier& b) {
    asm volatile("s_waitcnt vmcnt(0)" ::: "memory");
    __syncthreads();
    if (threadIdx.x == 0) {
        unsigned* bar = b.bar;
        __builtin_amdgcn_s_waitcnt(0);
        unsigned nloc = b.st[0], nx = b.st[1];
        if (nloc == 0u) { xcd_barrier_complete(bar, b.x, nloc, nx); b.st[0] = nloc; b.st[1] = nx; }
        const unsigned old = xb_add(&bar[XB_XSUB(b.x)], 1u);
        const unsigned gen = old / nloc;
        if (old + 1u == (gen + 1u) * nloc) {
            __builtin_amdgcn_fence(__ATOMIC_RELEASE, "agent");
            asm volatile("s_waitcnt vmcnt(0)" ::: "memory");
            const unsigned og = xb_add(&bar[XB_TOP], 1u);
            const unsigned tg = og / nx;
            if (og + 1u == (tg + 1u) * nx) xb_add(&bar[XB_TOPGEN], 1u);
            else XB_SPIN(xb_ld(&bar[XB_TOPGEN]) == tg, bar);
            __builtin_amdgcn_fence(__ATOMIC_ACQUIRE, "agent");
            xb_add(&bar[XB_XGEN(b.x)], 1u);
            asm volatile("s_waitcnt vmcnt(0)" ::: "memory");
        } else {
            XB_SPIN(xb_ld(&bar[XB_XGEN(b.x)]) == gen, bar);
            __builtin_amdgcn_fence(__ATOMIC_ACQUIRE, "agent");
            asm volatile("s_waitcnt vmcnt(0)" ::: "memory");
        }
    }
    __syncthreads();
}

__device__ __forceinline__ void st_wt(float* p, float v) { __hip_atomic_store(p, v, __ATOMIC_RELAXED, __HIP_MEMORY_SCOPE_AGENT); }
__device__ __forceinline__ void st_wt16(void* p, v4u v) { asm volatile("global_store_dwordx4 %0, %1, off sc1\n\ts_nop 1" :: "v"(p), "v"(v) : "memory"); }
__device__ __forceinline__ void st_wt8(void* p, v2u v) { __hip_atomic_store((unsigned long long*)p, ((unsigned long long)v.y << 32) | v.x, __ATOMIC_RELAXED, __HIP_MEMORY_SCOPE_AGENT); }
__device__ __forceinline__ void arrive_counter(unsigned* cnt) {
    asm volatile("s_waitcnt vmcnt(0)" ::: "memory"); __syncthreads();
    if (threadIdx.x == 0) __hip_atomic_fetch_add(cnt, 1u, __ATOMIC_RELAXED, __HIP_MEMORY_SCOPE_AGENT);
}
__device__ __forceinline__ void arrive_counter2(unsigned* cnt, unsigned* total) {
    asm volatile("s_waitcnt vmcnt(0)" ::: "memory"); __syncthreads();
    if (threadIdx.x == 0) { __hip_atomic_fetch_add(cnt, 1u, __ATOMIC_RELAXED, __HIP_MEMORY_SCOPE_AGENT); __hip_atomic_fetch_add(total, 1u, __ATOMIC_RELAXED, __HIP_MEMORY_SCOPE_AGENT); }
}
__device__ __forceinline__ void wait_counter(unsigned* cnt, unsigned need, unsigned* tmo) {
    if (threadIdx.x == 0) {
        unsigned sp = 0u;
        while (__hip_atomic_load(cnt, __ATOMIC_RELAXED, __HIP_MEMORY_SCOPE_AGENT) < need) { __builtin_amdgcn_s_sleep(2); if (++sp > (1u << 20)) { __hip_atomic_store(tmo, 1u, __ATOMIC_RELAXED, __HIP_MEMORY_SCOPE_AGENT); break; } }
        __builtin_amdgcn_fence(__ATOMIC_ACQUIRE, "agent");
        asm volatile("s_waitcnt vmcnt(0)" ::: "memory");
    }
    __syncthreads();
}

struct Args { const float* in[20]; float* out; unsigned char* ws; int ph_lo, ph_hi; };
struct Frame {
    LAS unsigned char* lds;
    volatile LAS unsigned* MISC;
    int tid, lane, wave;
    int vcu, G;
    const Args* a;
    unsigned long long pacc;
};
#ifndef PROBE_SEC
#define PROBE_SEC 0
#endif
#define SEC_BEGIN(id) unsigned long long sec_t0_##id = 0ull; if (PROBE_SEC == (id)) { __builtin_amdgcn_s_barrier(); sec_t0_##id = __builtin_amdgcn_s_memrealtime(); }
#define SEC_END(id) if (PROBE_SEC == (id)) { __builtin_amdgcn_s_barrier(); F.pacc += __builtin_amdgcn_s_memrealtime() - sec_t0_##id; }
#define FIN(name, idx) (F.a->in[idx])
#define F_x FIN(x, 0)
#define F_c FIN(c, 1)
#define F_ctx FIN(ctx, 2)
#define F_c_ctx FIN(c_ctx, 3)
#define F_w_mod FIN(w_mod, 4)
#define F_b_mod FIN(b_mod, 5)
#define F_norm_mix_g FIN(norm_mix_g, 6)
#define F_w_in FIN(w_in, 7)
#define F_conv_w FIN(conv_w, 8)
#define F_conv_b FIN(conv_b, 9)
#define F_conv_ln_g FIN(conv_ln_g, 10)
#define F_conv_ln_b FIN(conv_ln_b, 11)
#define F_rpb FIN(rpb, 12)
#define F_w_out FIN(w_out, 13)
#define F_norm_ffn_g FIN(norm_ffn_g, 14)
#define F_w_router FIN(w_router, 15)
#define F_w_gate FIN(w_gate, 16)
#define F_w_up FIN(w_up, 17)
#define F_w_down FIN(w_down, 18)
#define F_norm_final_g FIN(norm_final_g, 19)
#define F_out (F.a->out)
#define WSP(T, off) ((T*)(F.a->ws + (off)))
#define F_MOD WSP(float, WS_MOD)
#define F_AFF WSP(float, WS_AFF)
#define F_INV WSP(int, WS_INV)
#define F_TOK WSP(int, WS_TOK)
#define F_WTS WSP(float, WS_WT)
#define F_X1 WSP(bf16, WS_X1)
#define F_WIN WSP(bf16, WS_WIN)
#define F_WOUT WSP(bf16, WS_WOUT)
#define F_WGU WSP(bf16, WS_WGU)
#define F_WD WSP(bf16, WS_WD)
#define F_YS WSP(bf16, WS_YS)
#define F_H WSP(bf16, WS_H)
#define F_H8 WSP(unsigned char, WS_H8)
#define F_WQKV8 WSP(unsigned char, WS_WQKV8)
#define F_U WSP(bf16, WS_U)
#define F_Q WSP(bf16, WS_Q)
#define F_K WSP(bf16, WS_K)
#define F_VT WSP(bf16, WS_VT)
#define F_MIX WSP(bf16, WS_MIX)
#define F_HID WSP(bf16, WS_HID)
#define F_H2 WSP(bf16, WS_H2)

template <int CTRL> __device__ __forceinline__ float dpp_mov(float v) { return __builtin_bit_cast(float, __builtin_amdgcn_update_dpp(0, __builtin_bit_cast(int, v), CTRL, 0xF, 0xF, true)); }
__device__ __forceinline__ float row16_sum(float v) { v += dpp_mov<0xB1>(v); v += dpp_mov<0x4E>(v); v += dpp_mov<0x141>(v); v += dpp_mov<0x140>(v); return v; }
__device__ __forceinline__ float row16_max(float v) { v = fmaxf(v, dpp_mov<0xB1>(v)); v = fmaxf(v, dpp_mov<0x4E>(v)); v = fmaxf(v, dpp_mov<0x141>(v)); v = fmaxf(v, dpp_mov<0x140>(v)); return v; }
__device__ __forceinline__ float rdlane(float v, int l) { return __builtin_bit_cast(float, __builtin_amdgcn_readlane(__builtin_bit_cast(int, v), l)); }
__device__ __forceinline__ float wave_sum(float v) {
    v = row16_sum(v);
    return (rdlane(v, 0) + rdlane(v, 16)) + (rdlane(v, 32) + rdlane(v, 48));
}
__device__ __forceinline__ float half_sum(float v, int half) {
    v = row16_sum(v);
    const float lo = rdlane(v, 0) + rdlane(v, 16), hi = rdlane(v, 32) + rdlane(v, 48);
    return half ? hi : lo;
}
__device__ __forceinline__ float wave_max(float v) {
#pragma unroll
    for (int o = 1; o < 64; o <<= 1) v = fmaxf(v, __shfl_xor(v, o));
    return v;
}

__device__ __forceinline__ void tr_load(const float* W, int N, int k0, int n0, int lane, f32x4 (&v)[8]) {
    const float* p = W + (size_t)(k0 + 8 * (lane & 7)) * N + n0 + 4 * (lane >> 3);
#pragma unroll
    for (int r = 0; r < 8; ++r) v[r] = __builtin_nontemporal_load((const f32x4*)(p + (size_t)r * N));
}
__device__ __forceinline__ void tr_store(const f32x4 (&v)[8], bf16* WT, int Kdst, int drow0, int k0, int lane) {
    bf16* q = WT + (size_t)(drow0 + 4 * (lane >> 3)) * Kdst + k0 + 8 * (lane & 7);
#pragma unroll
    for (int c = 0; c < 4; ++c) { v4u o; o.x = pk2(v[0][c], v[1][c]); o.y = pk2(v[2][c], v[3][c]); o.z = pk2(v[4][c], v[5][c]); o.w = pk2(v[6][c], v[7][c]);
        *(GAS v4u*)(q + (size_t)c * Kdst) = o; }
}
__device__ __forceinline__ void transpose_item(const float* W, int N, int k0, int n0, bf16* WT, int Kdst, int drow0, int lane) {
    f32x4 v[8]; tr_load(W, N, k0, n0, lane, v); tr_store(v, WT, Kdst, drow0, k0, lane);
}

__device__ __forceinline__ void tr8_load(const float* W, int N, int k0, int n0, int lane, f32x4 (&v)[16]);
__device__ __forceinline__ void tr8_store(const f32x4 (&v)[16], unsigned char* WT, int Kdst, int drow0, int k0, int lane, const float WPRESCALE);
constexpr int P1_RW = 2, P1_IT = 4;
__device__ __forceinline__ void p1_load(Frame& F, f32x4 (&xv)[P1_IT][P1_RW][4]);
__device__ __forceinline__ void p0_prologue(Frame& F, f32x4 (&xv)[P1_IT][P1_RW][4]) {
    {
        LAS float* sl = (LAS float*)(F.lds + RING_OFF);
        LAS float* part = sl + 3 * DM;
        for (int i = F.tid; i < 3 * DM; i += NWAVES * 64) { const int r = i >> 10, k = i & 1023; const float cv = (r < 2) ? F_c[r * DM + k] : F_c_ctx[k]; sl[i] = cv * fast_sigmoid(cv); }
        __syncthreads();
        for (int it = F.vcu; it < NMODV / 32; it += F.G) {
            const int c32 = F.lane & 31, n = it * 32 + c32, kb = F.wave * 128 + (F.lane >> 5);
            float wv[64];
#pragma unroll
            for (int i = 0; i < 64; ++i) wv[i] = __builtin_nontemporal_load(&F_w_mod[(size_t)(kb + 2 * i) * NMODV + n]);
            float a0 = 0.f, a1 = 0.f, a2 = 0.f;
#pragma unroll
            for (int i = 0; i < 64; ++i) { const int k = kb + 2 * i; a0 += sl[k] * wv[i]; a1 += sl[DM + k] * wv[i]; a2 += sl[2 * DM + k] * wv[i]; }
            a0 += __shfl_xor(a0, 32); a1 += __shfl_xor(a1, 32); a2 += __shfl_xor(a2, 32);
            if (F.lane < 32) { part[(F.wave * 3 + 0) * 32 + c32] = a0; part[(F.wave * 3 + 1) * 32 + c32] = a1; part[(F.wave * 3 + 2) * 32 + c32] = a2; }
            __syncthreads();
            if (F.tid < 96) { const int r = F.tid >> 5, c = F.tid & 31; float sacc = F_b_mod[it * 32 + c];
#pragma unroll
                for (int w = 0; w < 8; ++w) sacc += part[(w * 3 + r) * 32 + c];
                st_wt(&F_MOD[r * NMODV + it * 32 + c], sacc); }
            arrive_counter((unsigned*)WSP(unsigned, WS_CTL) + CW_ARR0);
        }
        __syncthreads();
    }
    asm volatile("" ::: "memory"); __builtin_amdgcn_sched_barrier(0);
    p1_load(F, xv);
    const int gw = F.vcu * NWAVES + F.wave, NGW = F.G * NWAVES;
    constexpr int I_GLU = (DM / 64) * (1024 / 32);
    constexpr int I_QKV = (DM / 128) * (1536 / 32);
    constexpr int I_OUT = (DM / 64) * (DM / 32);
    for (int it = gw; it < I_GLU + I_QKV + I_OUT; it += NGW) {
        int r = it;
        if (r < I_GLU) { const int kb = r >> 5, n0 = (r & 31) * 32; const int half = n0 >> 9, rem = n0 & 511, drow = 256 * (rem >> 7) + 128 * half + (rem & 127);
            transpose_item(F_w_in, NINC, kb * 64, n0, F_WIN, DM, drow, F.lane); continue; }
        r -= I_GLU;
        if (r < I_QKV) { const int kb = r / 48, nb = r % 48; f32x4 v[16]; tr8_load(F_w_in, NINC, kb * 128, 1024 + nb * 32, F.lane, v); tr8_store(v, F_WQKV8, DM, nb * 32, kb * 128, F.lane, 32.0f); continue; }
        r -= I_QKV;
        { const int nblk = DM / 32, kb = r / nblk, nb = r % nblk; transpose_item(F_w_out, DM, kb * 64, nb * 32, F_WOUT, DM, nb * 32, F.lane); }
    }
}

constexpr int MOE_I_G = (DM / 128) * (DEXP / 32);
constexpr int MOE_I_D = (DEXP / 128) * (DM / 32);
constexpr int MOE_ITEMS = NEXP * (2 * MOE_I_G), MOE_CHUNK = 4, MOE_NCHUNK = MOE_ITEMS / MOE_CHUNK;
constexpr float WPRE = 32.0f;
struct MoeSrc { const float* W; int N, k0, n0; unsigned char* WT; int Kdst, half; };
__device__ __forceinline__ MoeSrc moe_chunk_src(Frame& F, int ch) {
    int r = ch * MOE_CHUNK; MoeSrc m;
    const int e = r / (2 * MOE_I_G); r -= e * (2 * MOE_I_G);
    const int half = r / MOE_I_G; r -= half * MOE_I_G; const int nblk = DEXP / 32;
    m.W = (half ? F_w_up : F_w_gate) + (size_t)e * DM * DEXP; m.N = DEXP; m.k0 = (r / nblk) * 128; m.n0 = (r % nblk) * 32; m.WT = (unsigned char*)F_WGU + (size_t)e * 2 * DEXP * DM; m.Kdst = DM; m.half = half;
    return m;
}
__device__ __forceinline__ float moe_prescale(const MoeSrc& m) { return m.half == 0 ? WPRE * LOG2E : (m.half == 1 ? WPRE / LOG2E : WPRE); }
__device__ __forceinline__ int moe_drow(const MoeSrc& m, int n0) { return m.half == 2 ? n0 : 256 * (n0 >> 7) + 128 * m.half + (n0 & 127); }
__device__ __forceinline__ void tr8_load(const float* W, int N, int k0, int n0, int lane, f32x4 (&v)[16]) {
    const float* p = W + (size_t)(k0 + 16 * (lane & 7)) * N + n0 + 4 * (lane >> 3);
#pragma unroll
    for (int r = 0; r < 16; ++r) v[r] = __builtin_nontemporal_load((const f32x4*)(p + (size_t)r * N));
}
__device__ __forceinline__ void tr8_store(const f32x4 (&v)[16], unsigned char* WT, int Kdst, int drow0, int k0, int lane, const float WPRESCALE = 32.0f) {
    unsigned char* q = WT + (size_t)(drow0 + 4 * (lane >> 3)) * Kdst + k0 + 16 * (lane & 7);
#pragma unroll
    for (int c = 0; c < 4; ++c) { v4u o;
        o.x = pk4_fp8(v[0][c] * WPRESCALE, v[1][c] * WPRESCALE, v[2][c] * WPRESCALE, v[3][c] * WPRESCALE); o.y = pk4_fp8(v[4][c] * WPRESCALE, v[5][c] * WPRESCALE, v[6][c] * WPRESCALE, v[7][c] * WPRESCALE);
        o.z = pk4_fp8(v[8][c] * WPRESCALE, v[9][c] * WPRESCALE, v[10][c] * WPRESCALE, v[11][c] * WPRESCALE); o.w = pk4_fp8(v[12][c] * WPRESCALE, v[13][c] * WPRESCALE, v[14][c] * WPRESCALE, v[15][c] * WPRESCALE);
        *(GAS v4u*)(q + (size_t)c * Kdst) = o; }
}
template <bool STATIC_FIRST>
__device__ __forceinline__ void moe_weights(Frame& F, unsigned* counter, int quota) {
    const int gw = F.vcu * NWAVES + F.wave, NGW = F.G * NWAVES, lane = F.lane;
    int ch;
    if (STATIC_FIRST) ch = gw;
    else { unsigned t0 = 0u; if (lane == 0) t0 = __hip_atomic_fetch_add(counter, 1u, __ATOMIC_RELAXED, __HIP_MEMORY_SCOPE_AGENT); ch = NGW + (int)__builtin_amdgcn_readfirstlane(t0); }
    for (int done = 0; ch < MOE_NCHUNK && done != quota; ++done) {
        const MoeSrc m = moe_chunk_src(F, ch);
        unsigned nx = 0u;
        const bool more = (done + 1 != quota);
        if (more && lane == 0) nx = __hip_atomic_fetch_add(counter, 1u, __ATOMIC_RELAXED, __HIP_MEMORY_SCOPE_AGENT);
        f32x4 va[16], vb[16]; const float wpre = moe_prescale(m);
        tr8_load(m.W, m.N, m.k0, m.n0, lane, va);
#pragma unroll
        for (int k = 0; k < MOE_CHUNK; k += 2) {
            tr8_load(m.W, m.N, m.k0, m.n0 + 32 * (k + 1), lane, vb);
            tr8_store(va, m.WT, m.Kdst, moe_drow(m, m.n0 + 32 * k), m.k0, lane, wpre);
            if (k + 2 < MOE_CHUNK) tr8_load(m.W, m.N, m.k0, m.n0 + 32 * (k + 2), lane, va);
            tr8_store(vb, m.WT, m.Kdst, moe_drow(m, m.n0 + 32 * (k + 1)), m.k0, lane, wpre);
        }
        ch = NGW + (int)__builtin_amdgcn_readfirstlane(nx);
    }
}

constexpr int DOWN_IPE = (DEXP / 64) * (DM / 32);
constexpr int DOWN_ITEMS = NEXP * DOWN_IPE;
struct DownSide {
    static constexpr bool ON = true;
    const float* w_down; unsigned char* WD; int gw, NGW, lane;
    __device__ __forceinline__ bool has(int ui) const { return ui * NGW + gw < DOWN_ITEMS; }
    __device__ __forceinline__ unsigned row_stride_bytes() const { return DM * 4u; }
    __device__ __forceinline__ const void* src(int ui) const {
        int lane = this->lane; asm volatile("" : "+v"(lane));
        const int d = ui * NGW + gw, e = d / DOWN_IPE, r = d % DOWN_IPE, kb = r / (DM / 32), nb = r % (DM / 32);
        return w_down + (size_t)e * DEXP * DM + (size_t)(kb * 64 + 8 * (lane & 7)) * DM + nb * 32 + 4 * (lane >> 3);
    }
    __device__ __forceinline__ void issue(int ui, f32x4 (&v)[8]) const {
        if (!has(ui)) return; const char* p = (const char*)src(ui);
#pragma unroll
        for (int r = 0; r < 8; ++r) v[r] = __builtin_nontemporal_load((const f32x4*)(p + (size_t)r * row_stride_bytes()));
    }
    __device__ __forceinline__ void finish(int ui, const f32x4 (&v)[8]) const {
        int lane = this->lane; asm volatile("" : "+v"(lane));
        const int d = ui * NGW + gw; if (d >= DOWN_ITEMS) return;
        const int e = d / DOWN_IPE, r = d % DOWN_IPE, kb = r / (DM / 32), nb = r % (DM / 32);
        unsigned char* q = WD + (size_t)e * DM * DEXP + (size_t)(nb * 32 + 4 * (lane >> 3)) * DEXP + kb * 64 + 8 * (lane & 7);
#pragma unroll
        for (int c = 0; c < 4; ++c) { v2u o; o.x = pk4_fp8(v[0][c] * WPRE, v[1][c] * WPRE, v[2][c] * WPRE, v[3][c] * WPRE); o.y = pk4_fp8(v[4][c] * WPRE, v[5][c] * WPRE, v[6][c] * WPRE, v[7][c] * WPRE);
            *(GAS v2u*)(q + (size_t)c * DEXP) = o; }
    }
};

__device__ __forceinline__ void p1_load(Frame& F, f32x4 (&xv)[P1_IT][P1_RW][4]) {
    const int gw = F.vcu * NWAVES + F.wave, NGW = F.G * NWAVES, lane = F.lane;
#pragma unroll
    for (int k = 0; k < P1_IT; ++k) { const int pr = gw + k * NGW;
        if (pr < MALL / P1_RW) { const int m0 = P1_RW * pr; const float* xr = (m0 < MTOK) ? F_x + (size_t)m0 * DM : F_ctx + (size_t)(m0 - MTOK) * DM;
#pragma unroll
            for (int q = 0; q < P1_RW; ++q)
#pragma unroll
                for (int j = 0; j < 4; ++j) xv[k][q][j] = __builtin_nontemporal_load((const f32x4*)(xr + (size_t)q * DM + 4 * lane + 256 * j)); } }
}
__device__ __forceinline__ void p1_row_pair(Frame& F, int pr, f32x4 (&v)[P1_RW][4]) {
    const int lane = F.lane, m0 = P1_RW * pr;
    const float* mod = F_MOD + (size_t)((m0 < MTOK) ? (m0 >> 13) : 2) * NMODV;
    float rstd[P1_RW];
#pragma unroll
    for (int q = 0; q < P1_RW; ++q) { float ss = 0.f;
#pragma unroll
        for (int j = 0; j < 4; ++j) ss += (v[q][j].x * v[q][j].x + v[q][j].y * v[q][j].y) + (v[q][j].z * v[q][j].z + v[q][j].w * v[q][j].w);
        rstd[q] = 1.0f / sqrtf(wave_sum(ss) * (1.0f / DM) + EPS); }
#pragma unroll
    for (int j = 0; j < 4; ++j) { const int col = 4 * lane + 256 * j;
        const f32x4 g = *(const GAS f32x4*)(F_norm_mix_g + col), sh = *(const GAS f32x4*)(mod + col), sc = *(const GAS f32x4*)(mod + DM + col);
        const f32x4 gs = g * (1.0f + sc);
#pragma unroll
        for (int q = 0; q < P1_RW; ++q) { const f32x4 h = v[q][j] * rstd[q] * gs + sh;
            v2u w; w.x = pk2(h.x, h.y); w.y = pk2(h.z, h.w); ((GAS v2u*)(F_H + (size_t)(m0 + q) * DM))[lane + 64 * j] = w;
            ((GAS unsigned*)(F_H8 + (size_t)(m0 + q) * DM))[lane + 64 * j] = pk4_fp8(clamp448(h.x), clamp448(h.y), clamp448(h.z), clamp448(h.w)); } }
}
__device__ __forceinline__ void p1_hpass(Frame& F, f32x4 (&xv)[P1_IT][P1_RW][4]) {
    wait_counter((unsigned*)WSP(unsigned, WS_CTL) + CW_ARR0, NMODV / 32, (unsigned*)WSP(unsigned, WS_CTL) + CW_TMO);
    const int gw = F.vcu * NWAVES + F.wave, NGW = F.G * NWAVES, lane = F.lane;
#pragma unroll
    for (int k = 0; k < P1_IT; ++k) { const int pr = gw + k * NGW; if (pr < MALL / P1_RW) p1_row_pair(F, pr, xv[k]); }
    for (int pr = gw + P1_IT * NGW; pr < MALL / P1_RW; pr += NGW) {
        const int m0 = P1_RW * pr; const float* xr = (m0 < MTOK) ? F_x + (size_t)m0 * DM : F_ctx + (size_t)(m0 - MTOK) * DM; f32x4 v[P1_RW][4];
#pragma unroll
        for (int q = 0; q < P1_RW; ++q)
#pragma unroll
            for (int j = 0; j < 4; ++j) v[q][j] = __builtin_nontemporal_load((const f32x4*)(xr + (size_t)q * DM + 4 * lane + 256 * j));
        p1_row_pair(F, pr, v); }
}

struct GluOrder {
    int vcu, G; const char *H, *WIN;
    __device__ __forceinline__ bool next(int i, pg8::Unit& u) const {
        const size_t tstep = (size_t)256 * DM * 2;
        int pm, pn;
        if (G == 256) { if (i > 0) return false; const int x = vcu >> 5, s = vcu & 31; pm = 8 * x + (s & 7); pn = s >> 3; }
        else { const int L = i * G + vcu; if (L >= 256) return false; pm = L >> 2; pn = L & 3; }
        u.pm = pm; u.pn = pn; u.kind = 0; u.A = H + (size_t)pm * tstep; u.B = WIN + (size_t)pn * tstep; return true;
    }
};
struct QkvOrder {
    int vcu, G; const char *H8, *W8;
    __device__ __forceinline__ bool next(int i, pg8::Unit& u) const {
        const size_t tstep = (size_t)256 * DM;
        int pm, pn, kind;
        if (G == 256) {
            const int x = vcu >> 5, s = vcu & 31;
            if (i == 0) { pm = 8 * x + (s & 7); pn = 4 + (s >> 3); kind = pn < 6 ? 1 : 2; }
            else if (i == 1) {
                if (s < 16) { kind = 3; pm = s & 1; pn = 8 * x + (s >> 1); }
                else if (s == 16) { if (x < 4) { kind = 3; pm = x & 1; pn = 64 + (x >> 1); } else { kind = 2; pm = 64 + ((x - 4) >> 1); pn = 6 + ((x - 4) & 1); } }
                else return false;
            } else return false;
        } else {
            const int L = i * G + vcu;
            if (L < 256) { pm = L >> 2; pn = 4 + (L & 3); kind = pn < 6 ? 1 : 2; }
            else if (L < 260) { kind = 2; pm = 64 + ((L - 256) >> 1); pn = 6 + ((L - 256) & 1); }
            else if (L < 392) { kind = 3; pm = (L - 260) & 1; pn = (L - 260) >> 1; }
            else return false;
        }
        u.pm = pm; u.pn = pn; u.kind = kind;
        if (kind == 3) { u.A = W8 + (size_t)(4 + pm) * tstep; u.B = H8 + (size_t)pn * tstep; }
        else { u.A = H8 + (size_t)pm * tstep; u.B = W8 + (size_t)(pn - 4) * tstep; }
        return true;
    }
};
struct EpiInProj {
    static constexpr bool PERM = true;
    bf16 *U, *Q, *Kb, *Vt; float qscale;
    __device__ __forceinline__ void operator()(const pg8::f32x4 (&acc)[2][2][4][2], const pg8::Unit& u, int wr, int wc, int fr, int fq) const {
        const int row0 = u.pm * 256 + wr * 64 + fr;
        if (u.kind == 0) {
            const int col0 = u.pn * 128 + wc * 32 + 8 * fq;
#pragma unroll
            for (int ai = 0; ai < 2; ++ai)
#pragma unroll
                for (int m = 0; m < 4; ++m) {
                    float v[8];
#pragma unroll
                    for (int n = 0; n < 2; ++n)
#pragma unroll
                        for (int i = 0; i < 4; ++i) v[4 * n + i] = acc[ai][0][m][n][i] * fast_sigmoid(acc[ai][1][m][n][i]);
                    v4u w; w.x = pg8::cvt_pk_bf16(v[0], v[1]); w.y = pg8::cvt_pk_bf16(v[2], v[3]); w.z = pg8::cvt_pk_bf16(v[4], v[5]); w.w = pg8::cvt_pk_bf16(v[6], v[7]);
                    *(v4u*)(U + (size_t)(row0 + ai * 128 + m * 16) * CONVC + col0) = w; }
        } else if (u.kind == 3) {
            const int b = u.pn < 64 ? (u.pn >> 5) : (u.pn - 64), tb0 = u.pn < 64 ? ((u.pn & 31) << 8) : SEQ;
#pragma unroll
            for (int ai = 0; ai < 2; ++ai)
#pragma unroll
                for (int m = 0; m < 4; ++m) { const int vc = row0 + ai * 128 + m * 16, head = vc >> 6, d = vc & 63;
#pragma unroll
                    for (int bj = 0; bj < 2; ++bj) { const int tb = tb0 + bj * 128 + wc * 32 + 8 * fq, w0 = tb & 31;
                        const size_t off = ((((size_t)(b * 8 + head) * KTILES + (tb >> 5)) * 2 + (d >> 5)) * 2 + (w0 >> 4)) * 512 + (((w0 >> 3) & 1) * 32 + (d & 31)) * 8;
                        const pg8::f32x4 v0 = acc[ai][bj][m][0], v1 = acc[ai][bj][m][1];
                        v4u w; w.x = pg8::cvt_pk_bf16(v0[0], v0[1]); w.y = pg8::cvt_pk_bf16(v0[2], v0[3]); w.z = pg8::cvt_pk_bf16(v1[0], v1[1]); w.w = pg8::cvt_pk_bf16(v1[2], v1[3]);
                        *(v4u*)(Vt + off) = w; } }
        } else {
            const bool isq = u.kind == 1; const float sc = isq ? qscale : 1.f;
            const int colt = (u.pn - (isq ? 4 : 6)) * 256;
            const int b = u.pm < 64 ? (u.pm >> 5) : (u.pm - 64), tb0 = u.pm < 64 ? ((u.pm & 31) << 8) : SEQ;
            bf16* base = isq ? Q : Kb; const int ntile = isq ? (SEQ / 32) : KTILES;
#pragma unroll
            for (int ai = 0; ai < 2; ++ai)
#pragma unroll
                for (int m = 0; m < 4; ++m) { const int tb = tb0 + wr * 64 + fr + ai * 128 + m * 16; int w = tb & 31; if (!isq) w = (w & 0x13) | ((w & 4) << 1) | ((w & 8) >> 1);
#pragma unroll
                    for (int bj = 0; bj < 2; ++bj) { const int c0 = colt + bj * 128 + wc * 32 + 8 * fq, head = c0 >> 6, d0 = c0 & 63;
                        const size_t off = (((size_t)(b * 8 + head) * ntile + (tb >> 5)) * 4 + (d0 >> 4)) * 512 + (((d0 >> 3) & 1) * 32 + w) * 8;
                        const pg8::f32x4 v0 = acc[ai][bj][m][0] * sc, v1 = acc[ai][bj][m][1] * sc;
                        v4u wv; wv.x = pg8::cvt_pk_bf16(v0[0], v0[1]); wv.y = pg8::cvt_pk_bf16(v0[2], v0[3]); wv.z = pg8::cvt_pk_bf16(v1[0], v1[1]); wv.w = pg8::cvt_pk_bf16(v1[2], v1[3]);
                        *(v4u*)(base + off) = wv; } }
        }
    }
};

constexpr int P3_Y_OFF = 0;
constexpr int P3_BIAS_OFF = 0;
constexpr float ATT_THR = 8.0f;

struct AttnState { f32x16 O[2][2]; float mref[2], lsum[2]; };
template <bool LOCAL>
__device__ __forceinline__ void attn_tile(AttnState& st, const bf16x8 (&Ak)[4], const bf16x8 (&Av)[2][2], const bf16x8 (&Bq)[2][4], const LAS float* btrow, const int half, int q32, int hh) {
    f32x16 S[2];
    if (LOCAL) {
#pragma unroll
        for (int qt = 0; qt < 2; ++qt) { const int qc = 32 * qt + q32; int c0 = qc - 8; c0 = c0 < 0 ? 0 : (c0 > 48 ? 48 : c0);
            const int vb = 8 * hh + 32 * half - c0;
            const LAS float* bp = btrow + (8 * hh + 32 * half - qc + 63);
            const int rlo = (qt != half) ? (qt == 0 ? 0 : 8) : 0, rhi = (qt != half) ? rlo + 8 : 16;
#pragma unroll
            for (int rr = 0; rr < 16; ++rr) { const int kconst = 16 * (rr >> 3) + (rr & 7);
                if (rr >= rlo && rr < rhi) { const float bv = bp[kconst]; S[qt][rr] = ((unsigned)(kconst + vb) < 16u) ? bv : -1e30f; } else S[qt][rr] = 0.f; } }
    } else {
#pragma unroll
        for (int qt = 0; qt < 2; ++qt)
#pragma unroll
            for (int rr = 0; rr < 16; ++rr) S[qt][rr] = 0.f;
    }
#pragma unroll
    for (int qt = 0; qt < 2; ++qt)
#pragma unroll
        for (int ds = 0; ds < 4; ++ds) S[qt] = __builtin_amdgcn_mfma_f32_32x32x16_bf16(Ak[ds], Bq[qt][ds], S[qt], 0, 0, 0);
#pragma unroll
    for (int qt = 0; qt < 2; ++qt) {
        const bool corner = LOCAL && (qt != half);
        const int rlo = corner ? (qt == 0 ? 0 : 8) : 0, rhi = corner ? rlo + 8 : 16;
        float tm = fmaxf(S[qt][rlo], S[qt][rlo + 1]);
#pragma unroll
        for (int rr = rlo + 2; rr < rhi; ++rr) tm = fmaxf(tm, S[qt][rr]);
        tm = fmaxf(tm, __shfl_xor(tm, 32));
        if (__any(tm > st.mref[qt] + ATT_THR)) {
            const float mn = fmaxf(st.mref[qt], tm), sc = __builtin_amdgcn_exp2f(st.mref[qt] - mn);
            st.mref[qt] = mn; st.lsum[qt] *= sc;
#pragma unroll
            for (int i = 0; i < 16; ++i) { st.O[0][qt][i] *= sc; st.O[1][qt][i] *= sc; }
        }
        float p[16]; float ps = 0.f;
#pragma unroll
        for (int rr = 0; rr < 16; ++rr) { if (rr >= rlo && rr < rhi) { p[rr] = __builtin_amdgcn_exp2f(S[qt][rr] - st.mref[qt]); ps += p[rr]; } else p[rr] = 0.f; }
        st.lsum[qt] += ps;
#pragma unroll
        for (int s2 = 0; s2 < 2; ++s2) {
            if (8 * s2 >= rlo && 8 * s2 < rhi) {
                v4u w; w.x = pg8::cvt_pk_bf16(p[8 * s2 + 0], p[8 * s2 + 1]); w.y = pg8::cvt_pk_bf16(p[8 * s2 + 2], p[8 * s2 + 3]); w.z = pg8::cvt_pk_bf16(p[8 * s2 + 4], p[8 * s2 + 5]); w.w = pg8::cvt_pk_bf16(p[8 * s2 + 6], p[8 * s2 + 7]);
                const bf16x8 Bp = __builtin_bit_cast(bf16x8, w);
#pragma unroll
                for (int dt = 0; dt < 2; ++dt) st.O[dt][qt] = __builtin_amdgcn_mfma_f32_32x32x16_bf16(Av[dt][s2], Bp, st.O[dt][qt], 0, 0, 0);
            }
        }
    }
}
#define ATT_LOADK(AK, TILE) do { _Pragma("unroll") for (int ds = 0; ds < 4; ++ds) AK[ds] = *(const GAS bf16x8*)(Kh + ((size_t)(TILE) * 4 + ds) * 512); } while (0)
#define ATT_LOADV(AV, TILE) do { _Pragma("unroll") for (int dt = 0; dt < 2; ++dt) _Pragma("unroll") for (int s2 = 0; s2 < 2; ++s2) AV[dt][s2] = *(const GAS bf16x8*)(Vh + (((size_t)(TILE) * 2 + dt) * 2 + s2) * 512); } while (0)
__device__ __forceinline__ void attn_wave(Frame& F, int b, int r) {
    const int lane = F.lane, head = F.wave, q32 = lane & 31, hh = lane >> 5;
    const LAS float* bt = (const LAS float*)(F.lds + P3_BIAS_OFF) + head * 15 * 128;
    const int tok0 = b * SEQ + r * 64;
    bf16x8 Bq[2][4];
#pragma unroll
    for (int qt = 0; qt < 2; ++qt)
#pragma unroll
        for (int ds = 0; ds < 4; ++ds) Bq[qt][ds] = *(const GAS bf16x8*)(F_Q + ((((size_t)(b * 8 + head) * (SEQ / 32) + 2 * r + qt) * 4 + ds) * 64 + lane) * 8);
    AttnState st;
#pragma unroll
    for (int a = 0; a < 2; ++a)
#pragma unroll
        for (int c = 0; c < 2; ++c)
#pragma unroll
            for (int i = 0; i < 16; ++i) st.O[a][c][i] = 0.f;
    st.mref[0] = st.mref[1] = -1e30f; st.lsum[0] = st.lsum[1] = 0.f;
    int r0 = r - 4; r0 = r0 < 0 ? 0 : (r0 > GROWS - 8 ? GROWS - 8 : r0);
    const bf16* Kh = F_K + (size_t)(b * 8 + head) * KTILES * 2048 + lane * 8;
    const bf16* Vh = F_VT + (size_t)(b * 8 + head) * KTILES * 2048 + lane * 8;
    const int ctx0 = SEQ / 32, loc0 = 2 * r0;
    bf16x8 Ka[4], Kb[4], Vc[2][2];
    ATT_LOADK(Ka, ctx0);
#pragma unroll 1
    for (int t = 0; t < 8; t += 2) {
        ATT_LOADV(Vc, ctx0 + t); ATT_LOADK(Kb, ctx0 + t + 1);
        attn_tile<false>(st, Ka, Vc, Bq, bt, 0, q32, hh);
        ATT_LOADV(Vc, ctx0 + t + 1); { const int nt = (t + 2 < 8) ? ctx0 + t + 2 : loc0; ATT_LOADK(Ka, nt); }
        attn_tile<false>(st, Kb, Vc, Bq, bt, 0, q32, hh);
    }
#pragma unroll 1
    for (int j = 0; j < 8; ++j) { const int kr = r0 + j; const LAS float* btrow = bt + (kr - r + 7) * 128;
        ATT_LOADV(Vc, loc0 + 2 * j); ATT_LOADK(Kb, loc0 + 2 * j + 1);
        attn_tile<true>(st, Ka, Vc, Bq, btrow, 0, q32, hh);
        ATT_LOADV(Vc, loc0 + 2 * j + 1); { const int nt = (j + 1 < 8) ? loc0 + 2 * (j + 1) : loc0; ATT_LOADK(Ka, nt); }
        attn_tile<true>(st, Kb, Vc, Bq, btrow, 1, q32, hh);
    }
#pragma unroll
    for (int qt = 0; qt < 2; ++qt) {
        const float lt = st.lsum[qt] + __shfl_xor(st.lsum[qt], 32), inv = 1.0f / lt;
        bf16* orow = F_MIX + (size_t)(tok0 + 32 * qt + q32) * DM + CONVC + head * HD + 4 * hh;
#pragma unroll
        for (int dt = 0; dt < 2; ++dt)
#pragma unroll
            for (int g4 = 0; g4 < 4; ++g4) { v2u w; w.x = pg8::cvt_pk_bf16(st.O[dt][qt][4 * g4 + 0] * inv, st.O[dt][qt][4 * g4 + 1] * inv); w.y = pg8::cvt_pk_bf16(st.O[dt][qt][4 * g4 + 2] * inv, st.O[dt][qt][4 * g4 + 3] * inv);
                st_wt8(orow + 32 * dt + 8 * g4, w); }
    }
}

__device__ __forceinline__ void conv_unit(Frame& F, int b, int r) {
    const int lane = F.lane, w = F.wave;
    const int cp = F.tid & 255, th = F.tid >> 8;
    LAS float* yb = (LAS float*)(F.lds + P3_Y_OFF);
    const float *cw = F_conv_w, *cb = F_conv_b, *lg = F_conv_ln_g, *lb = F_conv_ln_b;
    asm volatile("" : "+s"(cw), "+s"(cb), "+s"(lg), "+s"(lb));
    {
        const int t0 = r * 64 + 32 * th - 15;
        f32x2 in[62];
        const bf16* up = F_U + (size_t)b * SEQ * CONVC + 2 * cp;
#pragma unroll
        for (int k = 0; k < 62; ++k) { const int tt = t0 + k; unsigned wv = 0u; if (tt >= 0 && tt < SEQ) wv = *(const GAS unsigned*)(up + (size_t)tt * CONVC); in[k] = (f32x2){bf_lo(wv), bf_hi(wv)}; }
        f32x2 wj[CONVW];
#pragma unroll
        for (int j = 0; j < CONVW; ++j) wj[j] = *(const GAS f32x2*)(cw + j * CONVC + 2 * cp);
        const f32x2 bias = *(const GAS f32x2*)(cb + 2 * cp);
        __builtin_amdgcn_sched_barrier(0); __syncthreads();
#pragma unroll
        for (int t = 0; t < 32; ++t) { f32x2 a = bias;
#pragma unroll
            for (int j = 0; j < CONVW; ++j) a = wj[j] * in[t + j] + a;
            *(LAS f32x2*)(yb + (32 * th + t) * CONVC + 2 * cp) = a; }
    }
    __syncthreads();
    const f32x4 g0 = *(const GAS f32x4*)(lg + 8 * lane), g1 = *(const GAS f32x4*)(lg + 8 * lane + 4);
    const f32x4 b0 = *(const GAS f32x4*)(lb + 8 * lane), b1 = *(const GAS f32x4*)(lb + 8 * lane + 4);
#pragma unroll 2
    for (int k = 0; k < 8; ++k) { const int tk = 8 * w + k;
        f32x4 y0 = *(const LAS f32x4*)(yb + tk * CONVC + 8 * lane), y1 = *(const LAS f32x4*)(yb + tk * CONVC + 8 * lane + 4);
        const float s = wave_sum((y0.x + y0.y) + (y0.z + y0.w) + (y1.x + y1.y) + (y1.z + y1.w));
        const float mean = s * (1.0f / CONVC);
        y0 = y0 - mean; y1 = y1 - mean;
        const float q = wave_sum((y0.x * y0.x + y0.y * y0.y) + (y0.z * y0.z + y0.w * y0.w) + (y1.x * y1.x + y1.y * y1.y) + (y1.z * y1.z + y1.w * y1.w));
        const float rstd = 1.0f / sqrtf(q * (1.0f / CONVC) + EPS);
        y0 = y0 * rstd * g0 + b0; y1 = y1 * rstd * g1 + b1;
        v4u wv; wv.x = pk2(y0.x * fast_sigmoid(y0.x), y0.y * fast_sigmoid(y0.y)); wv.y = pk2(y0.z * fast_sigmoid(y0.z), y0.w * fast_sigmoid(y0.w));
        wv.z = pk2(y1.x * fast_sigmoid(y1.x), y1.y * fast_sigmoid(y1.y)); wv.w = pk2(y1.z * fast_sigmoid(y1.z), y1.w * fast_sigmoid(y1.w));
        st_wt16(F_MIX + (size_t)(b * SEQ + r * 64 + tk) * DM + 8 * lane, wv); }
    __syncthreads();
}

__device__ __forceinline__ void p3_bias_fill(Frame& F, int r) {
    LAS float* bt = (LAS float*)(F.lds + P3_BIAS_OFF);
    int r0 = r - 4; r0 = r0 < 0 ? 0 : (r0 > GROWS - 8 ? GROWS - 8 : r0); const int dr0 = r0 - r + 7;
    for (int i = F.tid; i < NHEADS * 8 * 128; i += NWAVES * 64) { const int d = (i & 127) - 48, dr = dr0 + ((i >> 7) & 7), hd = i >> 10; bt[(hd * 15 + dr) * 128 + (i & 127)] = (d >= 0 && d < 31) ? F_rpb[(hd * 15 + dr) * 31 + d] * LOG2E : 0.f; }
}
__device__ __forceinline__ void p3_mixers(Frame& F, const bool prefilled) {
    LAS float* bt = (LAS float*)(F.lds + P3_BIAS_OFF);
    for (int u = F.vcu; u < NB * GROWS; u += F.G) {
        const int b = u / GROWS, r = u % GROWS;
        SEC_BEGIN(3)
        if (u != F.vcu || !prefilled) p3_bias_fill(F, r);
        __syncthreads();
        SEC_END(3)
        SEC_BEGIN(1)
#ifndef PROBE_ATTN
#define PROBE_ATTN 1
#endif
#pragma unroll 1
        for (int rp = 0; rp < PROBE_ATTN; ++rp) attn_wave(F, b, r);
        asm volatile("" ::: "memory"); __builtin_amdgcn_sched_barrier(0);
        SEC_END(1)
        SEC_BEGIN(2)
        conv_unit(F, b, r);
        SEC_END(2)
        arrive_counter2((unsigned*)WSP(unsigned, WS_CTL) + CW_ARR3 + CW_ARRS * (u >> 2), (unsigned*)WSP(unsigned, WS_CTL) + CW_ARR3 - CW_ARRS);
    }
}

struct OutProjOrder {
    int vcu, G; const char *MIX, *WOUT;
    __device__ __forceinline__ bool next(int i, pg8::Unit& u) const {
        const size_t tstep = (size_t)256 * DM * 2;
        int pm, pn;
        if (G == 256) { if (i > 0) return false; const int x = vcu >> 5, s = vcu & 31; pm = 8 * x + (s & 7); pn = s >> 3; }
        else { const int L = i * G + vcu; if (L >= 256) return false; pm = L >> 2; pn = L & 3; }
        u.pm = pm; u.pn = pn; u.kind = 0; u.A = MIX + (size_t)pm * tstep; u.B = WOUT + (size_t)pn * tstep; return true;
    }
};
struct EpiOutProj {
    static constexpr bool PERM = true;
    const float* x; const float* MOD; bf16* X1;
    __device__ __forceinline__ void operator()(const pg8::f32x4 (&acc)[2][2][4][2], const pg8::Unit& u, int wr, int wc, int fr, int fq) const {
        const int row0 = u.pm * 256 + wr * 64 + fr, col0 = u.pn * 256 + wc * 32 + 8 * fq;
        const float* g1 = MOD + (size_t)(u.pm >> 5) * NMODV + 2 * DM;
        pg8::f32x4 gv[2][2];
#pragma unroll
        for (int bj = 0; bj < 2; ++bj)
#pragma unroll
            for (int n = 0; n < 2; ++n) gv[bj][n] = *(const pg8::f32x4*)(g1 + col0 + bj * 128 + n * 4);
#pragma unroll
        for (int ai = 0; ai < 2; ++ai) {
            pg8::f32x4 xr[4][2][2];
#pragma unroll
            for (int m = 0; m < 4; ++m) { const size_t off = (size_t)(row0 + ai * 128 + m * 16) * DM + col0;
#pragma unroll
                for (int bj = 0; bj < 2; ++bj) { xr[m][bj][0] = *(const pg8::f32x4*)(x + off + bj * 128); xr[m][bj][1] = *(const pg8::f32x4*)(x + off + bj * 128 + 4); } }
#pragma unroll
            for (int m = 0; m < 4; ++m) { const size_t off = (size_t)(row0 + ai * 128 + m * 16) * DM + col0;
#pragma unroll
                for (int bj = 0; bj < 2; ++bj) { const pg8::f32x4 v0 = xr[m][bj][0] + gv[bj][0] * acc[ai][bj][m][0], v1 = xr[m][bj][1] + gv[bj][1] * acc[ai][bj][m][1];
                    v4u w; w.x = pg8::cvt_pk_bf16(v0[0], v0[1]); w.y = pg8::cvt_pk_bf16(v0[2], v0[3]); w.z = pg8::cvt_pk_bf16(v1[0], v1[1]); w.w = pg8::cvt_pk_bf16(v1[2], v1[3]);
                    st_wt16(X1 + off + bj * 128, w); } }
        }
    }
};

__device__ __forceinline__ void p5_router(Frame& F) {
    LAS f32x4* wl = (LAS f32x4*)(F.lds + RING_OFF);
    for (int idx = F.tid; idx < DM * 4; idx += NWAVES * 64) { const int c = idx >> 2, q = idx & 3; const f32x4 v = *(const GAS f32x4*)(F_w_router + c * NEXP + 4 * q);
        const int j = c >> 8, l = (c & 255) >> 2, i = c & 3; wl[((j * 4 + i) * 4 + q) * 64 + l] = v; }
    __syncthreads();
    const int gw = F.vcu * NWAVES + F.wave, NGW = F.G * NWAVES, lane = F.lane;
    { unsigned* c4 = (unsigned*)WSP(unsigned, WS_CTL) + CW_ARR4; unsigned* tmo = (unsigned*)WSP(unsigned, WS_CTL) + CW_TMO;
      if (F.G == 256) wait_counter(c4 + CW_ARRS * (F.vcu >> 2), 4u, tmo); else wait_counter(c4 - CW_ARRS, 256u, tmo); }
    const int qstep = (F.G == 256) ? NWAVES : NGW, qbeg = (F.G == 256) ? F.vcu * 16 + F.wave : gw, qend = (F.G == 256) ? F.vcu * 16 + 16 : MTOK / 4;
    for (int qd = qbeg; qd < qend; qd += qstep) {
        const int m0 = 4 * qd, b = m0 >> 13;
        const float* mod = F_MOD + (size_t)b * NMODV;
        f32x4 v[4][4];
#pragma unroll
        for (int tk = 0; tk < 4; ++tk)
#pragma unroll
            for (int j = 0; j < 4; ++j) { const v2u w = ((const GAS v2u*)(F_X1 + (size_t)(m0 + tk) * DM))[lane + 64 * j]; v[tk][j] = (f32x4){bf_lo(w.x), bf_hi(w.x), bf_lo(w.y), bf_hi(w.y)}; }
        float rstd[4];
#pragma unroll
        for (int tk = 0; tk < 4; ++tk) { float ss = 0.f;
#pragma unroll
            for (int j = 0; j < 4; ++j) ss += (v[tk][j].x * v[tk][j].x + v[tk][j].y * v[tk][j].y) + (v[tk][j].z * v[tk][j].z + v[tk][j].w * v[tk][j].w);
            rstd[tk] = 1.0f / sqrtf(wave_sum(ss) * (1.0f / DM) + EPS); }
        float lg[64];
#pragma unroll
        for (int e = 0; e < 64; ++e) lg[e] = 0.f;
#pragma unroll
        for (int j = 0; j < 4; ++j) { const int col = 4 * lane + 256 * j;
            const f32x4 g = *(const GAS f32x4*)(F_norm_ffn_g + col), sh = *(const GAS f32x4*)(mod + 3 * DM + col), sc = *(const GAS f32x4*)(mod + 4 * DM + col);
            const f32x4 gs = g * (1.0f + sc);
#pragma unroll
            for (int tk = 0; tk < 4; ++tk) { v[tk][j] = v[tk][j] * rstd[tk] * gs + sh;
                ((GAS unsigned*)((unsigned char*)F_H2 + (size_t)(m0 + tk) * DM))[lane + 64 * j] = pk4_fp8(clamp448(v[tk][j].x), clamp448(v[tk][j].y), clamp448(v[tk][j].z), clamp448(v[tk][j].w)); }
#pragma unroll
            for (int i = 0; i < 4; ++i) {
#pragma unroll
                for (int q = 0; q < 4; ++q) { const f32x4 wv = wl[((j * 4 + i) * 4 + q) * 64 + lane];
#pragma unroll
                    for (int tk = 0; tk < 4; ++tk) { const float hv = v[tk][j][i];
                        lg[tk * 16 + 4 * q + 0] += hv * wv.x; lg[tk * 16 + 4 * q + 1] += hv * wv.y; lg[tk * 16 + 4 * q + 2] += hv * wv.z; lg[tk * 16 + 4 * q + 3] += hv * wv.w; } }
                __builtin_amdgcn_sched_barrier(0); } }
#pragma unroll
        for (int w = 32; w >= 1; w >>= 1) {
#pragma unroll
            for (int i = 0; i < w; ++i) { const bool up = (lane & w) != 0; const float send = up ? lg[i] : lg[i + w], keep = up ? lg[i + w] : lg[i]; lg[i] = keep + __shfl_xor(send, w); } }
        const float logit = lg[0];
        const float mx = row16_max(logit), p = __expf(logit - mx), den = row16_sum(p);
        const int tk = lane >> 4, e = lane & 15, t = (m0 + tk) & (SEQ - 1);
        st_wt(&F_AFF[(size_t)(b * NEXP + e) * SEQ + t], p / den);
    }
    arrive_counter((unsigned*)WSP(unsigned, WS_CTL) + CW_ARR5);
}

__device__ __forceinline__ int block_excl_scan(int v, LAS int* sc, int tid, int lane, int wave, int& total) {
    int inc = v;
#pragma unroll
    for (int o = 1; o < 64; o <<= 1) { const int t = __shfl_up(inc, o); if (lane >= o) inc += t; }
    __syncthreads();
    if (lane == 63) sc[wave] = inc;
    __syncthreads();
    int base = 0, tot = 0;
#pragma unroll
    for (int w = 0; w < 8; ++w) { const int c = sc[w]; if (w < wave) base += c; tot += c; }
    total = tot;
    return base + inc - v;
}
__device__ __forceinline__ void p6_topk(Frame& F) {
    LAS int* hist = (LAS int*)(F.lds + RING_OFF);
    LAS int* sel = hist + 256;
    LAS int* sc = hist + 264;
    if ((int)blockIdx.x < NB * NEXP) wait_counter((unsigned*)WSP(unsigned, WS_CTL) + CW_ARR5, (unsigned)F.G, (unsigned*)WSP(unsigned, WS_CTL) + CW_TMO);
    for (int be = blockIdx.x; be < NB * NEXP; be += F.G) {
        const int b = be >> 4, e = be & 15;
        const float* a = F_AFF + (size_t)be * SEQ + 16 * F.tid;
        unsigned v[16];
#pragma unroll
        for (int j = 0; j < 4; ++j) { const v4u q = *(const GAS v4u*)(a + 4 * j); v[4 * j] = q.x; v[4 * j + 1] = q.y; v[4 * j + 2] = q.z; v[4 * j + 3] = q.w; }
        unsigned prefix = 0u, mask = 0u; int kk = CAP;
#pragma unroll 1
        for (int pass = 0; pass < 4; ++pass) { const int shift = 24 - 8 * pass;
            __syncthreads();
            if (F.tid < 256) hist[F.tid] = 0;
            __syncthreads();
#pragma unroll
            for (int j = 0; j < 16; ++j) if ((v[j] & mask) == prefix) __hip_atomic_fetch_add(&hist[(v[j] >> shift) & 255u], 1, __ATOMIC_RELAXED, __HIP_MEMORY_SCOPE_WORKGROUP);
            __syncthreads();
            if (F.wave == 0) {
                int c[4]; int s4 = 0;
#pragma unroll
                for (int j = 0; j < 4; ++j) { c[j] = hist[4 * F.lane + j]; s4 += c[j]; }
                int suf = s4;
#pragma unroll
                for (int o = 1; o < 64; o <<= 1) { const int t = __shfl_down(suf, o); if (F.lane + o < 64) suf += t; }
                int above = suf - s4;
#pragma unroll
                for (int j = 3; j >= 0; --j) { if (above < kk && kk <= above + c[j]) { sel[0] = 4 * F.lane + j; sel[1] = kk - above; } above += c[j]; }
            }
            __syncthreads();
            prefix |= (unsigned)sel[0] << shift; mask |= 255u << shift; kk = sel[1];
        }
        const unsigned T = prefix; const int need_eq = kk;
        int ceq = 0;
#pragma unroll
        for (int j = 0; j < 16; ++j) ceq += (v[j] == T) ? 1 : 0;
        int tot; int eqb = block_excl_scan(ceq, sc, F.tid, F.lane, F.wave, tot);
        unsigned selm = 0u; int csel = 0;
#pragma unroll
        for (int j = 0; j < 16; ++j) { bool s = v[j] > T; if (v[j] == T) { s = eqb < need_eq; ++eqb; } if (s) { selm |= 1u << j; ++csel; } }
        int slot = block_excl_scan(csel, sc, F.tid, F.lane, F.wave, tot);
        const int obase = (e * 2 + b) * CAP;
        int iv[16];
#pragma unroll
        for (int j = 0; j < 16; ++j) { const bool s = (selm >> j) & 1u; iv[j] = s ? slot : -1;
            if (s) { F_TOK[obase + slot] = 16 * F.tid + j; F_WTS[obase + slot] = __builtin_bit_cast(float, v[j]); ++slot; } }
        int* ip = F_INV + (size_t)be * SEQ + 16 * F.tid;
#pragma unroll
        for (int j = 0; j < 4; ++j) *(GAS v4u*)(ip + 4 * j) = (v4u){(unsigned)iv[4 * j], (unsigned)iv[4 * j + 1], (unsigned)iv[4 * j + 2], (unsigned)iv[4 * j + 3]};
        __syncthreads();
    }
}

struct GateUpOrder {
    int vcu, G; const char *H2, *WGU; const int* TOK;
    __device__ __forceinline__ bool next(int i, pg8::Unit& u) const {
        int e, pml, pn;
        if (G == 256) { if (i >= 8) return false; const int x = vcu >> 5, s = vcu & 31; e = 2 * x + (i >> 2); pml = s & 7; pn = 4 * (i & 3) + (s >> 3); }
        else { const int L = i * G + vcu; if (L >= 2048) return false; e = L >> 7; pml = L & 7; pn = (L >> 3) & 15; }
        u.pm = e * 8 + pml; u.pn = pn; u.kind = 0;
        u.A = H2; u.B = WGU + ((size_t)e * 2 * DEXP + (size_t)pn * 256) * DM; return true;
    }
    __device__ __forceinline__ const int* rows(const pg8::Unit& u) const { return TOK + u.pm * 256; }
    __device__ __forceinline__ int row_base(const pg8::Unit& u) const { return ((u.pm >> 2) & 1) * SEQ; }
};
struct EpiSwiGLU {
    static constexpr bool PERM = true;
    unsigned char* HID;
    __device__ __forceinline__ void operator()(const pg8::f32x4 (&acc)[2][2][4][2], const pg8::Unit& u, int wr, int wc, int fr, int fq) const { half(acc, u, wr, wc, fr, fq, 0); half(acc, u, wr, wc, fr, fq, 1); }
    __device__ __forceinline__ void half(const pg8::f32x4 (&acc)[2][2][4][2], const pg8::Unit& u, int wr, int wc, int fr, int fq, const int ai) const {
        asm volatile("" : "+v"(fr), "+v"(fq));
        const int row0 = u.pm * 256 + wr * 64 + fr, col0 = u.pn * 128 + wc * 32 + 8 * fq;
#pragma unroll
            for (int m = 0; m < 4; ++m) {
                float v[8];
#pragma unroll
                for (int n = 0; n < 2; ++n)
#pragma unroll
                    for (int i = 0; i < 4; i += 2) { const f32x2 g2 = (f32x2){acc[ai][0][m][n][i], acc[ai][0][m][n][i + 1]}, u2 = (f32x2){acc[ai][1][m][n][i], acc[ai][1][m][n][i + 1]};
                        f32x2 d2 = (f32x2){__builtin_amdgcn_exp2f(-g2.x), __builtin_amdgcn_exp2f(-g2.y)} + 1.0f;
                        const f32x2 r2 = (f32x2){__builtin_amdgcn_rcpf(d2.x), __builtin_amdgcn_rcpf(d2.y)}, h2 = (g2 * u2) * r2;
                        v[4 * n + i] = clamp448(h2.x); v[4 * n + i + 1] = clamp448(h2.y); }
                v2u w; w.x = pk4_fp8(v[0], v[1], v[2], v[3]); w.y = pk4_fp8(v[4], v[5], v[6], v[7]);
                *(v2u*)(HID + (size_t)(row0 + ai * 128 + m * 16) * DEXP + col0) = w; }
    }
};
struct DownOrder {
    int vcu, G; const char *HID, *WD;
    __device__ __forceinline__ bool next(int i, pg8::Unit& u) const {
        int e, pml, pn;
        if (G == 256) { if (i >= 2) return false; const int x = vcu >> 5, s = vcu & 31; e = 2 * x + i; pml = s & 7; pn = s >> 3; }
        else { const int L = i * G + vcu; if (L >= 512) return false; e = L >> 5; pml = L & 7; pn = (L >> 3) & 3; }
        u.pm = e * 8 + pml; u.pn = pn; u.kind = 0;
        u.A = HID + (size_t)u.pm * 256 * DEXP; u.B = WD + ((size_t)e * DM + (size_t)pn * 256) * DEXP; return true;
    }
};
constexpr float YS_SCALE = 16.0f;
struct EpiDown {
    static constexpr bool PERM = true;
    unsigned char* YS; const float* WTS;
    __device__ __forceinline__ void operator()(const pg8::f32x4 (&acc)[2][2][4][2], const pg8::Unit& u, int wr, int wc, int fr, int fq) const {
        const int row0 = u.pm * 256 + wr * 64 + fr, col0 = u.pn * 256 + wc * 32 + 8 * fq;
#pragma unroll
        for (int ai = 0; ai < 2; ++ai)
#pragma unroll
            for (int m = 0; m < 4; ++m) { const int row = row0 + ai * 128 + m * 16; const float wt = WTS[row] * YS_SCALE; unsigned char* rowp = YS + (size_t)row * DM + col0;
#pragma unroll
                for (int bj = 0; bj < 2; ++bj) { const pg8::f32x4 v0 = acc[ai][bj][m][0] * wt, v1 = acc[ai][bj][m][1] * wt;
                    v2u w; w.x = pk4_fp8(clamp448(v0[0]), clamp448(v0[1]), clamp448(v0[2]), clamp448(v0[3])); w.y = pk4_fp8(clamp448(v1[0]), clamp448(v1[1]), clamp448(v1[2]), clamp448(v1[3]));
                    *(v2u*)(rowp + bj * 128) = w; } }
    }
};

__device__ __forceinline__ void p9_final(Frame& F) {
    const int gw = F.vcu * NWAVES + F.wave, NGW = F.G * NWAVES, lane = F.lane, half = lane >> 5, l32 = lane & 31;
    for (int pr = gw; pr < MTOK / 2; pr += NGW) {
        const int m = 2 * pr + half, b = m >> 13, t = m & (SEQ - 1);
        const float* mod = F_MOD + (size_t)b * NMODV;
        int slotv = -1;
        if (l32 < 16) slotv = F_INV[(size_t)(b * NEXP + l32) * SEQ + t];
        f32x4 v[8], sum[8];
#pragma unroll
        for (int j = 0; j < 4; ++j) { const v4u w = ((const GAS v4u*)(F_X1 + (size_t)m * DM))[l32 + 32 * j];
            v[2 * j] = (f32x4){bf_lo(w.x), bf_hi(w.x), bf_lo(w.y), bf_hi(w.y)}; v[2 * j + 1] = (f32x4){bf_lo(w.z), bf_hi(w.z), bf_lo(w.w), bf_hi(w.w)};
            sum[2 * j] = (f32x4){0.f, 0.f, 0.f, 0.f}; sum[2 * j + 1] = (f32x4){0.f, 0.f, 0.f, 0.f}; }
        const unsigned long long bal = __ballot(slotv >= 0);
        unsigned my16 = (unsigned)(bal >> (32 * half)) & 0xffffu;
        const int cnt = __popc(my16), ocnt = __popc((unsigned)(bal >> (32 * (1 - half))) & 0xffffu);
        const int maxcnt = cnt > ocnt ? cnt : ocnt;
        for (int k0 = 0; k0 < maxcnt; k0 += 4) {
            v2u rows[4][4]; bool val[4];
#pragma unroll
            for (int kk = 0; kk < 4; ++kk) { val[kk] = my16 != 0u; const int e = val[kk] ? (__ffs(my16) - 1) : 0; my16 &= my16 - 1u;
                const int sl = __shfl(slotv, 32 * half + e);
                const GAS v2u* yr = (const GAS v2u*)((const unsigned char*)F_YS + (size_t)((e * 2 + b) * CAP + (sl < 0 ? 0 : sl)) * DM) + l32;
#pragma unroll
                for (int j = 0; j < 4; ++j) rows[kk][j] = val[kk] ? yr[32 * j] : (v2u){0u, 0u}; }
#pragma unroll
            for (int kk = 0; kk < 4; ++kk)
#pragma unroll
                for (int j = 0; j < 4; ++j) { const v2u w = rows[kk][j];
                    const auto a0 = __builtin_amdgcn_cvt_pk_f32_fp8((int)w.x, false), a1 = __builtin_amdgcn_cvt_pk_f32_fp8((int)w.x, true), a2 = __builtin_amdgcn_cvt_pk_f32_fp8((int)w.y, false), a3 = __builtin_amdgcn_cvt_pk_f32_fp8((int)w.y, true);
                    sum[2 * j].x += a0[0]; sum[2 * j].y += a0[1]; sum[2 * j].z += a1[0]; sum[2 * j].w += a1[1];
                    sum[2 * j + 1].x += a2[0]; sum[2 * j + 1].y += a2[1]; sum[2 * j + 1].z += a3[0]; sum[2 * j + 1].w += a3[1]; }
        }
        float ss = 0.f;
#pragma unroll
        for (int q = 0; q < 8; ++q) { const int col = 8 * l32 + 256 * (q >> 1) + 4 * (q & 1); const f32x4 g2 = *(const GAS f32x4*)(mod + 5 * DM + col);
            v[q] = v[q] + g2 * (sum[q] * (1.0f / YS_SCALE)); ss += (v[q].x * v[q].x + v[q].y * v[q].y) + (v[q].z * v[q].z + v[q].w * v[q].w); }
        const float rstd = 1.0f / sqrtf(half_sum(ss, half) * (1.0f / DM) + EPS);
#pragma unroll
        for (int q = 0; q < 8; ++q) { const int col = 8 * l32 + 256 * (q >> 1) + 4 * (q & 1); const f32x4 g = *(const GAS f32x4*)(F_norm_final_g + col);
            *(GAS f32x4*)(F_out + (size_t)m * DM + col) = v[q] * rstd * g; }
    }
}

constexpr int N_PHASES = 9;
#ifndef P2_QUOTA
#define P2_QUOTA 0
#endif
#ifndef P2_QWAVES
#define P2_QWAVES 8
#endif
__global__ void __launch_bounds__(NWAVES * 64, 2) mk_fwd(Args args) {
    extern __shared__ __attribute__((aligned(16))) unsigned char lds[];
    Frame F;
    F.lds = (LAS unsigned char*)lds;
    F.MISC = (volatile LAS unsigned*)(F.lds + MISC_OFF);
    F.tid = threadIdx.x; F.lane = F.tid & 63; F.wave = __builtin_amdgcn_readfirstlane(F.tid >> 6);
    F.G = gridDim.x; { const int bx = blockIdx.x; F.vcu = (F.G % 8 == 0) ? (bx % 8) * (F.G / 8) + bx / 8 : bx; }
    F.a = &args; F.pacc = 0ull;
    gu32* ctl = (gu32*)(args.ws + WS_CTL);
    for (int u = F.tid; u < (MISC_OFF + 128 - LDSCTL_OFF) / 4; u += NWAVES * 64) ((LAS unsigned*)(F.lds + LDSCTL_OFF))[u] = 0u;
    __syncthreads();
    const int lo = args.ph_lo, hi = args.ph_hi;
    const bool multi = (hi - lo) > 1;
    XcdBarrier bar; bar.bar = (unsigned*)(ctl + CW_BAR); bar.x = 0; bar.st = nullptr;
    if (multi) bar = xcd_barrier_post((unsigned*)(ctl + CW_BAR), F.MISC + 8);
#ifndef PH_MASK
#define PH_MASK 0xFFFF
#endif
#define IN(k) ((((PH_MASK) >> (k)) & 1) && lo <= (k) && (k) < hi)
#define SEAM(k) do { if ((k) != 0 && (k) != 3 && (k) != 4 && (k) != 5 && IN(k) && IN((k) + 1)) xcd_barrier(bar); } while (0)

#ifndef PROBE_REP
#define PROBE_REP 0
#endif
#define NREP(k) (1 + (((PROBE_REP) >> (k)) & 1))
#ifndef PROBE_SPAN
#define PROBE_SPAN -1
#endif
    unsigned long long span_t0 = 0ull, span_dt = 0ull;
#define PHASE(k, ...) if (IN(k)) { if ((k) == PROBE_SPAN) span_t0 = __builtin_amdgcn_s_memrealtime(); for (int rep_ = 0; rep_ < NREP(k); ++rep_) { __VA_ARGS__; if (rep_ + 1 < NREP(k)) xcd_barrier(bar); } SEAM(k); if ((k) == PROBE_SPAN) span_dt = __builtin_amdgcn_s_memrealtime() - span_t0; }
    if (PROBE_SPAN == 99) span_t0 = __builtin_amdgcn_s_memrealtime();
    f32x4 xv_[P1_IT][P1_RW][4];
    PHASE(0, p0_prologue(F, xv_))
    PHASE(1, p1_hpass(F, xv_))
    PHASE(2, { EpiInProj E{F_U, F_Q, F_K, F_VT, 0.125f * LOG2E};
               { GluOrder S{F.vcu, F.G, (const char*)F_H, (const char*)F_WIN}; pg8::gemm_phase<EpiInProj, GluOrder>(F.lds + RING_OFF, 2 * DM, S, E); }
               { QkvOrder S{F.vcu, F.G, (const char*)F_H8, (const char*)F_WQKV8}; pg8::gemm_phase<EpiInProj, QkvOrder, false, true>(F.lds + RING_OFF, DM, S, E); }
               if (F.vcu < NB * GROWS) p3_bias_fill(F, F.vcu % GROWS); })
    PHASE(3, p3_mixers(F, lo <= 2))
    PHASE(4, { OutProjOrder S{F.vcu, F.G, (const char*)F_MIX, (const char*)F_WOUT};
               EpiOutProj E{F_x, F_MOD, F_X1};
               unsigned* c3 = (unsigned*)WSP(unsigned, WS_CTL) + CW_ARR3; unsigned* c4 = (unsigned*)WSP(unsigned, WS_CTL) + CW_ARR4; unsigned* tmo = (unsigned*)WSP(unsigned, WS_CTL) + CW_TMO;
               pg8::Unit u0; const bool one = (F.G == 256) && S.next(0, u0);
               if (one) wait_counter(c3 + CW_ARRS * u0.pm, 4u, tmo); else wait_counter(c3 - CW_ARRS, (unsigned)(NB * GROWS), tmo);
               pg8::gemm_phase<EpiOutProj, OutProjOrder>(F.lds + RING_OFF, 2 * DM, S, E);
               if (one) arrive_counter2(c4 + CW_ARRS * u0.pm, c4 - CW_ARRS); else { pg8::Unit uu; for (int i = 0; S.next(i, uu); ++i) arrive_counter2(c4 + CW_ARRS * uu.pm, c4 - CW_ARRS); } })
    PHASE(5, p5_router(F))
    PHASE(6, { p6_topk(F); moe_weights<true>(F, (unsigned*)(ctl + CW_WQ), -1); })
    PHASE(7, { GateUpOrder S{F.vcu, F.G, (const char*)F_H2, (const char*)F_WGU, F_TOK};
               EpiSwiGLU E{(unsigned char*)F_HID};
               DownSide SD{F_w_down, (unsigned char*)F_WD, F.vcu * NWAVES + F.wave, F.G * NWAVES, F.lane};
               pg8::gemm_phase<EpiSwiGLU, GateUpOrder, true, true, true, true, DownSide>(F.lds + RING_OFF, DM, S, E, SD);
               { pg8::Unit uu; int nu = 0; while (S.next(nu, uu)) ++nu;
                 for (int ui = nu; ui * SD.NGW + SD.gw < DOWN_ITEMS; ++ui) { f32x4 v[8]; SD.issue(ui, v); SD.finish(ui, v); } } })
    PHASE(8, { DownOrder S{F.vcu, F.G, (const char*)F_HID, (const char*)F_WD};
               EpiDown E{(unsigned char*)F_YS, F_WTS};
               pg8::gemm_phase<EpiDown, DownOrder, false, true>(F.lds + RING_OFF, DEXP, S, E); })
    PHASE(9, p9_final(F))
    if (PROBE_SPAN == 99) span_dt = __builtin_amdgcn_s_memrealtime() - span_t0;
    if (PROBE_SEC > 0) span_dt = F.pacc;
    if ((PROBE_SPAN >= 0 || PROBE_SEC > 0) && blockIdx.x == 0) { const unsigned long long t0 = __builtin_amdgcn_s_memrealtime(); while (__builtin_amdgcn_s_memrealtime() - t0 < span_dt) __builtin_amdgcn_s_sleep(8); }
#undef IN
#undef SEAM
}

extern "C" void kernel_launch(void* const* d_in, const int* in_sizes, int n_in, void* d_out, int out_size, void* d_ws, size_t ws_size, hipStream_t stream) {
    static int grid = 0;
    if (grid == 0) {
        if (n_in != 20 || out_size != MTOK * DM || ws_size < WS_END) { fprintf(stderr, "kernel_launch: unexpected shapes (n_in %d out %d ws %zu)\n", n_in, out_size, ws_size); grid = -1; return; }
        int dev = 0, cus = 0, per_cu = 0;
        if (hipGetDevice(&dev) != hipSuccess || hipDeviceGetAttribute(&cus, hipDeviceAttributeMultiprocessorCount, dev) != hipSuccess) { grid = -1; return; }
        if (hipFuncSetAttribute((const void*)mk_fwd, hipFuncAttributeMaxDynamicSharedMemorySize, LDS_BYTES) != hipSuccess) { fprintf(stderr, "kernel_launch: hipFuncSetAttribute failed\n"); grid = -1; return; }
        if (hipOccupancyMaxActiveBlocksPerMultiprocessor(&per_cu, (const void*)mk_fwd, NWAVES * 64, LDS_BYTES) != hipSuccess || per_cu < 1) { fprintf(stderr, "kernel_launch: occupancy query says %d\n", per_cu); per_cu = 1; }
        (void)hipGetLastError();
        grid = cus;
    }
    if (grid < 0) return;
    (void)hipMemsetAsync((char*)d_ws + WS_CTL, 0, CTL_ZERO_BYTES, stream);
    Args a{};
    for (int i = 0; i < 20; ++i) a.in[i] = (const float*)d_in[i];
    a.out = (float*)d_out; a.ws = (unsigned char*)d_ws;
#if MK_ONE_LAUNCH
    a.ph_lo = 0; a.ph_hi = N_PHASES + 1;
    hipLaunchKernelGGL(mk_fwd, dim3(grid), dim3(NWAVES * 64), LDS_BYTES, stream, a);
#else
    for (int p = 1; p <= N_PHASES; ++p) { a.ph_lo = (p == 1) ? 0 : p; a.ph_hi = p + 1; hipLaunchKernelGGL(mk_fwd, dim3(grid), dim3(NWAVES * 64), LDS_BYTES, stream, a); }
#endif
}
```

```cpp
#include <hip/hip_runtime.h>
#include <cstdio>
#include <cstdint>

#ifndef MK_ONE_LAUNCH
#define MK_ONE_LAUNCH 1
#endif

namespace pg8 {
#define PG8_LAS __attribute__((address_space(3)))
typedef unsigned short bf16_t;
typedef short bf16x8 __attribute__((ext_vector_type(8)));
typedef float f32x4 __attribute__((ext_vector_type(4)));
typedef unsigned u32x4 __attribute__((ext_vector_type(4)));
constexpr int BM = 256, BK = 64, HALF = 128, HTB = HALF * BK * 2, STAGE_BYTES = 8 * HTB;
constexpr int WSCALE_WORD = 0x7a7a7a7a;
constexpr int GIDX_OFF = 147456;

__host__ __device__ __forceinline__ int lds_byte(int r, int c) { const int st = (r >> 4) * 2 + (c >> 5), rr = r & 15, cc = c & 31, ob = rr * 64 + cc * 2; return st * 1024 + (ob ^ (((ob >> 9) & 1) << 5)); }
__host__ __device__ __forceinline__ void stage_rc(int b, int& R, int& C) { const int st = b / 1024, sb = b % 1024, swz = sb ^ (((sb >> 9) & 1) << 5); R = (st >> 1) * 16 + swz / 64; C = (st & 1) * 32 + (swz % 64) / 2; }
__host__ __device__ __forceinline__ int perm32(int rho) { const int n = rho >> 4, i = rho & 15; return 8 * (i >> 2) + 4 * n + (i & 3); }

struct Unit { int pm, pn, kind; const char* A; const char* B; };

__device__ __forceinline__ unsigned cvt_pk_bf16(float lo, float hi) { unsigned r; asm volatile("v_cvt_pk_bf16_f32 %0, %1, %2" : "=v"(r) : "v"(lo), "v"(hi)); return r; }

typedef int v8i __attribute__((ext_vector_type(8)));
typedef int v4i __attribute__((ext_vector_type(4)));
struct NoSide { static constexpr bool ON = false; __device__ __forceinline__ bool has(int) const { return false; } __device__ __forceinline__ const void* src(int) const { return nullptr; } __device__ __forceinline__ unsigned row_stride_bytes() const { return 0u; } __device__ __forceinline__ void finish(int, const f32x4 (&)[8]) const {} };
template <class Epi, class Sched, bool GATHER = false, bool FP8 = false, bool ALIGN_EPI = true, bool SP2 = true, class Side = NoSide>
__device__ __forceinline__ void gemm_phase(PG8_LAS unsigned char* lds, const int KB, const Sched& S, const Epi& E, const Side& SD = Side()) {
    const int tid = threadIdx.x, wid = __builtin_amdgcn_readfirstlane(tid >> 6), lane = tid & 63, wr = wid >> 2, wc = wid & 3, fr = lane & 15, fq = lane >> 4;
    const int nt = KB / 128;
    unsigned voffA[2], voffB[2];
#pragma unroll
    for (int i = 0; i < 2; ++i) { int R, C; stage_rc(tid * 16 + i * 8192, R, C); const int Rb = Epi::PERM ? ((R & ~31) + perm32(R & 31)) : R;
        voffA[i] = (unsigned)(R * KB + C * 2); voffB[i] = (unsigned)(Rb * KB + C * 2); }
    const size_t kstep = (size_t)(BK * 2);
    const size_t hstep = (size_t)HALF * KB;
    const unsigned ldsw = (unsigned)wid * 1024u;
    const int aoff = lds_byte(wr * 64 + fr, fq * 8), boff = lds_byte(wc * 32 + fr, fq * 8);
#define PG8_SA(b, h) (((b) * 2 + (h)) * HTB)
#define PG8_SB(b, h) ((4 + (b) * 2 + (h)) * HTB)
#define PG8_STAGE(bufoff, gbase, voff) do { _Pragma("unroll") for (int _i = 0; _i < 2; ++_i) \
        __builtin_amdgcn_global_load_lds((const unsigned*)((const char*)(gbase) + (voff)[_i]), (PG8_LAS unsigned*)(lds + (bufoff) + ldsw + _i * 8192), 16, 0, 0); } while (0)
#define PG8_STAGE_A(bufoff, kptr, h, goff) do { _Pragma("unroll") for (int _i = 0; _i < 2; ++_i) \
        __builtin_amdgcn_global_load_lds((const unsigned*)((const char*)(kptr) + (GATHER ? (goff)[h][_i] : (voffA[_i] + (unsigned)((h) * hstep)))), (PG8_LAS unsigned*)(lds + (bufoff) + ldsw + _i * 8192), 16, 0, 0); } while (0)
#define PG8_LD16(p) (*(const PG8_LAS v4i*)(p))
#define PG8_LDA(dst, b, h) do { if constexpr (FP8) { _Pragma("unroll") for (int m = 0; m < 4; ++m) { const v4i lo_ = PG8_LD16(lds + PG8_SA(b, h) + aoff + m * 2048), hi_ = PG8_LD16(lds + PG8_SA(b, h) + aoff + m * 2048 + 1024); \
            dst##8[m] = __builtin_shufflevector(lo_, hi_, 0, 1, 2, 3, 4, 5, 6, 7); } } \
        else { _Pragma("unroll") for (int m = 0; m < 4; ++m) _Pragma("unroll") for (int k = 0; k < 2; ++k) dst[m][k] = *(const PG8_LAS bf16x8*)(lds + PG8_SA(b, h) + aoff + m * 2048 + k * 1024); } } while (0)
#define PG8_LDB(dst, b, h) do { if constexpr (FP8) { _Pragma("unroll") for (int n = 0; n < 2; ++n) { const v4i lo_ = PG8_LD16(lds + PG8_SB(b, h) + boff + n * 2048), hi_ = PG8_LD16(lds + PG8_SB(b, h) + boff + n * 2048 + 1024); \
            dst##8[n] = __builtin_shufflevector(lo_, hi_, 0, 1, 2, 3, 4, 5, 6, 7); } } \
        else { _Pragma("unroll") for (int n = 0; n < 2; ++n) _Pragma("unroll") for (int k = 0; k < 2; ++k) dst[n][k] = *(const PG8_LAS bf16x8*)(lds + PG8_SB(b, h) + boff + n * 2048 + k * 1024); } } while (0)
#define PG8_MMA(ai, bj, At, Bt) do { __builtin_amdgcn_s_setprio(1); _Pragma("unroll") for (int m = 0; m < 4; ++m) _Pragma("unroll") for (int n = 0; n < 2; ++n) { \
        if constexpr (FP8) { asm volatile("v_mfma_scale_f32_16x16x128_f8f6f4 %0, %1, %2, %0, %3, %4 op_sel_hi:[0,0,0]" : "+v"(acc[ai][bj][m][n]) : "v"(Bt##8[n]), "v"(At##8[m]), "v"(wsc_), "v"(one_)); } \
        else { _Pragma("unroll") for (int k = 0; k < 2; ++k) acc[ai][bj][m][n] = __builtin_amdgcn_mfma_f32_16x16x32_bf16(Bt[n][k], At[m][k], acc[ai][bj][m][n], 0, 0, 0); } } \
        __builtin_amdgcn_s_setprio(0); } while (0)
#define PG8_WAIT_V(n) asm volatile("s_waitcnt vmcnt(" #n ")" ::: "memory")
#define PG8_WAIT_L(n) asm volatile("s_waitcnt lgkmcnt(" #n ")" ::: "memory")
#define PG8_BAR __builtin_amdgcn_s_barrier()
#define PG8_SCHED __builtin_amdgcn_sched_barrier(0)
    Unit cur, nxt; int ui = 0;
    if (!S.next(0, cur)) return;
    f32x4 acc[2][2][4][2];
#pragma unroll
    for (int a = 0; a < 2; ++a)
#pragma unroll
        for (int b = 0; b < 2; ++b)
#pragma unroll
            for (int m = 0; m < 4; ++m)
#pragma unroll
                for (int n = 0; n < 2; ++n) acc[a][b][m][n] = (f32x4){0.f, 0.f, 0.f, 0.f};
    bf16x8 At[4][2], B0[2][2], B1[2][2];
    v8i At8[4], B08[2], B18[2];
    int wsc_ = WSCALE_WORD, one_ = 0x7f7f7f7f; asm volatile("" : "+v"(wsc_), "+v"(one_));
    const char* cA = cur.A; const char* cB = cur.B;
    unsigned goffC[2][2] = {{0u, 0u}, {0u, 0u}};
    if constexpr (GATHER) {
#pragma unroll
        for (int h = 0; h < 2; ++h)
#pragma unroll
            for (int i = 0; i < 2; ++i) { int R_, C_; stage_rc(tid * 16 + i * 8192, R_, C_); goffC[h][i] = (unsigned)((S.row_base(cur) + S.rows(cur)[h * HALF + R_]) * KB + C_ * 2); }
    }
    if constexpr (SP2) {
        PG8_STAGE(PG8_SB(0, 0), cB, voffB); PG8_STAGE(PG8_SB(0, 1), cB + hstep, voffB); PG8_STAGE_A(PG8_SA(0, 0), cA, 0, goffC); PG8_STAGE_A(PG8_SA(0, 1), cA, 1, goffC);
        if (wr == 1) PG8_BAR;
        PG8_WAIT_V(2); PG8_BAR;
        PG8_STAGE(PG8_SB(1, 0), cB + kstep, voffB); PG8_STAGE_A(PG8_SA(1, 0), cA + kstep, 0, goffC); PG8_STAGE(PG8_SB(1, 1), cB + hstep + kstep, voffB);
        PG8_WAIT_V(6); PG8_BAR;
    } else {
        PG8_STAGE(PG8_SB(0, 0), cB, voffB); PG8_STAGE_A(PG8_SA(0, 0), cA, 0, goffC); PG8_STAGE(PG8_SB(0, 1), cB + hstep, voffB); PG8_STAGE_A(PG8_SA(0, 1), cA, 1, goffC);
        if (wr == 1) PG8_BAR;
        PG8_WAIT_V(4); PG8_BAR;
        PG8_STAGE(PG8_SB(1, 0), cB + kstep, voffB); PG8_STAGE_A(PG8_SA(1, 0), cA + kstep, 0, goffC); PG8_STAGE(PG8_SB(1, 1), cB + hstep + kstep, voffB);
        PG8_WAIT_V(6); PG8_BAR;
    }
    for (;;) {
        const bool has_next = S.next(ui + 1, nxt);
        const char* nA = has_next ? nxt.A : cA; const char* nB = has_next ? nxt.B : cB;
        if constexpr (GATHER) {
            if (has_next && wid < 4) __builtin_amdgcn_global_load_lds((const unsigned*)(S.rows(nxt) + tid), (PG8_LAS unsigned*)(lds + GIDX_OFF + ((ui + 1) & 1) * 1024 + wid * 256), 4, 0, 0);
        }
#pragma unroll 1
        for (int t = 0; t < nt; t += 2) {
            const bool last = (t == nt - 2);
            const char* a1 = cA + (size_t)(t + 1) * kstep;
            const char* a2 = last ? nA : cA + (size_t)(t + 2) * kstep; const char* b2 = last ? nB : cB + (size_t)(t + 2) * kstep;
            const char* a3 = a2 + kstep; const char* b3 = b2 + kstep;
            if constexpr (SP2) {
            PG8_LDB(B0, 0, 0); PG8_LDB(B1, 0, 1); PG8_SCHED; PG8_LDA(At, 0, 0); PG8_STAGE_A(PG8_SA(1, 1), a1, 1, goffC);
            if constexpr (GATHER) { if (last && has_next) { const PG8_LAS int* mb = (const PG8_LAS int*)(lds + GIDX_OFF + ((ui + 1) & 1) * 1024); const int rb = S.row_base(nxt);
                _Pragma("unroll") for (int h = 0; h < 2; ++h) _Pragma("unroll") for (int i = 0; i < 2; ++i) { int R_, C_; stage_rc(tid * 16 + i * 8192, R_, C_); goffC[h][i] = (unsigned)((rb + mb[h * HALF + R_]) * KB + C_ * 2); } } }
            PG8_WAIT_V(8); PG8_WAIT_L(0); PG8_BAR; PG8_MMA(0, 0, At, B0); PG8_MMA(0, 1, At, B1); PG8_BAR; PG8_SCHED;
            PG8_LDA(At, 0, 1); PG8_STAGE(PG8_SB(0, 0), b2, voffB); PG8_STAGE(PG8_SB(0, 1), b2 + hstep, voffB); PG8_STAGE_A(PG8_SA(0, 0), a2, 0, goffC);
            PG8_WAIT_V(8); PG8_WAIT_L(0); PG8_BAR; PG8_MMA(1, 0, At, B0); PG8_MMA(1, 1, At, B1); PG8_BAR; PG8_SCHED;
            PG8_LDB(B0, 1, 0); PG8_LDB(B1, 1, 1); PG8_SCHED; PG8_LDA(At, 1, 0); PG8_STAGE_A(PG8_SA(0, 1), a2, 1, goffC);
            PG8_WAIT_V(8); PG8_WAIT_L(0); PG8_BAR; PG8_MMA(0, 0, At, B0); PG8_MMA(0, 1, At, B1); PG8_BAR; PG8_SCHED;
            PG8_LDA(At, 1, 1); PG8_STAGE(PG8_SB(1, 0), b3, voffB); PG8_STAGE(PG8_SB(1, 1), b3 + hstep, voffB); PG8_STAGE_A(PG8_SA(1, 0), a3, 0, goffC);
            PG8_WAIT_V(8); PG8_WAIT_L(0); PG8_BAR; PG8_MMA(1, 0, At, B0); PG8_MMA(1, 1, At, B1); PG8_BAR; PG8_SCHED;
            } else {
            PG8_LDB(B0, 0, 0); PG8_SCHED; PG8_LDA(At, 0, 0); PG8_STAGE_A(PG8_SA(1, 1), a1, 1, goffC);
            if constexpr (GATHER) { if (last && has_next) { const PG8_LAS int* mb = (const PG8_LAS int*)(lds + GIDX_OFF + ((ui + 1) & 1) * 1024); const int rb = S.row_base(nxt);
                _Pragma("unroll") for (int h = 0; h < 2; ++h) _Pragma("unroll") for (int i = 0; i < 2; ++i) { int R_, C_; stage_rc(tid * 16 + i * 8192, R_, C_); goffC[h][i] = (unsigned)((rb + mb[h * HALF + R_]) * KB + C_ * 2); } } }
            PG8_WAIT_L(8); PG8_BAR; PG8_WAIT_L(0); PG8_MMA(0, 0, At, B0); PG8_BAR; PG8_SCHED;
            PG8_LDB(B1, 0, 1); PG8_STAGE(PG8_SB(0, 0), b2, voffB);
            PG8_BAR; PG8_WAIT_L(0); PG8_MMA(0, 1, At, B1); PG8_BAR;
            PG8_LDA(At, 0, 1); PG8_STAGE_A(PG8_SA(0, 0), a2, 0, goffC);
            PG8_BAR; PG8_WAIT_L(0); PG8_MMA(1, 0, At, B0); PG8_BAR; PG8_SCHED;
            PG8_STAGE(PG8_SB(0, 1), b2 + hstep, voffB);
            PG8_WAIT_V(6); PG8_BAR; PG8_MMA(1, 1, At, B1); PG8_BAR;
            PG8_LDB(B0, 1, 0); PG8_SCHED; PG8_LDA(At, 1, 0); PG8_STAGE_A(PG8_SA(0, 1), a2, 1, goffC);
            PG8_WAIT_L(8); PG8_BAR; PG8_WAIT_L(0); PG8_MMA(0, 0, At, B0); PG8_BAR; PG8_SCHED;
            PG8_LDB(B1, 1, 1); PG8_STAGE(PG8_SB(1, 0), b3, voffB);
            PG8_BAR; PG8_WAIT_L(0); PG8_MMA(0, 1, At, B1); PG8_BAR;
            PG8_LDA(At, 1, 1); PG8_STAGE_A(PG8_SA(1, 0), a3, 0, goffC);
            PG8_BAR; PG8_WAIT_L(0); PG8_MMA(1, 0, At, B0); PG8_BAR; PG8_SCHED;
            PG8_STAGE(PG8_SB(1, 1), b3 + hstep, voffB);
            PG8_WAIT_V(6); PG8_BAR; PG8_MMA(1, 1, At, B1); PG8_BAR;
            }
        }
        if constexpr (ALIGN_EPI) { if (wr == 0) PG8_BAR; }
        if constexpr (FP8) {
#pragma unroll
            for (int b_ = 0; b_ < 2; ++b_) asm volatile("s_nop 15\n\ts_nop 15" : "+v"(acc[1][b_][0][0]), "+v"(acc[1][b_][0][1]), "+v"(acc[1][b_][1][0]), "+v"(acc[1][b_][1][1]), "+v"(acc[1][b_][2][0]), "+v"(acc[1][b_][2][1]), "+v"(acc[1][b_][3][0]), "+v"(acc[1][b_][3][1]));
        }
        if constexpr (Side::ON) {
            E.half(acc, cur, wr, wc, fr, fq, 0); asm volatile("" ::: "memory"); __builtin_amdgcn_sched_barrier(0);
            const bool son = SD.has(ui); const char* sp = son ? (const char*)SD.src(ui) : nullptr; const unsigned sst = SD.row_stride_bytes();
            if (son) {
#define PG8_SLD(R, r) asm volatile("global_load_dwordx4 %0, %1, off nt" : "=v"(R) : "v"(sp + (size_t)(r) * sst) : "memory")
                PG8_SLD(acc[0][0][0][0], 0); PG8_SLD(acc[0][0][0][1], 1); PG8_SLD(acc[0][0][1][0], 2); PG8_SLD(acc[0][0][1][1], 3);
                PG8_SLD(acc[0][0][2][0], 4); PG8_SLD(acc[0][0][2][1], 5); PG8_SLD(acc[0][0][3][0], 6); PG8_SLD(acc[0][0][3][1], 7);
#undef PG8_SLD
            }
            __builtin_amdgcn_sched_barrier(0);
            E.half(acc, cur, wr, wc, fr, fq, 1);
            if (son) {
                asm volatile("s_waitcnt vmcnt(0)" : "+v"(acc[0][0][0][0]), "+v"(acc[0][0][0][1]), "+v"(acc[0][0][1][0]), "+v"(acc[0][0][1][1]), "+v"(acc[0][0][2][0]), "+v"(acc[0][0][2][1]), "+v"(acc[0][0][3][0]), "+v"(acc[0][0][3][1]) :: "memory");
                const f32x4 sv_[8] = {acc[0][0][0][0], acc[0][0][0][1], acc[0][0][1][0], acc[0][0][1][1], acc[0][0][2][0], acc[0][0][2][1], acc[0][0][3][0], acc[0][0][3][1]};
                SD.finish(ui, sv_);
            }
        }
        else E(acc, cur, wr, wc, fr, fq);
        if (!has_next) break;
#pragma unroll
        for (int a = 0; a < 2; ++a)
#pragma unroll
            for (int b = 0; b < 2; ++b)
#pragma unroll
                for (int m = 0; m < 4; ++m)
#pragma unroll
                    for (int n = 0; n < 2; ++n) acc[a][b][m][n] = (f32x4){0.f, 0.f, 0.f, 0.f};
        cur = nxt; cA = nA; cB = nB; ++ui;
        if constexpr (ALIGN_EPI) { if (wr == 1) PG8_BAR; }
    }
    PG8_WAIT_V(0);
    if constexpr (!ALIGN_EPI) { if (wr == 0) PG8_BAR; }
    PG8_BAR;
#undef PG8_SA
#undef PG8_SB
#undef PG8_STAGE
#undef PG8_STAGE_A
#undef PG8_LDA
#undef PG8_LDB
#undef PG8_MMA
#undef PG8_LD16
#undef PG8_WAIT_V
#undef PG8_WAIT_L
#undef PG8_BAR
#undef PG8_SCHED
}
}

constexpr int NWAVES = 8;
constexpr int DM = 1024, NB = 2, SEQ = 8192, MTOK = NB * SEQ;
constexpr int CTXL = 256, MCTX = NB * CTXL, MALL = MTOK + MCTX;
constexpr int NMODV = 6 * DM;
constexpr int CONVC = 512, CONVW = 31, NHEADS = 8, HD = 64, ATTW = 512;
constexpr int NINC = 2560;
constexpr int NEXP = 16, DEXP = 2048, CAP = 1024, MX = NB * NEXP * CAP;
constexpr int GROWS = SEQ / 64;
constexpr int KTILES = SEQ / 32 + CTXL / 32;
constexpr float EPS = 1e-6f;
constexpr float LOG2E = 1.4426950408889634f;

constexpr size_t MiB = 1u << 20;
constexpr size_t WS_CTL = 0, CTL_ZERO_BYTES = 32 * 1024;
constexpr size_t WS_MOD = 1 * MiB;
constexpr size_t WS_AFF = 2 * MiB;
constexpr size_t WS_INV = 3 * MiB;
constexpr size_t WS_TOK = 4 * MiB;
constexpr size_t WS_WT = 4 * MiB + 128 * 1024;
constexpr size_t WS_WIN = 5 * MiB;
constexpr size_t WS_WOUT = 10 * MiB;
constexpr size_t WS_WGU = 12 * MiB;
constexpr size_t WS_WD = 140 * MiB;
constexpr size_t WS_X1 = 204 * MiB;
constexpr size_t WS_YS = 268 * MiB;
constexpr size_t WS_H = 332 * MiB;
constexpr size_t WS_H8 = 240 * MiB;
constexpr size_t WS_WQKV8 = 7 * MiB;
constexpr size_t WS_U = 365 * MiB;
constexpr size_t WS_Q = 381 * MiB;
constexpr size_t WS_K = 397 * MiB;
constexpr size_t WS_VT = WS_K + 16 * MiB + 512 * 1024;
constexpr size_t WS_MIX = 430 * MiB;
constexpr size_t WS_HID = 332 * MiB;
constexpr size_t WS_H2 = 462 * MiB;
constexpr size_t WS_END = 494 * MiB;
static_assert(WS_VT + (size_t)512 * MALL * 2 <= WS_MIX && WS_HID + (size_t)MX * DEXP * 2 <= WS_H2, "ws map");

constexpr int CW_TMO = 0, CW_CODE = 1;
constexpr int CW_BAR = 4096;
constexpr int CW_WQ = 2048;
constexpr int CW_ARR3 = 2304, CW_ARR4 = 3072, CW_ARRS = 8;
constexpr int CW_ARR0 = 2112, CW_ARR5 = 2176;

constexpr int RING_OFF = 0, RING_BYTES = 131072;
constexpr int LDSCTL_OFF = RING_BYTES, MISC_OFF = LDSCTL_OFF + 320;
constexpr int LDS_BYTES = 163840;
static_assert(MISC_OFF + 128 + 8 * 15 * 32 * 4 <= LDS_BYTES, "LDS map");

#define GAS __attribute__((address_space(1)))
#define LAS __attribute__((address_space(3)))
typedef unsigned short bf16;
typedef unsigned v4u __attribute__((ext_vector_type(4)));
typedef unsigned v2u __attribute__((ext_vector_type(2)));
typedef float f32x4 __attribute__((ext_vector_type(4)));
typedef float f32x16 __attribute__((ext_vector_type(16)));
typedef float f32x2 __attribute__((ext_vector_type(2)));
typedef short bf16x8 __attribute__((ext_vector_type(8)));
typedef GAS unsigned gu32;
#define RLX_AGENT __ATOMIC_RELAXED, __HIP_MEMORY_SCOPE_AGENT
#define LDS_WAIT() asm volatile("s_waitcnt lgkmcnt(0)" ::: "memory")
#define VM_WAIT() asm volatile("s_waitcnt vmcnt(0)" ::: "memory")
__device__ __forceinline__ unsigned f2bf(float f) { unsigned u = __builtin_bit_cast(unsigned, f); return (u + 0x7fffu + ((u >> 16) & 1u)) >> 16; }
__device__ __forceinline__ unsigned pk2(float lo, float hi) { return f2bf(lo) | (f2bf(hi) << 16); }
__device__ __forceinline__ float bf_lo(unsigned w) { return __builtin_bit_cast(float, w << 16); }
__device__ __forceinline__ float bf_hi(unsigned w) { return __builtin_bit_cast(float, w & 0xffff0000u); }
__device__ __forceinline__ unsigned pk4_fp8(float a, float b, float c, float d) { int w = 0; w = __builtin_amdgcn_cvt_pk_fp8_f32(a, b, w, false); w = __builtin_amdgcn_cvt_pk_fp8_f32(c, d, w, true); return (unsigned)w; }
__device__ __forceinline__ float clamp448(float x) { return __builtin_fminf(__builtin_fmaxf(x, -448.f), 448.f); }
__device__ __forceinline__ float fast_sigmoid(float x) { return __builtin_amdgcn_rcpf(1.0f + __builtin_amdgcn_exp2f(-x * LOG2E)); }

#define XB_TMO      128
#define XB_XCNT(j)  (256  + 64 * (j))
#define XB_XSUB(j)  (1280 + 64 * (j))
#define XB_XGEN(j)  (2304 + 64 * (j))
#define XB_TOP      3328
#define XB_TOPGEN   3392
#define XCD_BAR_WORDS 3456
#define XB_SPIN_CAP (1u << 18)
__device__ __forceinline__ unsigned xb_ld(unsigned* p)              { return __hip_atomic_load(p, __ATOMIC_RELAXED, __HIP_MEMORY_SCOPE_AGENT); }
__device__ __forceinline__ unsigned xb_add(unsigned* p, unsigned v) { return __hip_atomic_fetch_add(p, v, __ATOMIC_RELAXED, __HIP_MEMORY_SCOPE_AGENT); }
__device__ __forceinline__ unsigned xb_xcc_id() { return (unsigned)__builtin_amdgcn_s_getreg((3 << 11) | 20) & 0xFu; }
#define XB_SPIN(cond, bar) do { unsigned _sp = 0; while (cond) { __builtin_amdgcn_s_sleep(1); \
    if ((++_sp & 255u) == 0u) { if (xb_ld(&(bar)[XB_TMO])) break; if (_sp > XB_SPIN_CAP) { atomicAdd(&(bar)[XB_TMO], 1u); break; } } } } while (0)
struct XcdBarrier { unsigned* bar; unsigned x; volatile LAS unsigned* st; };
__device__ __forceinline__ XcdBarrier xcd_barrier_post(unsigned* bar, volatile LAS unsigned* st) {
    XcdBarrier b; b.bar = bar; b.x = xb_xcc_id(); b.st = st;
    if (threadIdx.x == 0) (void)xb_add(&bar[XB_XCNT(b.x)], 1u);
    return b;
}
__device__ __forceinline__ void xcd_barrier_complete(unsigned* bar, unsigned x, unsigned& nloc, unsigned& nx) {
    const unsigned G = gridDim.x * gridDim.y * gridDim.z;
    unsigned sum, cnt, mine, sp = 0u;
    for (;;) {
        sum = 0u; cnt = 0u; mine = 0u;
#pragma unroll
        for (unsigned j = 0; j < 16; ++j) { const unsigned c = xb_ld(&bar[XB_XCNT(j)]); sum += c; cnt += (c > 0u) ? 1u : 0u; mine = (j == x) ? c : mine; }
        if (sum == G) break;
        __builtin_amdgcn_s_sleep(1);
        if ((++sp & 255u) == 0u) { if (xb_ld(&bar[XB_TMO])) break; if (sp > XB_SPIN_CAP) { atomicAdd(&bar[XB_TMO], 1u); break; } }
    }
    nloc = mine > 0u ? mine : 1u; nx = cnt > 0u ? cnt : 1u;
}
__device__ __forceinline__ void xcd_barrier(const XcdBarrier& b) {
    asm volatile("s_waitcnt vmcnt(0)" ::: "memory");
    __syncthreads();
    if (threadIdx.x == 0) {
        unsigned* bar = b.bar;
        __builtin_amdgcn_s_waitcnt(0);
        unsigned nloc = b.st[0], nx = b.st[1];
        if (nloc == 0u) { xcd_barrier_complete(bar, b.x, nloc, nx); b.st[0] = nloc; b.st[1] = nx; }
        const unsigned old = xb_add(&bar[XB_XSUB(b.x)], 1u);
        const unsigned gen = old / nloc;
        if (old + 1u == (gen + 1u) * nloc) {
            __builtin_amdgcn_fence(__ATOMIC_RELEASE, "agent");
            asm volatile("s_waitcnt vmcnt(0)" ::: "memory");
            const unsigned og = xb_add(&bar[XB_TOP], 1u);
            const unsigned tg = og / nx;
            if (og + 1u == (tg + 1u) * nx) xb_add(&bar[XB_TOPGEN], 1u);
            else XB_SPIN(xb_ld(&bar[XB_TOPGEN]) == tg, bar);
            __builtin_amdgcn_fence(__ATOMIC_ACQUIRE, "agent");
            xb_add(&bar[XB_XGEN(b.x)], 1u);
            asm volatile("s_waitcnt vmcnt(0)" ::: "memory");
        } else {
            XB_SPIN(xb_ld(&bar[XB_XGEN(b.x)]) == gen, bar);
            __builtin_amdgcn_fence(__ATOMIC_ACQUIRE, "agent");
            asm volatile("s_waitcnt vmcnt(0)" ::: "memory");
        }
    }
    __syncthreads();
}

__device__ __forceinline__ void st_wt(float* p, float v) { __hip_atomic_store(p, v, __ATOMIC_RELAXED, __HIP_MEMORY_SCOPE_AGENT); }
__device__ __forceinline__ void st_wt16(void* p, v4u v) { asm volatile("global_store_dwordx4 %0, %1, off sc1\n\ts_nop 1" :: "v"(p), "v"(v) : "memory"); }
__device__ __forceinline__ void st_wt8(void* p, v2u v) { __hip_atomic_store((unsigned long long*)p, ((unsigned long long)v.y << 32) | v.x, __ATOMIC_RELAXED, __HIP_MEMORY_SCOPE_AGENT); }
__device__ __forceinline__ void arrive_counter(unsigned* cnt) {
    asm volatile("s_waitcnt vmcnt(0)" ::: "memory"); __syncthreads();
    if (threadIdx.x == 0) __hip_atomic_fetch_add(cnt, 1u, __ATOMIC_RELAXED, __HIP_MEMORY_SCOPE_AGENT);
}
__device__ __forceinline__ void arrive_counter2(unsigned* cnt, unsigned* total) {
    asm volatile("s_waitcnt vmcnt(0)" ::: "memory"); __syncthreads();
    if (threadIdx.x == 0) { __hip_atomic_fetch_add(cnt, 1u, __ATOMIC_RELAXED, __HIP_MEMORY_SCOPE_AGENT); __hip_atomic_fetch_add(total, 1u, __ATOMIC_RELAXED, __HIP_MEMORY_SCOPE_AGENT); }
}
__device__ __forceinline__ void wait_counter(unsigned* cnt, unsigned need, unsigned* tmo) {
    if (threadIdx.x == 0) {
        unsigned sp = 0u;
        while (__hip_atomic_load(cnt, __ATOMIC_RELAXED, __HIP_MEMORY_SCOPE_AGENT) < need) { __builtin_amdgcn_s_sleep(2); if (++sp > (1u << 20)) { __hip_atomic_store(tmo, 1u, __ATOMIC_RELAXED, __HIP_MEMORY_SCOPE_AGENT); break; } }
        __builtin_amdgcn_fence(__ATOMIC_ACQUIRE, "agent");
        asm volatile("s_waitcnt vmcnt(0)" ::: "memory");
    }
    __syncthreads();
}

struct Args { const float* in[20]; float* out; unsigned char* ws; int ph_lo, ph_hi; };
struct Frame {
    LAS unsigned char* lds;
    volatile LAS unsigned* MISC;
    int tid, lane, wave;
    int vcu, G;
    const Args* a;
    unsigned long long pacc;
};
#ifndef PROBE_SEC
#define PROBE_SEC 0
#endif
#define SEC_BEGIN(id) unsigned long long sec_t0_##id = 0ull; if (PROBE_SEC == (id)) { __builtin_amdgcn_s_barrier(); sec_t0_##id = __builtin_amdgcn_s_memrealtime(); }
#define SEC_END(id) if (PROBE_SEC == (id)) { __builtin_amdgcn_s_barrier(); F.pacc += __builtin_amdgcn_s_memrealtime() - sec_t0_##id; }
#define FIN(name, idx) (F.a->in[idx])
#define F_x FIN(x, 0)
#define F_c FIN(c, 1)
#define F_ctx FIN(ctx, 2)
#define F_c_ctx FIN(c_ctx, 3)
#define F_w_mod FIN(w_mod, 4)
#define F_b_mod FIN(b_mod, 5)
#define F_norm_mix_g FIN(norm_mix_g, 6)
#define F_w_in FIN(w_in, 7)
#define F_conv_w FIN(conv_w, 8)
#define F_conv_b FIN(conv_b, 9)
#define F_conv_ln_g FIN(conv_ln_g, 10)
#define F_conv_ln_b FIN(conv_ln_b, 11)
#define F_rpb FIN(rpb, 12)
#define F_w_out FIN(w_out, 13)
#define F_norm_ffn_g FIN(norm_ffn_g, 14)
#define F_w_router FIN(w_router, 15)
#define F_w_gate FIN(w_gate, 16)
#define F_w_up FIN(w_up, 17)
#define F_w_down FIN(w_down, 18)
#define F_norm_final_g FIN(norm_final_g, 19)
#define F_out (F.a->out)
#define WSP(T, off) ((T*)(F.a->ws + (off)))
#define F_MOD WSP(float, WS_MOD)
#define F_AFF WSP(float, WS_AFF)
#define F_INV WSP(int, WS_INV)
#define F_TOK WSP(int, WS_TOK)
#define F_WTS WSP(float, WS_WT)
#define F_X1 WSP(bf16, WS_X1)
#define F_WIN WSP(bf16, WS_WIN)
#define F_WOUT WSP(bf16, WS_WOUT)
#define F_WGU WSP(bf16, WS_WGU)
#define F_WD WSP(bf16, WS_WD)
#define F_YS WSP(bf16, WS_YS)
#define F_H WSP(bf16, WS_H)
#define F_H8 WSP(unsigned char, WS_H8)
#define F_WQKV8 WSP(unsigned char, WS_WQKV8)
#define F_U WSP(bf16, WS_U)
#define F_Q WSP(bf16, WS_Q)
#define F_K WSP(bf16, WS_K)
#define F_VT WSP(bf16, WS_VT)
#define F_MIX WSP(bf16, WS_MIX)
#define F_HID WSP(bf16, WS_HID)
#define F_H2 WSP(bf16, WS_H2)

template <int CTRL> __device__ __forceinline__ float dpp_mov(float v) { return __builtin_bit_cast(float, __builtin_amdgcn_update_dpp(0, __builtin_bit_cast(int, v), CTRL, 0xF, 0xF, true)); }
__device__ __forceinline__ float row16_sum(float v) { v += dpp_mov<0xB1>(v); v += dpp_mov<0x4E>(v); v += dpp_mov<0x141>(v); v += dpp_mov<0x140>(v); return v; }
__device__ __forceinline__ float row16_max(float v) { v = fmaxf(v, dpp_mov<0xB1>(v)); v = fmaxf(v, dpp_mov<0x4E>(v)); v = fmaxf(v, dpp_mov<0x141>(v)); v = fmaxf(v, dpp_mov<0x140>(v)); return v; }
__device__ __forceinline__ float rdlane(float v, int l) { return __builtin_bit_cast(float, __builtin_amdgcn_readlane(__builtin_bit_cast(int, v), l)); }
__device__ __forceinline__ float wave_sum(float v) {
    v = row16_sum(v);
    return (rdlane(v, 0) + rdlane(v, 16)) + (rdlane(v, 32) + rdlane(v, 48));
}
__device__ __forceinline__ float half_sum(float v, int half) {
    v = row16_sum(v);
    const float lo = rdlane(v, 0) + rdlane(v, 16), hi = rdlane(v, 32) + rdlane(v, 48);
    return half ? hi : lo;
}
__device__ __forceinline__ float wave_max(float v) {
#pragma unroll
    for (int o = 1; o < 64; o <<= 1) v = fmaxf(v, __shfl_xor(v, o));
    return v;
}

__device__ __forceinline__ void tr_load(const float* W, int N, int k0, int n0, int lane, f32x4 (&v)[8]) {
    const float* p = W + (size_t)(k0 + 8 * (lane & 7)) * N + n0 + 4 * (lane >> 3);
#pragma unroll
    for (int r = 0; r < 8; ++r) v[r] = __builtin_nontemporal_load((const f32x4*)(p + (size_t)r * N));
}
__device__ __forceinline__ void tr_store(const f32x4 (&v)[8], bf16* WT, int Kdst, int drow0, int k0, int lane) {
    bf16* q = WT + (size_t)(drow0 + 4 * (lane >> 3)) * Kdst + k0 + 8 * (lane & 7);
#pragma unroll
    for (int c = 0; c < 4; ++c) { v4u o; o.x = pk2(v[0][c], v[1][c]); o.y = pk2(v[2][c], v[3][c]); o.z = pk2(v[4][c], v[5][c]); o.w = pk2(v[6][c], v[7][c]);
        *(GAS v4u*)(q + (size_t)c * Kdst) = o; }
}
__device__ __forceinline__ void transpose_item(const float* W, int N, int k0, int n0, bf16* WT, int Kdst, int drow0, int lane) {
    f32x4 v[8]; tr_load(W, N, k0, n0, lane, v); tr_store(v, WT, Kdst, drow0, k0, lane);
}

__device__ __forceinline__ void tr8_load(const float* W, int N, int k0, int n0, int lane, f32x4 (&v)[16]);
__device__ __forceinline__ void tr8_store(const f32x4 (&v)[16], unsigned char* WT, int Kdst, int drow0, int k0, int lane, const float WPRESCALE);
constexpr int P1_RW = 2, P1_IT = 4;
__device__ __forceinline__ void p1_load(Frame& F, f32x4 (&xv)[P1_IT][P1_RW][4]);
__device__ __forceinline__ void p0_prologue(Frame& F, f32x4 (&xv)[P1_IT][P1_RW][4]) {
    {
        LAS float* sl = (LAS float*)(F.lds + RING_OFF);
        LAS float* part = sl + 3 * DM;
        for (int i = F.tid; i < 3 * DM; i += NWAVES * 64) { const int r = i >> 10, k = i & 1023; const float cv = (r < 2) ? F_c[r * DM + k] : F_c_ctx[k]; sl[i] = cv * fast_sigmoid(cv); }
        __syncthreads();
        for (int it = F.vcu; it < NMODV / 32; it += F.G) {
            const int c32 = F.lane & 31, n = it * 32 + c32, kb = F.wave * 128 + (F.lane >> 5);
            float wv[64];
#pragma unroll
            for (int i = 0; i < 64; ++i) wv[i] = __builtin_nontemporal_load(&F_w_mod[(size_t)(kb + 2 * i) * NMODV + n]);
            float a0 = 0.f, a1 = 0.f, a2 = 0.f;
#pragma unroll
            for (int i = 0; i < 64; ++i) { const int k = kb + 2 * i; a0 += sl[k] * wv[i]; a1 += sl[DM + k] * wv[i]; a2 += sl[2 * DM + k] * wv[i]; }
            a0 += __shfl_xor(a0, 32); a1 += __shfl_xor(a1, 32); a2 += __shfl_xor(a2, 32);
            if (F.lane < 32) { part[(F.wave * 3 + 0) * 32 + c32] = a0; part[(F.wave * 3 + 1) * 32 + c32] = a1; part[(F.wave * 3 + 2) * 32 + c32] = a2; }
            __syncthreads();
            if (F.tid < 96) { const int r = F.tid >> 5, c = F.tid & 31; float sacc = F_b_mod[it * 32 + c];
#pragma unroll
                for (int w = 0; w < 8; ++w) sacc += part[(w * 3 + r) * 32 + c];
                st_wt(&F_MOD[r * NMODV + it * 32 + c], sacc); }
            arrive_counter((unsigned*)WSP(unsigned, WS_CTL) + CW_ARR0);
        }
        __syncthreads();
    }
    asm volatile("" ::: "memory"); __builtin_amdgcn_sched_barrier(0);
    p1_load(F, xv);
    const int gw = F.vcu * NWAVES + F.wave, NGW = F.G * NWAVES;
    constexpr int I_GLU = (DM / 64) * (1024 / 32);
    constexpr int I_QKV = (DM / 128) * (1536 / 32);
    constexpr int I_OUT = (DM / 64) * (DM / 32);
    for (int it = gw; it < I_GLU + I_QKV + I_OUT; it += NGW) {
        int r = it;
        if (r < I_GLU) { const int kb = r >> 5, n0 = (r & 31) * 32; const int half = n0 >> 9, rem = n0 & 511, drow = 256 * (rem >> 7) + 128 * half + (rem & 127);
            transpose_item(F_w_in, NINC, kb * 64, n0, F_WIN, DM, drow, F.lane); continue; }
        r -= I_GLU;
        if (r < I_QKV) { const int kb = r / 48, nb = r % 48; f32x4 v[16]; tr8_load(F_w_in, NINC, kb * 128, 1024 + nb * 32, F.lane, v); tr8_store(v, F_WQKV8, DM, nb * 32, kb * 128, F.lane, 32.0f); continue; }
        r -= I_QKV;
        { const int nblk = DM / 32, kb = r / nblk, nb = r % nblk; transpose_item(F_w_out, DM, kb * 64, nb * 32, F_WOUT, DM, nb * 32, F.lane); }
    }
}

constexpr int MOE_I_G = (DM / 128) * (DEXP / 32);
constexpr int MOE_I_D = (DEXP / 128) * (DM / 32);
constexpr int MOE_ITEMS = NEXP * (2 * MOE_I_G), MOE_CHUNK = 4, MOE_NCHUNK = MOE_ITEMS / MOE_CHUNK;
constexpr float WPRE = 32.0f;
struct MoeSrc { const float* W; int N, k0, n0; unsigned char* WT; int Kdst, half; };
__device__ __forceinline__ MoeSrc moe_chunk_src(Frame& F, int ch) {
    int r = ch * MOE_CHUNK; MoeSrc m;
    const int e = r / (2 * MOE_I_G); r -= e * (2 * MOE_I_G);
    const int half = r / MOE_I_G; r -= half * MOE_I_G; const int nblk = DEXP / 32;
    m.W = (half ? F_w_up : F_w_gate) + (size_t)e * DM * DEXP; m.N = DEXP; m.k0 = (r / nblk) * 128; m.n0 = (r % nblk) * 32; m.WT = (unsigned char*)F_WGU + (size_t)e * 2 * DEXP * DM; m.Kdst = DM; m.half = half;
    return m;
}
__device__ __forceinline__ float moe_prescale(const MoeSrc& m) { return m.half == 0 ? WPRE * LOG2E : (m.half == 1 ? WPRE / LOG2E : WPRE); }
__device__ __forceinline__ int moe_drow(const MoeSrc& m, int n0) { return m.half == 2 ? n0 : 256 * (n0 >> 7) + 128 * m.half + (n0 & 127); }
__device__ __forceinline__ void tr8_load(const float* W, int N, int k0, int n0, int lane, f32x4 (&v)[16]) {
    const float* p = W + (size_t)(k0 + 16 * (lane & 7)) * N + n0 + 4 * (lane >> 3);
#pragma unroll
    for (int r = 0; r < 16; ++r) v[r] = __builtin_nontemporal_load((const f32x4*)(p + (size_t)r * N));
}
__device__ __forceinline__ void tr8_store(const f32x4 (&v)[16], unsigned char* WT, int Kdst, int drow0, int k0, int lane, const float WPRESCALE = 32.0f) {
    unsigned char* q = WT + (size_t)(drow0 + 4 * (lane >> 3)) * Kdst + k0 + 16 * (lane & 7);
#pragma unroll
    for (int c = 0; c < 4; ++c) { v4u o;
        o.x = pk4_fp8(v[0][c] * WPRESCALE, v[1][c] * WPRESCALE, v[2][c] * WPRESCALE, v[3][c] * WPRESCALE); o.y = pk4_fp8(v[4][c] * WPRESCALE, v[5][c] * WPRESCALE, v[6][c] * WPRESCALE, v[7][c] * WPRESCALE);
        o.z = pk4_fp8(v[8][c] * WPRESCALE, v[9][c] * WPRESCALE, v[10][c] * WPRESCALE, v[11][c] * WPRESCALE); o.w = pk4_fp8(v[12][c] * WPRESCALE, v[13][c] * WPRESCALE, v[14][c] * WPRESCALE, v[15][c] * WPRESCALE);
        *(GAS v4u*)(q + (size_t)c * Kdst) = o; }
}
template <bool STATIC_FIRST>
__device__ __forceinline__ void moe_weights(Frame& F, unsigned* counter, int quota) {
    const int gw = F.vcu * NWAVES + F.wave, NGW = F.G * NWAVES, lane = F.lane;
    int ch;
    if (STATIC_FIRST) ch = gw;
    else { unsigned t0 = 0u; if (lane == 0) t0 = __hip_atomic_fetch_add(counter, 1u, __ATOMIC_RELAXED, __HIP_MEMORY_SCOPE_AGENT); ch = NGW + (int)__builtin_amdgcn_readfirstlane(t0); }
    for (int done = 0; ch < MOE_NCHUNK && done != quota; ++done) {
        const MoeSrc m = moe_chunk_src(F, ch);
        unsigned nx = 0u;
        const bool more = (done + 1 != quota);
        if (more && lane == 0) nx = __hip_atomic_fetch_add(counter, 1u, __ATOMIC_RELAXED, __HIP_MEMORY_SCOPE_AGENT);
        f32x4 va[16], vb[16]; const float wpre = moe_prescale(m);
        tr8_load(m.W, m.N, m.k0, m.n0, lane, va);
#pragma unroll
        for (int k = 0; k < MOE_CHUNK; k += 2) {
            tr8_load(m.W, m.N, m.k0, m.n0 + 32 * (k + 1), lane, vb);
            tr8_store(va, m.WT, m.Kdst, moe_drow(m, m.n0 + 32 * k), m.k0, lane, wpre);
            if (k + 2 < MOE_CHUNK) tr8_load(m.W, m.N, m.k0, m.n0 + 32 * (k + 2), lane, va);
            tr8_store(vb, m.WT, m.Kdst, moe_drow(m, m.n0 + 32 * (k + 1)), m.k0, lane, wpre);
        }
        ch = NGW + (int)__builtin_amdgcn_readfirstlane(nx);
    }
}

constexpr int DOWN_IPE = (DEXP / 64) * (DM / 32);
constexpr int DOWN_ITEMS = NEXP * DOWN_IPE;
struct DownSide {
    static constexpr bool ON = true;
    const float* w_down; unsigned char* WD; int gw, NGW, lane;
    __device__ __forceinline__ bool has(int ui) const { return ui * NGW + gw < DOWN_ITEMS; }
    __device__ __forceinline__ unsigned row_stride_bytes() const { return DM * 4u; }
    __device__ __forceinline__ const void* src(int ui) const {
        int lane = this->lane; asm volatile("" : "+v"(lane));
        const int d = ui * NGW + gw, e = d / DOWN_IPE, r = d % DOWN_IPE, kb = r / (DM / 32), nb = r % (DM / 32);
        return w_down + (size_t)e * DEXP * DM + (size_t)(kb * 64 + 8 * (lane & 7)) * DM + nb * 32 + 4 * (lane >> 3);
    }
    __device__ __forceinline__ void issue(int ui, f32x4 (&v)[8]) const {
        if (!has(ui)) return; const char* p = (const char*)src(ui);
#pragma unroll
        for (int r = 0; r < 8; ++r) v[r] = __builtin_nontemporal_load((const f32x4*)(p + (size_t)r * row_stride_bytes()));
    }
    __device__ __forceinline__ void finish(int ui, const f32x4 (&v)[8]) const {
        int lane = this->lane; asm volatile("" : "+v"(lane));
        const int d = ui * NGW + gw; if (d >= DOWN_ITEMS) return;
        const int e = d / DOWN_IPE, r = d % DOWN_IPE, kb = r / (DM / 32), nb = r % (DM / 32);
        unsigned char* q = WD + (size_t)e * DM * DEXP + (size_t)(nb * 32 + 4 * (lane >> 3)) * DEXP + kb * 64 + 8 * (lane & 7);
#pragma unroll
        for (int c = 0; c < 4; ++c) { v2u o; o.x = pk4_fp8(v[0][c] * WPRE, v[1][c] * WPRE, v[2][c] * WPRE, v[3][c] * WPRE); o.y = pk4_fp8(v[4][c] * WPRE, v[5][c] * WPRE, v[6][c] * WPRE, v[7][c] * WPRE);
            *(GAS v2u*)(q + (size_t)c * DEXP) = o; }
    }
};

__device__ __forceinline__ void p1_load(Frame& F, f32x4 (&xv)[P1_IT][P1_RW][4]) {
    const int gw = F.vcu * NWAVES + F.wave, NGW = F.G * NWAVES, lane = F.lane;
#pragma unroll
    for (int k = 0; k < P1_IT; ++k) { const int pr = gw + k * NGW;
        if (pr < MALL / P1_RW) { const int m0 = P1_RW * pr; const float* xr = (m0 < MTOK) ? F_x + (size_t)m0 * DM : F_ctx + (size_t)(m0 - MTOK) * DM;
#pragma unroll
            for (int q = 0; q < P1_RW; ++q)
#pragma unroll
                for (int j = 0; j < 4; ++j) xv[k][q][j] = __builtin_nontemporal_load((const f32x4*)(xr + (size_t)q * DM + 4 * lane + 256 * j)); } }
}
__device__ __forceinline__ void p1_row_pair(Frame& F, int pr, f32x4 (&v)[P1_RW][4]) {
    const int lane = F.lane, m0 = P1_RW * pr;
    const float* mod = F_MOD + (size_t)((m0 < MTOK) ? (m0 >> 13) : 2) * NMODV;
    float rstd[P1_RW];
#pragma unroll
    for (int q = 0; q < P1_RW; ++q) { float ss = 0.f;
#pragma unroll
        for (int j = 0; j < 4; ++j) ss += (v[q][j].x * v[q][j].x + v[q][j].y * v[q][j].y) + (v[q][j].z * v[q][j].z + v[q][j].w * v[q][j].w);
        rstd[q] = 1.0f / sqrtf(wave_sum(ss) * (1.0f / DM) + EPS); }
#pragma unroll
    for (int j = 0; j < 4; ++j) { const int col = 4 * lane + 256 * j;
        const f32x4 g = *(const GAS f32x4*)(F_norm_mix_g + col), sh = *(const GAS f32x4*)(mod + col), sc = *(const GAS f32x4*)(mod + DM + col);
        const f32x4 gs = g * (1.0f + sc);
#pragma unroll
        for (int q = 0; q < P1_RW; ++q) { const f32x4 h = v[q][j] * rstd[q] * gs + sh;
            v2u w; w.x = pk2(h.x, h.y); w.y = pk2(h.z, h.w); ((GAS v2u*)(F_H + (size_t)(m0 + q) * DM))[lane + 64 * j] = w;
            ((GAS unsigned*)(F_H8 + (size_t)(m0 + q) * DM))[lane + 64 * j] = pk4_fp8(clamp448(h.x), clamp448(h.y), clamp448(h.z), clamp448(h.w)); } }
}
__device__ __forceinline__ void p1_hpass(Frame& F, f32x4 (&xv)[P1_IT][P1_RW][4]) {
    wait_counter((unsigned*)WSP(unsigned, WS_CTL) + CW_ARR0, NMODV / 32, (unsigned*)WSP(unsigned, WS_CTL) + CW_TMO);
    const int gw = F.vcu * NWAVES + F.wave, NGW = F.G * NWAVES, lane = F.lane;
#pragma unroll
    for (int k = 0; k < P1_IT; ++k) { const int pr = gw + k * NGW; if (pr < MALL / P1_RW) p1_row_pair(F, pr, xv[k]); }
    for (int pr = gw + P1_IT * NGW; pr < MALL / P1_RW; pr += NGW) {
        const int m0 = P1_RW * pr; const float* xr = (m0 < MTOK) ? F_x + (size_t)m0 * DM : F_ctx + (size_t)(m0 - MTOK) * DM; f32x4 v[P1_RW][4];
#pragma unroll
        for (int q = 0; q < P1_RW; ++q)
#pragma unroll
            for (int j = 0; j < 4; ++j) v[q][j] = __builtin_nontemporal_load((const f32x4*)(xr + (size_t)q * DM + 4 * lane + 256 * j));
        p1_row_pair(F, pr, v); }
}

struct GluOrder {
    int vcu, G; const char *H, *WIN;
    __device__ __forceinline__ bool next(int i, pg8::Unit& u) const {
        const size_t tstep = (size_t)256 * DM * 2;
        int pm, pn;
        if (G == 256) { if (i > 0) return false; const int x = vcu >> 5, s = vcu & 31; pm = 8 * x + (s & 7); pn = s >> 3; }
        else { const int L = i * G + vcu; if (L >= 256) return false; pm = L >> 2; pn = L & 3; }
        u.pm = pm; u.pn = pn; u.kind = 0; u.A = H + (size_t)pm * tstep; u.B = WIN + (size_t)pn * tstep; return true;
    }
};
struct QkvOrder {
    int vcu, G; const char *H8, *W8;
    __device__ __forceinline__ bool next(int i, pg8::Unit& u) const {
        const size_t tstep = (size_t)256 * DM;
        int pm, pn, kind;
        if (G == 256) {
            const int x = vcu >> 5, s = vcu & 31;
            if (i == 0) { pm = 8 * x + (s & 7); pn = 4 + (s >> 3); kind = pn < 6 ? 1 : 2; }
            else if (i == 1) {
                if (s < 16) { kind = 3; pm = s & 1; pn = 8 * x + (s >> 1); }
                else if (s == 16) { if (x < 4) { kind = 3; pm = x & 1; pn = 64 + (x >> 1); } else { kind = 2; pm = 64 + ((x - 4) >> 1); pn = 6 + ((x - 4) & 1); } }
                else return false;
            } else return false;
        } else {
            const int L = i * G + vcu;
            if (L < 256) { pm = L >> 2; pn = 4 + (L & 3); kind = pn < 6 ? 1 : 2; }
            else if (L < 260) { kind = 2; pm = 64 + ((L - 256) >> 1); pn = 6 + ((L - 256) & 1); }
            else if (L < 392) { kind = 3; pm = (L - 260) & 1; pn = (L - 260) >> 1; }
            else return false;
        }
        u.pm = pm; u.pn = pn; u.kind = kind;
        if (kind == 3) { u.A = W8 + (size_t)(4 + pm) * tstep; u.B = H8 + (size_t)pn * tstep; }
        else { u.A = H8 + (size_t)pm * tstep; u.B = W8 + (size_t)(pn - 4) * tstep; }
        return true;
    }
};
struct EpiInProj {
    static constexpr bool PERM = true;
    bf16 *U, *Q, *Kb, *Vt; float qscale;
    __device__ __forceinline__ void operator()(const pg8::f32x4 (&acc)[2][2][4][2], const pg8::Unit& u, int wr, int wc, int fr, int fq) const {
        const int row0 = u.pm * 256 + wr * 64 + fr;
        if (u.kind == 0) {
            const int col0 = u.pn * 128 + wc * 32 + 8 * fq;
#pragma unroll
            for (int ai = 0; ai < 2; ++ai)
#pragma unroll
                for (int m = 0; m < 4; ++m) {
                    float v[8];
#pragma unroll
                    for (int n = 0; n < 2; ++n)
#pragma unroll
                        for (int i = 0; i < 4; ++i) v[4 * n + i] = acc[ai][0][m][n][i] * fast_sigmoid(acc[ai][1][m][n][i]);
                    v4u w; w.x = pg8::cvt_pk_bf16(v[0], v[1]); w.y = pg8::cvt_pk_bf16(v[2], v[3]); w.z = pg8::cvt_pk_bf16(v[4], v[5]); w.w = pg8::cvt_pk_bf16(v[6], v[7]);
                    *(v4u*)(U + (size_t)(row0 + ai * 128 + m * 16) * CONVC + col0) = w; }
        } else if (u.kind == 3) {
            const int b = u.pn < 64 ? (u.pn >> 5) : (u.pn - 64), tb0 = u.pn < 64 ? ((u.pn & 31) << 8) : SEQ;
#pragma unroll
            for (int ai = 0; ai < 2; ++ai)
#pragma unroll
                for (int m = 0; m < 4; ++m) { const int vc = row0 + ai * 128 + m * 16, head = vc >> 6, d = vc & 63;
#pragma unroll
                    for (int bj = 0; bj < 2; ++bj) { const int tb = tb0 + bj * 128 + wc * 32 + 8 * fq, w0 = tb & 31;
                        const size_t off = ((((size_t)(b * 8 + head) * KTILES + (tb >> 5)) * 2 + (d >> 5)) * 2 + (w0 >> 4)) * 512 + (((w0 >> 3) & 1) * 32 + (d & 31)) * 8;
                        const pg8::f32x4 v0 = acc[ai][bj][m][0], v1 = acc[ai][bj][m][1];
                        v4u w; w.x = pg8::cvt_pk_bf16(v0[0], v0[1]); w.y = pg8::cvt_pk_bf16(v0[2], v0[3]); w.z = pg8::cvt_pk_bf16(v1[0], v1[1]); w.w = pg8::cvt_pk_bf16(v1[2], v1[3]);
                        *(v4u*)(Vt + off) = w; } }
        } else {
            const bool isq = u.kind == 1; const float sc = isq ? qscale : 1.f;
            const int colt = (u.pn - (isq ? 4 : 6)) * 256;
            const int b = u.pm < 64 ? (u.pm >> 5) : (u.pm - 64), tb0 = u.pm < 64 ? ((u.pm & 31) << 8) : SEQ;
            bf16* base = isq ? Q : Kb; const int ntile = isq ? (SEQ / 32) : KTILES;
#pragma unroll
            for (int ai = 0; ai < 2; ++ai)
#pragma unroll
                for (int m = 0; m < 4; ++m) { const int tb = tb0 + wr * 64 + fr + ai * 128 + m * 16; int w = tb & 31; if (!isq) w = (w & 0x13) | ((w & 4) << 1) | ((w & 8) >> 1);
#pragma unroll
                    for (int bj = 0; bj < 2; ++bj) { const int c0 = colt + bj * 128 + wc * 32 + 8 * fq, head = c0 >> 6, d0 = c0 & 63;
                        const size_t off = (((size_t)(b * 8 + head) * ntile + (tb >> 5)) * 4 + (d0 >> 4)) * 512 + (((d0 >> 3) & 1) * 32 + w) * 8;
                        const pg8::f32x4 v0 = acc[ai][bj][m][0] * sc, v1 = acc[ai][bj][m][1] * sc;
                        v4u wv; wv.x = pg8::cvt_pk_bf16(v0[0], v0[1]); wv.y = pg8::cvt_pk_bf16(v0[2], v0[3]); wv.z = pg8::cvt_pk_bf16(v1[0], v1[1]); wv.w = pg8::cvt_pk_bf16(v1[2], v1[3]);
                        *(v4u*)(base + off) = wv; } }
        }
    }
};

constexpr int P3_Y_OFF = 0;
constexpr int P3_BIAS_OFF = 0;
constexpr float ATT_THR = 8.0f;

struct AttnState { f32x16 O[2][2]; float mref[2], lsum[2]; };
template <bool LOCAL>
__device__ __forceinline__ void attn_tile(AttnState& st, const bf16x8 (&Ak)[4], const bf16x8 (&Av)[2][2], const bf16x8 (&Bq)[2][4], const LAS float* btrow, const int half, int q32, int hh) {
    f32x16 S[2];
    if (LOCAL) {
#pragma unroll
        for (int qt = 0; qt < 2; ++qt) { const int qc = 32 * qt + q32; int c0 = qc - 8; c0 = c0 < 0 ? 0 : (c0 > 48 ? 48 : c0);
            const int vb = 8 * hh + 32 * half - c0;
            const LAS float* bp = btrow + (8 * hh + 32 * half - qc + 63);
            const int rlo = (qt != half) ? (qt == 0 ? 0 : 8) : 0, rhi = (qt != half) ? rlo + 8 : 16;
#pragma unroll
            for (int rr = 0; rr < 16; ++rr) { const int kconst = 16 * (rr >> 3) + (rr & 7);
                if (rr >= rlo && rr < rhi) { const float bv = bp[kconst]; S[qt][rr] = ((unsigned)(kconst + vb) < 16u) ? bv : -1e30f; } else S[qt][rr] = 0.f; } }
    } else {
#pragma unroll
        for (int qt = 0; qt < 2; ++qt)
#pragma unroll
            for (int rr = 0; rr < 16; ++rr) S[qt][rr] = 0.f;
    }
#pragma unroll
    for (int qt = 0; qt < 2; ++qt)
#pragma unroll
        for (int ds = 0; ds < 4; ++ds) S[qt] = __builtin_amdgcn_mfma_f32_32x32x16_bf16(Ak[ds], Bq[qt][ds], S[qt], 0, 0, 0);
#pragma unroll
    for (int qt = 0; qt < 2; ++qt) {
        const bool corner = LOCAL && (qt != half);
        const int rlo = corner ? (qt == 0 ? 0 : 8) : 0, rhi = corner ? rlo + 8 : 16;
        float tm = fmaxf(S[qt][rlo], S[qt][rlo + 1]);
#pragma unroll
        for (int rr = rlo + 2; rr < rhi; ++rr) tm = fmaxf(tm, S[qt][rr]);
        tm = fmaxf(tm, __shfl_xor(tm, 32));
        if (__any(tm > st.mref[qt] + ATT_THR)) {
            const float mn = fmaxf(st.mref[qt], tm), sc = __builtin_amdgcn_exp2f(st.mref[qt] - mn);
            st.mref[qt] = mn; st.lsum[qt] *= sc;
#pragma unroll
            for (int i = 0; i < 16; ++i) { st.O[0][qt][i] *= sc; st.O[1][qt][i] *= sc; }
        }
        float p[16]; float ps = 0.f;
#pragma unroll
        for (int rr = 0; rr < 16; ++rr) { if (rr >= rlo && rr < rhi) { p[rr] = __builtin_amdgcn_exp2f(S[qt][rr] - st.mref[qt]); ps += p[rr]; } else p[rr] = 0.f; }
        st.lsum[qt] += ps;
#pragma unroll
        for (int s2 = 0; s2 < 2; ++s2) {
            if (8 * s2 >= rlo && 8 * s2 < rhi) {
                v4u w; w.x = pg8::cvt_pk_bf16(p[8 * s2 + 0], p[8 * s2 + 1]); w.y = pg8::cvt_pk_bf16(p[8 * s2 + 2], p[8 * s2 + 3]); w.z = pg8::cvt_pk_bf16(p[8 * s2 + 4], p[8 * s2 + 5]); w.w = pg8::cvt_pk_bf16(p[8 * s2 + 6], p[8 * s2 + 7]);
                const bf16x8 Bp = __builtin_bit_cast(bf16x8, w);
#pragma unroll
                for (int dt = 0; dt < 2; ++dt) st.O[dt][qt] = __builtin_amdgcn_mfma_f32_32x32x16_bf16(Av[dt][s2], Bp, st.O[dt][qt], 0, 0, 0);
            }
        }
    }
}
#define ATT_LOADK(AK, TILE) do { _Pragma("unroll") for (int ds = 0; ds < 4; ++ds) AK[ds] = *(const GAS bf16x8*)(Kh + ((size_t)(TILE) * 4 + ds) * 512); } while (0)
#define ATT_LOADV(AV, TILE) do { _Pragma("unroll") for (int dt = 0; dt < 2; ++dt) _Pragma("unroll") for (int s2 = 0; s2 < 2; ++s2) AV[dt][s2] = *(const GAS bf16x8*)(Vh + (((size_t)(TILE) * 2 + dt) * 2 + s2) * 512); } while (0)
__device__ __forceinline__ void attn_wave(Frame& F, int b, int r) {
    const int lane = F.lane, head = F.wave, q32 = lane & 31, hh = lane >> 5;
    const LAS float* bt = (const LAS float*)(F.lds + P3_BIAS_OFF) + head * 15 * 128;
    const int tok0 = b * SEQ + r * 64;
    bf16x8 Bq[2][4];
#pragma unroll
    for (int qt = 0; qt < 2; ++qt)
#pragma unroll
        for (int ds = 0; ds < 4; ++ds) Bq[qt][ds] = *(const GAS bf16x8*)(F_Q + ((((size_t)(b * 8 + head) * (SEQ / 32) + 2 * r + qt) * 4 + ds) * 64 + lane) * 8);
    AttnState st;
#pragma unroll
    for (int a = 0; a < 2; ++a)
#pragma unroll
        for (int c = 0; c < 2; ++c)
#pragma unroll
            for (int i = 0; i < 16; ++i) st.O[a][c][i] = 0.f;
    st.mref[0] = st.mref[1] = -1e30f; st.lsum[0] = st.lsum[1] = 0.f;
    int r0 = r - 4; r0 = r0 < 0 ? 0 : (r0 > GROWS - 8 ? GROWS - 8 : r0);
    const bf16* Kh = F_K + (size_t)(b * 8 + head) * KTILES * 2048 + lane * 8;
    const bf16* Vh = F_VT + (size_t)(b * 8 + head) * KTILES * 2048 + lane * 8;
    const int ctx0 = SEQ / 32, loc0 = 2 * r0;
    bf16x8 Ka[4], Kb[4], Vc[2][2];
    ATT_LOADK(Ka, ctx0);
#pragma unroll 1
    for (int t = 0; t < 8; t += 2) {
        ATT_LOADV(Vc, ctx0 + t); ATT_LOADK(Kb, ctx0 + t + 1);
        attn_tile<false>(st, Ka, Vc, Bq, bt, 0, q32, hh);
        ATT_LOADV(Vc, ctx0 + t + 1); { const int nt = (t + 2 < 8) ? ctx0 + t + 2 : loc0; ATT_LOADK(Ka, nt); }
        attn_tile<false>(st, Kb, Vc, Bq, bt, 0, q32, hh);
    }
#pragma unroll 1
    for (int j = 0; j < 8; ++j) { const int kr = r0 + j; const LAS float* btrow = bt + (kr - r + 7) * 128;
        ATT_LOADV(Vc, loc0 + 2 * j); ATT_LOADK(Kb, loc0 + 2 * j + 1);
        attn_tile<true>(st, Ka, Vc, Bq, btrow, 0, q32, hh);
        ATT_LOADV(Vc, loc0 + 2 * j + 1); { const int nt = (j + 1 < 8) ? loc0 + 2 * (j + 1) : loc0; ATT_LOADK(Ka, nt); }
        attn_tile<true>(st, Kb, Vc, Bq, btrow, 1, q32, hh);
    }
#pragma unroll
    for (int qt = 0; qt < 2; ++qt) {
        const float lt = st.lsum[qt] + __shfl_xor(st.lsum[qt], 32), inv = 1.0f / lt;
        bf16* orow = F_MIX + (size_t)(tok0 + 32 * qt + q32) * DM + CONVC + head * HD + 4 * hh;
#pragma unroll
        for (int dt = 0; dt < 2; ++dt)
#pragma unroll
            for (int g4 = 0; g4 < 4; ++g4) { v2u w; w.x = pg8::cvt_pk_bf16(st.O[dt][qt][4 * g4 + 0] * inv, st.O[dt][qt][4 * g4 + 1] * inv); w.y = pg8::cvt_pk_bf16(st.O[dt][qt][4 * g4 + 2] * inv, st.O[dt][qt][4 * g4 + 3] * inv);
                st_wt8(orow + 32 * dt + 8 * g4, w); }
    }
}

__device__ __forceinline__ void conv_unit(Frame& F, int b, int r) {
    const int lane = F.lane, w = F.wave;
    const int cp = F.tid & 255, th = F.tid >> 8;
    LAS float* yb = (LAS float*)(F.lds + P3_Y_OFF);
    const float *cw = F_conv_w, *cb = F_conv_b, *lg = F_conv_ln_g, *lb = F_conv_ln_b;
    asm volatile("" : "+s"(cw), "+s"(cb), "+s"(lg), "+s"(lb));
    {
        const int t0 = r * 64 + 32 * th - 15;
        f32x2 in[62];
        const bf16* up = F_U + (size_t)b * SEQ * CONVC + 2 * cp;
#pragma unroll
        for (int k = 0; k < 62; ++k) { const int tt = t0 + k; unsigned wv = 0u; if (tt >= 0 && tt < SEQ) wv = *(const GAS unsigned*)(up + (size_t)tt * CONVC); in[k] = (f32x2){bf_lo(wv), bf_hi(wv)}; }
        f32x2 wj[CONVW];
#pragma unroll
        for (int j = 0; j < CONVW; ++j) wj[j] = *(const GAS f32x2*)(cw + j * CONVC + 2 * cp);
        const f32x2 bias = *(const GAS f32x2*)(cb + 2 * cp);
#pragma unroll
        for (int t = 0; t < 32; ++t) { f32x2 a = bias;
#pragma unroll
            for (int j = 0; j < CONVW; ++j) a = wj[j] * in[t + j] + a;
            *(LAS f32x2*)(yb + (32 * th + t) * CONVC + 2 * cp) = a; }
    }
    __syncthreads();
    const f32x4 g0 = *(const GAS f32x4*)(lg + 8 * lane), g1 = *(const GAS f32x4*)(lg + 8 * lane + 4);
    const f32x4 b0 = *(const GAS f32x4*)(lb + 8 * lane), b1 = *(const GAS f32x4*)(lb + 8 * lane + 4);
#pragma unroll 2
    for (int k = 0; k < 8; ++k) { const int tk = 8 * w + k;
        f32x4 y0 = *(const LAS f32x4*)(yb + tk * CONVC + 8 * lane), y1 = *(const LAS f32x4*)(yb + tk * CONVC + 8 * lane + 4);
        const float s = wave_sum((y0.x + y0.y) + (y0.z + y0.w) + (y1.x + y1.y) + (y1.z + y1.w));
        const float mean = s * (1.0f / CONVC);
        y0 = y0 - mean; y1 = y1 - mean;
        const float q = wave_sum((y0.x * y0.x + y0.y * y0.y) + (y0.z * y0.z + y0.w * y0.w) + (y1.x * y1.x + y1.y * y1.y) + (y1.z * y1.z + y1.w * y1.w));
        const float rstd = 1.0f / sqrtf(q * (1.0f / CONVC) + EPS);
        y0 = y0 * rstd * g0 + b0; y1 = y1 * rstd * g1 + b1;
        v4u wv; wv.x = pk2(y0.x * fast_sigmoid(y0.x), y0.y * fast_sigmoid(y0.y)); wv.y = pk2(y0.z * fast_sigmoid(y0.z), y0.w * fast_sigmoid(y0.w));
        wv.z = pk2(y1.x * fast_sigmoid(y1.x), y1.y * fast_sigmoid(y1.y)); wv.w = pk2(y1.z * fast_sigmoid(y1.z), y1.w * fast_sigmoid(y1.w));
        st_wt16(F_MIX + (size_t)(b * SEQ + r * 64 + tk) * DM + 8 * lane, wv); }
    __syncthreads();
}

__device__ __forceinline__ void p3_bias_fill(Frame& F, int r) {
    LAS float* bt = (LAS float*)(F.lds + P3_BIAS_OFF);
    int r0 = r - 4; r0 = r0 < 0 ? 0 : (r0 > GROWS - 8 ? GROWS - 8 : r0); const int dr0 = r0 - r + 7;
    for (int i = F.tid; i < NHEADS * 8 * 128; i += NWAVES * 64) { const int d = (i & 127) - 48, dr = dr0 + ((i >> 7) & 7), hd = i >> 10; bt[(hd * 15 + dr) * 128 + (i & 127)] = (d >= 0 && d < 31) ? F_rpb[(hd * 15 + dr) * 31 + d] * LOG2E : 0.f; }
}
__device__ __forceinline__ void p3_mixers(Frame& F, const bool prefilled) {
    LAS float* bt = (LAS float*)(F.lds + P3_BIAS_OFF);
    for (int u = F.vcu; u < NB * GROWS; u += F.G) {
        const int b = u / GROWS, r = u % GROWS;
        SEC_BEGIN(3)
        if (u != F.vcu || !prefilled) p3_bias_fill(F, r);
        __syncthreads();
        SEC_END(3)
        SEC_BEGIN(1)
#ifndef PROBE_ATTN
#define PROBE_ATTN 1
#endif
#pragma unroll 1
        for (int rp = 0; rp < PROBE_ATTN; ++rp) attn_wave(F, b, r);
        asm volatile("" ::: "memory"); __builtin_amdgcn_sched_barrier(0); __syncthreads(); asm volatile("" ::: "memory");
        SEC_END(1)
        SEC_BEGIN(2)
        conv_unit(F, b, r);
        SEC_END(2)
        arrive_counter2((unsigned*)WSP(unsigned, WS_CTL) + CW_ARR3 + CW_ARRS * (u >> 2), (unsigned*)WSP(unsigned, WS_CTL) + CW_ARR3 - CW_ARRS);
    }
}

struct OutProjOrder {
    int vcu, G; const char *MIX, *WOUT;
    __device__ __forceinline__ bool next(int i, pg8::Unit& u) const {
        const size_t tstep = (size_t)256 * DM * 2;
        int pm, pn;
        if (G == 256) { if (i > 0) return false; const int x = vcu >> 5, s = vcu & 31; pm = 8 * x + (s & 7); pn = s >> 3; }
        else { const int L = i * G + vcu; if (L >= 256) return false; pm = L >> 2; pn = L & 3; }
        u.pm = pm; u.pn = pn; u.kind = 0; u.A = MIX + (size_t)pm * tstep; u.B = WOUT + (size_t)pn * tstep; return true;
    }
};
struct EpiOutProj {
    static constexpr bool PERM = true;
    const float* x; const float* MOD; bf16* X1;
    __device__ __forceinline__ void operator()(const pg8::f32x4 (&acc)[2][2][4][2], const pg8::Unit& u, int wr, int wc, int fr, int fq) const {
        const int row0 = u.pm * 256 + wr * 64 + fr, col0 = u.pn * 256 + wc * 32 + 8 * fq;
        const float* g1 = MOD + (size_t)(u.pm >> 5) * NMODV + 2 * DM;
        pg8::f32x4 gv[2][2];
#pragma unroll
        for (int bj = 0; bj < 2; ++bj)
#pragma unroll
            for (int n = 0; n < 2; ++n) gv[bj][n] = *(const pg8::f32x4*)(g1 + col0 + bj * 128 + n * 4);
#pragma unroll
        for (int ai = 0; ai < 2; ++ai) {
            pg8::f32x4 xr[4][2][2];
#pragma unroll
            for (int m = 0; m < 4; ++m) { const size_t off = (size_t)(row0 + ai * 128 + m * 16) * DM + col0;
#pragma unroll
                for (int bj = 0; bj < 2; ++bj) { xr[m][bj][0] = *(const pg8::f32x4*)(x + off + bj * 128); xr[m][bj][1] = *(const pg8::f32x4*)(x + off + bj * 128 + 4); } }
#pragma unroll
            for (int m = 0; m < 4; ++m) { const size_t off = (size_t)(row0 + ai * 128 + m * 16) * DM + col0;
#pragma unroll
                for (int bj = 0; bj < 2; ++bj) { const pg8::f32x4 v0 = xr[m][bj][0] + gv[bj][0] * acc[ai][bj][m][0], v1 = xr[m][bj][1] + gv[bj][1] * acc[ai][bj][m][1];
                    v4u w; w.x = pg8::cvt_pk_bf16(v0[0], v0[1]); w.y = pg8::cvt_pk_bf16(v0[2], v0[3]); w.z = pg8::cvt_pk_bf16(v1[0], v1[1]); w.w = pg8::cvt_pk_bf16(v1[2], v1[3]);
                    st_wt16(X1 + off + bj * 128, w); } }
        }
    }
};

__device__ __forceinline__ void p5_router(Frame& F) {
    LAS f32x4* wl = (LAS f32x4*)(F.lds + RING_OFF);
    for (int idx = F.tid; idx < DM * 4; idx += NWAVES * 64) { const int c = idx >> 2, q = idx & 3; const f32x4 v = *(const GAS f32x4*)(F_w_router + c * NEXP + 4 * q);
        const int j = c >> 8, l = (c & 255) >> 2, i = c & 3; wl[((j * 4 + i) * 4 + q) * 64 + l] = v; }
    __syncthreads();
    const int gw = F.vcu * NWAVES + F.wave, NGW = F.G * NWAVES, lane = F.lane;
    { unsigned* c4 = (unsigned*)WSP(unsigned, WS_CTL) + CW_ARR4; unsigned* tmo = (unsigned*)WSP(unsigned, WS_CTL) + CW_TMO;
      if (F.G == 256) wait_counter(c4 + CW_ARRS * (F.vcu >> 2), 4u, tmo); else wait_counter(c4 - CW_ARRS, 256u, tmo); }
    const int qstep = (F.G == 256) ? NWAVES : NGW, qbeg = (F.G == 256) ? F.vcu * 16 + F.wave : gw, qend = (F.G == 256) ? F.vcu * 16 + 16 : MTOK / 4;
    for (int qd = qbeg; qd < qend; qd += qstep) {
        const int m0 = 4 * qd, b = m0 >> 13;
        const float* mod = F_MOD + (size_t)b * NMODV;
        f32x4 v[4][4];
#pragma unroll
        for (int tk = 0; tk < 4; ++tk)
#pragma unroll
            for (int j = 0; j < 4; ++j) { const v2u w = ((const GAS v2u*)(F_X1 + (size_t)(m0 + tk) * DM))[lane + 64 * j]; v[tk][j] = (f32x4){bf_lo(w.x), bf_hi(w.x), bf_lo(w.y), bf_hi(w.y)}; }
        float rstd[4];
#pragma unroll
        for (int tk = 0; tk < 4; ++tk) { float ss = 0.f;
#pragma unroll
            for (int j = 0; j < 4; ++j) ss += (v[tk][j].x * v[tk][j].x + v[tk][j].y * v[tk][j].y) + (v[tk][j].z * v[tk][j].z + v[tk][j].w * v[tk][j].w);
            rstd[tk] = 1.0f / sqrtf(wave_sum(ss) * (1.0f / DM) + EPS); }
        float lg[64];
#pragma unroll
        for (int e = 0; e < 64; ++e) lg[e] = 0.f;
#pragma unroll
        for (int j = 0; j < 4; ++j) { const int col = 4 * lane + 256 * j;
            const f32x4 g = *(const GAS f32x4*)(F_norm_ffn_g + col), sh = *(const GAS f32x4*)(mod + 3 * DM + col), sc = *(const GAS f32x4*)(mod + 4 * DM + col);
            const f32x4 gs = g * (1.0f + sc);
#pragma unroll
            for (int tk = 0; tk < 4; ++tk) { v[tk][j] = v[tk][j] * rstd[tk] * gs + sh;
                ((GAS unsigned*)((unsigned char*)F_H2 + (size_t)(m0 + tk) * DM))[lane + 64 * j] = pk4_fp8(clamp448(v[tk][j].x), clamp448(v[tk][j].y), clamp448(v[tk][j].z), clamp448(v[tk][j].w)); }
#pragma unroll
            for (int i = 0; i < 4; ++i) {
#pragma unroll
                for (int q = 0; q < 4; ++q) { const f32x4 wv = wl[((j * 4 + i) * 4 + q) * 64 + lane];
#pragma unroll
                    for (int tk = 0; tk < 4; ++tk) { const float hv = v[tk][j][i];
                        lg[tk * 16 + 4 * q + 0] += hv * wv.x; lg[tk * 16 + 4 * q + 1] += hv * wv.y; lg[tk * 16 + 4 * q + 2] += hv * wv.z; lg[tk * 16 + 4 * q + 3] += hv * wv.w; } }
                __builtin_amdgcn_sched_barrier(0); } }
#pragma unroll
        for (int w = 32; w >= 1; w >>= 1) {
#pragma unroll
            for (int i = 0; i < w; ++i) { const bool up = (lane & w) != 0; const float send = up ? lg[i] : lg[i + w], keep = up ? lg[i + w] : lg[i]; lg[i] = keep + __shfl_xor(send, w); } }
        const float logit = lg[0];
        const float mx = row16_max(logit), p = __expf(logit - mx), den = row16_sum(p);
        const int tk = lane >> 4, e = lane & 15, t = (m0 + tk) & (SEQ - 1);
        st_wt(&F_AFF[(size_t)(b * NEXP + e) * SEQ + t], p / den);
    }
    arrive_counter((unsigned*)WSP(unsigned, WS_CTL) + CW_ARR5);
}

__device__ __forceinline__ int block_excl_scan(int v, LAS int* sc, int tid, int lane, int wave, int& total) {
    int inc = v;
#pragma unroll
    for (int o = 1; o < 64; o <<= 1) { const int t = __shfl_up(inc, o); if (lane >= o) inc += t; }
    __syncthreads();
    if (lane == 63) sc[wave] = inc;
    __syncthreads();
    int base = 0, tot = 0;
#pragma unroll
    for (int w = 0; w < 8; ++w) { const int c = sc[w]; if (w < wave) base += c; tot += c; }
    total = tot;
    return base + inc - v;
}
__device__ __forceinline__ void p6_topk(Frame& F) {
    LAS int* hist = (LAS int*)(F.lds + RING_OFF);
    LAS int* sel = hist + 256;
    LAS int* sc = hist + 264;
    if ((int)blockIdx.x < NB * NEXP) wait_counter((unsigned*)WSP(unsigned, WS_CTL) + CW_ARR5, (unsigned)F.G, (unsigned*)WSP(unsigned, WS_CTL) + CW_TMO);
    for (int be = blockIdx.x; be < NB * NEXP; be += F.G) {
        const int b = be >> 4, e = be & 15;
        const float* a = F_AFF + (size_t)be * SEQ + 16 * F.tid;
        unsigned v[16];
#pragma unroll
        for (int j = 0; j < 4; ++j) { const v4u q = *(const GAS v4u*)(a + 4 * j); v[4 * j] = q.x; v[4 * j + 1] = q.y; v[4 * j + 2] = q.z; v[4 * j + 3] = q.w; }
        unsigned prefix = 0u, mask = 0u; int kk = CAP;
#pragma unroll 1
        for (int pass = 0; pass < 4; ++pass) { const int shift = 24 - 8 * pass;
            __syncthreads();
            if (F.tid < 256) hist[F.tid] = 0;
            __syncthreads();
#pragma unroll
            for (int j = 0; j < 16; ++j) if ((v[j] & mask) == prefix) __hip_atomic_fetch_add(&hist[(v[j] >> shift) & 255u], 1, __ATOMIC_RELAXED, __HIP_MEMORY_SCOPE_WORKGROUP);
            __syncthreads();
            if (F.wave == 0) {
                int c[4]; int s4 = 0;
#pragma unroll
                for (int j = 0; j < 4; ++j) { c[j] = hist[4 * F.lane + j]; s4 += c[j]; }
                int suf = s4;
#pragma unroll
                for (int o = 1; o < 64; o <<= 1) { const int t = __shfl_down(suf, o); if (F.lane + o < 64) suf += t; }
                int above = suf - s4;
#pragma unroll
                for (int j = 3; j >= 0; --j) { if (above < kk && kk <= above + c[j]) { sel[0] = 4 * F.lane + j; sel[1] = kk - above; } above += c[j]; }
            }
            __syncthreads();
            prefix |= (unsigned)sel[0] << shift; mask |= 255u << shift; kk = sel[1];
        }
        const unsigned T = prefix; const int need_eq = kk;
        int ceq = 0;
#pragma unroll
        for (int j = 0; j < 16; ++j) ceq += (v[j] == T) ? 1 : 0;
        int tot; int eqb = block_excl_scan(ceq, sc, F.tid, F.lane, F.wave, tot);
        unsigned selm = 0u; int csel = 0;
#pragma unroll
        for (int j = 0; j < 16; ++j) { bool s = v[j] > T; if (v[j] == T) { s = eqb < need_eq; ++eqb; } if (s) { selm |= 1u << j; ++csel; } }
        int slot = block_excl_scan(csel, sc, F.tid, F.lane, F.wave, tot);
        const int obase = (e * 2 + b) * CAP;
        int iv[16];
#pragma unroll
        for (int j = 0; j < 16; ++j) { const bool s = (selm >> j) & 1u; iv[j] = s ? slot : -1;
            if (s) { F_TOK[obase + slot] = 16 * F.tid + j; F_WTS[obase + slot] = __builtin_bit_cast(float, v[j]); ++slot; } }
        int* ip = F_INV + (size_t)be * SEQ + 16 * F.tid;
#pragma unroll
        for (int j = 0; j < 4; ++j) *(GAS v4u*)(ip + 4 * j) = (v4u){(unsigned)iv[4 * j], (unsigned)iv[4 * j + 1], (unsigned)iv[4 * j + 2], (unsigned)iv[4 * j + 3]};
        __syncthreads();
    }
}

struct GateUpOrder {
    int vcu, G; const char *H2, *WGU; const int* TOK;
    __device__ __forceinline__ bool next(int i, pg8::Unit& u) const {
        int e, pml, pn;
        if (G == 256) { if (i >= 8) return false; const int x = vcu >> 5, s = vcu & 31; e = 2 * x + (i >> 2); pml = s & 7; pn = 4 * (i & 3) + (s >> 3); }
        else { const int L = i * G + vcu; if (L >= 2048) return false; e = L >> 7; pml = L & 7; pn = (L >> 3) & 15; }
        u.pm = e * 8 + pml; u.pn = pn; u.kind = 0;
        u.A = H2; u.B = WGU + ((size_t)e * 2 * DEXP + (size_t)pn * 256) * DM; return true;
    }
    __device__ __forceinline__ const int* rows(const pg8::Unit& u) const { return TOK + u.pm * 256; }
    __device__ __forceinline__ int row_base(const pg8::Unit& u) const { return ((u.pm >> 2) & 1) * SEQ; }
};
struct EpiSwiGLU {
    static constexpr bool PERM = true;
    unsigned char* HID;
    __device__ __forceinline__ void operator()(const pg8::f32x4 (&acc)[2][2][4][2], const pg8::Unit& u, int wr, int wc, int fr, int fq) const { half(acc, u, wr, wc, fr, fq, 0); half(acc, u, wr, wc, fr, fq, 1); }
    __device__ __forceinline__ void half(const pg8::f32x4 (&acc)[2][2][4][2], const pg8::Unit& u, int wr, int wc, int fr, int fq, const int ai) const {
        asm volatile("" : "+v"(fr), "+v"(fq));
        const int row0 = u.pm * 256 + wr * 64 + fr, col0 = u.pn * 128 + wc * 32 + 8 * fq;
#pragma unroll
            for (int m = 0; m < 4; ++m) {
                float v[8];
#pragma unroll
                for (int n = 0; n < 2; ++n)
#pragma unroll
                    for (int i = 0; i < 4; i += 2) { const f32x2 g2 = (f32x2){acc[ai][0][m][n][i], acc[ai][0][m][n][i + 1]}, u2 = (f32x2){acc[ai][1][m][n][i], acc[ai][1][m][n][i + 1]};
                        f32x2 d2 = (f32x2){__builtin_amdgcn_exp2f(-g2.x), __builtin_amdgcn_exp2f(-g2.y)} + 1.0f;
                        const f32x2 r2 = (f32x2){__builtin_amdgcn_rcpf(d2.x), __builtin_amdgcn_rcpf(d2.y)}, h2 = (g2 * u2) * r2;
                        v[4 * n + i] = clamp448(h2.x); v[4 * n + i + 1] = clamp448(h2.y); }
                v2u w; w.x = pk4_fp8(v[0], v[1], v[2], v[3]); w.y = pk4_fp8(v[4], v[5], v[6], v[7]);
                *(v2u*)(HID + (size_t)(row0 + ai * 128 + m * 16) * DEXP + col0) = w; }
    }
};
struct DownOrder {
    int vcu, G; const char *HID, *WD;
    __device__ __forceinline__ bool next(int i, pg8::Unit& u) const {
        int e, pml, pn;
        if (G == 256) { if (i >= 2) return false; const int x = vcu >> 5, s = vcu & 31; e = 2 * x + i; pml = s & 7; pn = s >> 3; }
        else { const int L = i * G + vcu; if (L >= 512) return false; e = L >> 5; pml = L & 7; pn = (L >> 3) & 3; }
        u.pm = e * 8 + pml; u.pn = pn; u.kind = 0;
        u.A = HID + (size_t)u.pm * 256 * DEXP; u.B = WD + ((size_t)e * DM + (size_t)pn * 256) * DEXP; return true;
    }
};
constexpr float YS_SCALE = 16.0f;
struct EpiDown {
    static constexpr bool PERM = true;
    unsigned char* YS; const float* WTS;
    __device__ __forceinline__ void operator()(const pg8::f32x4 (&acc)[2][2][4][2], const pg8::Unit& u, int wr, int wc, int fr, int fq) const {
        const int row0 = u.pm * 256 + wr * 64 + fr, col0 = u.pn * 256 + wc * 32 + 8 * fq;
#pragma unroll
        for (int ai = 0; ai < 2; ++ai)
#pragma unroll
            for (int m = 0; m < 4; ++m) { const int row = row0 + ai * 128 + m * 16; const float wt = WTS[row] * YS_SCALE; unsigned char* rowp = YS + (size_t)row * DM + col0;
#pragma unroll
                for (int bj = 0; bj < 2; ++bj) { const pg8::f32x4 v0 = acc[ai][bj][m][0] * wt, v1 = acc[ai][bj][m][1] * wt;
                    v2u w; w.x = pk4_fp8(clamp448(v0[0]), clamp448(v0[1]), clamp448(v0[2]), clamp448(v0[3])); w.y = pk4_fp8(clamp448(v1[0]), clamp448(v1[1]), clamp448(v1[2]), clamp448(v1[3]));
                    *(v2u*)(rowp + bj * 128) = w; } }
    }
};

__device__ __forceinline__ void p9_final(Frame& F) {
    const int gw = F.vcu * NWAVES + F.wave, NGW = F.G * NWAVES, lane = F.lane, half = lane >> 5, l32 = lane & 31;
    for (int pr = gw; pr < MTOK / 2; pr += NGW) {
        const int m = 2 * pr + half, b = m >> 13, t = m & (SEQ - 1);
        const float* mod = F_MOD + (size_t)b * NMODV;
        int slotv = -1;
        if (l32 < 16) slotv = F_INV[(size_t)(b * NEXP + l32) * SEQ + t];
        f32x4 v[8], sum[8];
#pragma unroll
        for (int j = 0; j < 4; ++j) { const v4u w = ((const GAS v4u*)(F_X1 + (size_t)m * DM))[l32 + 32 * j];
            v[2 * j] = (f32x4){bf_lo(w.x), bf_hi(w.x), bf_lo(w.y), bf_hi(w.y)}; v[2 * j + 1] = (f32x4){bf_lo(w.z), bf_hi(w.z), bf_lo(w.w), bf_hi(w.w)};
            sum[2 * j] = (f32x4){0.f, 0.f, 0.f, 0.f}; sum[2 * j + 1] = (f32x4){0.f, 0.f, 0.f, 0.f}; }
        const unsigned long long bal = __ballot(slotv >= 0);
        unsigned my16 = (unsigned)(bal >> (32 * half)) & 0xffffu;
        const int cnt = __popc(my16), ocnt = __popc((unsigned)(bal >> (32 * (1 - half))) & 0xffffu);
        const int maxcnt = cnt > ocnt ? cnt : ocnt;
        for (int k0 = 0; k0 < maxcnt; k0 += 4) {
            v2u rows[4][4]; bool val[4];
#pragma unroll
            for (int kk = 0; kk < 4; ++kk) { val[kk] = my16 != 0u; const int e = val[kk] ? (__ffs(my16) - 1) : 0; my16 &= my16 - 1u;
                const int sl = __shfl(slotv, 32 * half + e);
                const GAS v2u* yr = (const GAS v2u*)((const unsigned char*)F_YS + (size_t)((e * 2 + b) * CAP + (sl < 0 ? 0 : sl)) * DM) + l32;
#pragma unroll
                for (int j = 0; j < 4; ++j) rows[kk][j] = val[kk] ? yr[32 * j] : (v2u){0u, 0u}; }
#pragma unroll
            for (int kk = 0; kk < 4; ++kk)
#pragma unroll
                for (int j = 0; j < 4; ++j) { const v2u w = rows[kk][j];
                    const auto a0 = __builtin_amdgcn_cvt_pk_f32_fp8((int)w.x, false), a1 = __builtin_amdgcn_cvt_pk_f32_fp8((int)w.x, true), a2 = __builtin_amdgcn_cvt_pk_f32_fp8((int)w.y, false), a3 = __builtin_amdgcn_cvt_pk_f32_fp8((int)w.y, true);
                    sum[2 * j].x += a0[0]; sum[2 * j].y += a0[1]; sum[2 * j].z += a1[0]; sum[2 * j].w += a1[1];
                    sum[2 * j + 1].x += a2[0]; sum[2 * j + 1].y += a2[1]; sum[2 * j + 1].z += a3[0]; sum[2 * j + 1].w += a3[1]; }
        }
        float ss = 0.f;
#pragma unroll
        for (int q = 0; q < 8; ++q) { const int col = 8 * l32 + 256 * (q >> 1) + 4 * (q & 1); const f32x4 g2 = *(const GAS f32x4*)(mod + 5 * DM + col);
            v[q] = v[q] + g2 * (sum[q] * (1.0f / YS_SCALE)); ss += (v[q].x * v[q].x + v[q].y * v[q].y) + (v[q].z * v[q].z + v[q].w * v[q].w); }
        const float rstd = 1.0f / sqrtf(half_sum(ss, half) * (1.0f / DM) + EPS);
#pragma unroll
        for (int q = 0; q < 8; ++q) { const int col = 8 * l32 + 256 * (q >> 1) + 4 * (q & 1); const f32x4 g = *(const GAS f32x4*)(F_norm_final_g + col);
            *(GAS f32x4*)(F_out + (size_t)m * DM + col) = v[q] * rstd * g; }
    }
}

constexpr int N_PHASES = 9;
#ifndef P2_QUOTA
#define P2_QUOTA 0
#endif
#ifndef P2_QWAVES
#define P2_QWAVES 8
#endif
__global__ void __launch_bounds__(NWAVES * 64, 2) mk_fwd(Args args) {
    extern __shared__ __attribute__((aligned(16))) unsigned char lds[];
    Frame F;
    F.lds = (LAS unsigned char*)lds;
    F.MISC = (volatile LAS unsigned*)(F.lds + MISC_OFF);
    F.tid = threadIdx.x; F.lane = F.tid & 63; F.wave = __builtin_amdgcn_readfirstlane(F.tid >> 6);
    F.G = gridDim.x; { const int bx = blockIdx.x; F.vcu = (F.G % 8 == 0) ? (bx % 8) * (F.G / 8) + bx / 8 : bx; }
    F.a = &args; F.pacc = 0ull;
    gu32* ctl = (gu32*)(args.ws + WS_CTL);
    for (int u = F.tid; u < (MISC_OFF + 128 - LDSCTL_OFF) / 4; u += NWAVES * 64) ((LAS unsigned*)(F.lds + LDSCTL_OFF))[u] = 0u;
    __syncthreads();
    const int lo = args.ph_lo, hi = args.ph_hi;
    const bool multi = (hi - lo) > 1;
    XcdBarrier bar; bar.bar = (unsigned*)(ctl + CW_BAR); bar.x = 0; bar.st = nullptr;
    if (multi) bar = xcd_barrier_post((unsigned*)(ctl + CW_BAR), F.MISC + 8);
#ifndef PH_MASK
#define PH_MASK 0xFFFF
#endif
#define IN(k) ((((PH_MASK) >> (k)) & 1) && lo <= (k) && (k) < hi)
#define SEAM(k) do { if ((k) != 0 && (k) != 3 && (k) != 4 && (k) != 5 && IN(k) && IN((k) + 1)) xcd_barrier(bar); } while (0)

#ifndef PROBE_REP
#define PROBE_REP 0
#endif
#define NREP(k) (1 + (((PROBE_REP) >> (k)) & 1))
#ifndef PROBE_SPAN
#define PROBE_SPAN -1
#endif
    unsigned long long span_t0 = 0ull, span_dt = 0ull;
#define PHASE(k, ...) if (IN(k)) { if ((k) == PROBE_SPAN) span_t0 = __builtin_amdgcn_s_memrealtime(); for (int rep_ = 0; rep_ < NREP(k); ++rep_) { __VA_ARGS__; if (rep_ + 1 < NREP(k)) xcd_barrier(bar); } SEAM(k); if ((k) == PROBE_SPAN) span_dt = __builtin_amdgcn_s_memrealtime() - span_t0; }
    if (PROBE_SPAN == 99) span_t0 = __builtin_amdgcn_s_memrealtime();
    f32x4 xv_[P1_IT][P1_RW][4];
    PHASE(0, p0_prologue(F, xv_))
    PHASE(1, p1_hpass(F, xv_))
    PHASE(2, { EpiInProj E{F_U, F_Q, F_K, F_VT, 0.125f * LOG2E};
               { GluOrder S{F.vcu, F.G, (const char*)F_H, (const char*)F_WIN}; pg8::gemm_phase<EpiInProj, GluOrder>(F.lds + RING_OFF, 2 * DM, S, E); }
               { QkvOrder S{F.vcu, F.G, (const char*)F_H8, (const char*)F_WQKV8}; pg8::gemm_phase<EpiInProj, QkvOrder, false, true>(F.lds + RING_OFF, DM, S, E); }
               if (F.vcu < NB * GROWS) p3_bias_fill(F, F.vcu % GROWS); })
    PHASE(3, p3_mixers(F, lo <= 2))
    PHASE(4, { OutProjOrder S{F.vcu, F.G, (const char*)F_MIX, (const char*)F_WOUT};
               EpiOutProj E{F_x, F_MOD, F_X1};
               unsigned* c3 = (unsigned*)WSP(unsigned, WS_CTL) + CW_ARR3; unsigned* c4 = (unsigned*)WSP(unsigned, WS_CTL) + CW_ARR4; unsigned* tmo = (unsigned*)WSP(unsigned, WS_CTL) + CW_TMO;
               pg8::Unit u0; const bool one = (F.G == 256) && S.next(0, u0);
               if (one) wait_counter(c3 + CW_ARRS * u0.pm, 4u, tmo); else wait_counter(c3 - CW_ARRS, (unsigned)(NB * GROWS), tmo);
               pg8::gemm_phase<EpiOutProj, OutProjOrder>(F.lds + RING_OFF, 2 * DM, S, E);
               if (one) arrive_counter2(c4 + CW_ARRS * u0.pm, c4 - CW_ARRS); else { pg8::Unit uu; for (int i = 0; S.next(i, uu); ++i) arrive_counter2(c4 + CW_ARRS * uu.pm, c4 - CW_ARRS); } })
    PHASE(5, p5_router(F))
    PHASE(6, { p6_topk(F); moe_weights<true>(F, (unsigned*)(ctl + CW_WQ), -1); })
    PHASE(7, { GateUpOrder S{F.vcu, F.G, (const char*)F_H2, (const char*)F_WGU, F_TOK};
               EpiSwiGLU E{(unsigned char*)F_HID};
               DownSide SD{F_w_down, (unsigned char*)F_WD, F.vcu * NWAVES + F.wave, F.G * NWAVES, F.lane};
               pg8::gemm_phase<EpiSwiGLU, GateUpOrder, true, true, true, true, DownSide>(F.lds + RING_OFF, DM, S, E, SD);
               { pg8::Unit uu; int nu = 0; while (S.next(nu, uu)) ++nu;
                 for (int ui = nu; ui * SD.NGW + SD.gw < DOWN_ITEMS; ++ui) { f32x4 v[8]; SD.issue(ui, v); SD.finish(ui, v); } } })
    PHASE(8, { DownOrder S{F.vcu, F.G, (const char*)F_HID, (const char*)F_WD};
               EpiDown E{(unsigned char*)F_YS, F_WTS};
               pg8::gemm_phase<EpiDown, DownOrder, false, true>(F.lds + RING_OFF, DEXP, S, E); })
    PHASE(9, p9_final(F))
    if (PROBE_SPAN == 99) span_dt = __builtin_amdgcn_s_memrealtime() - span_t0;
    if (PROBE_SEC > 0) span_dt = F.pacc;
    if ((PROBE_SPAN >= 0 || PROBE_SEC > 0) && blockIdx.x == 0) { const unsigned long long t0 = __builtin_amdgcn_s_memrealtime(); while (__builtin_amdgcn_s_memrealtime() - t0 < span_dt) __builtin_amdgcn_s_sleep(8); }
#undef IN
#undef SEAM
}

extern "C" void kernel_launch(void* const* d_in, const int* in_sizes, int n_in, void* d_out, int out_size, void* d_ws, size_t ws_size, hipStream_t stream) {
    static int grid = 0;
    if (grid == 0) {
        if (n_in != 20 || out_size != MTOK * DM || ws_size < WS_END) { fprintf(stderr, "kernel_launch: unexpected shapes (n_in %d out %d ws %zu)\n", n_in, out_size, ws_size); grid = -1; return; }
        int dev = 0, cus = 0, per_cu = 0;
        if (hipGetDevice(&dev) != hipSuccess || hipDeviceGetAttribute(&cus, hipDeviceAttributeMultiprocessorCount, dev) != hipSuccess) { grid = -1; return; }
        if (hipFuncSetAttribute((const void*)mk_fwd, hipFuncAttributeMaxDynamicSharedMemorySize, LDS_BYTES) != hipSuccess) { fprintf(stderr, "kernel_launch: hipFuncSetAttribute failed\n"); grid = -1; return; }
        if (hipOccupancyMaxActiveBlocksPerMultiprocessor(&per_cu, (const void*)mk_fwd, NWAVES * 64, LDS_BYTES) != hipSuccess || per_cu < 1) { fprintf(stderr, "kernel_launch: occupancy query says %d\n", per_cu); per_cu = 1; }
        (void)hipGetLastError();
        grid = cus;
    }
    if (grid < 0) return;
    (void)hipMemsetAsync((char*)d_ws + WS_CTL, 0, CTL_ZERO_BYTES, stream);
    Args a{};
    for (int i = 0; i < 20; ++i) a.in[i] = (const float*)d_in[i];
    a.out = (float*)d_out; a.ws = (unsigned char*)d_ws;
#if MK_ONE_LAUNCH
    a.ph_lo = 0; a.ph_hi = N_PHASES + 1;
    hipLaunchKernelGGL(mk_fwd, dim3(grid), dim3(NWAVES * 64), LDS_BYTES, stream, a);
#else
    for (int p = 1; p <= N_PHASES; ++p) { a.ph_lo = (p == 1) ? 0 : p; a.ph_hi = p + 1; hipLaunchKernelGGL(mk_fwd, dim3(grid), dim3(NWAVES * 64), LDS_BYTES, stream, a); }
#endif
}
```

```cpp
#include <hip/hip_runtime.h>
#include <cstdio>
#include <cstdint>

#ifndef MK_ONE_LAUNCH
#define MK_ONE_LAUNCH 1
#endif

namespace pg8 {
#define PG8_LAS __attribute__((address_space(3)))
typedef unsigned short bf16_t;
typedef short bf16x8 __attribute__((ext_vector_type(8)));
typedef float f32x4 __attribute__((ext_vector_type(4)));
typedef unsigned u32x4 __attribute__((ext_vector_type(4)));
constexpr int BM = 256, BK = 64, HALF = 128, HTB = HALF * BK * 2, STAGE_BYTES = 8 * HTB;
constexpr int WSCALE_WORD = 0x7a7a7a7a;
constexpr int GIDX_OFF = 147456;

__host__ __device__ __forceinline__ int lds_byte(int r, int c) { const int st = (r >> 4) * 2 + (c >> 5), rr = r & 15, cc = c & 31, ob = rr * 64 + cc * 2; return st * 1024 + (ob ^ (((ob >> 9) & 1) << 5)); }
__host__ __device__ __forceinline__ void stage_rc(int b, int& R, int& C) { const int st = b / 1024, sb = b % 1024, swz = sb ^ (((sb >> 9) & 1) << 5); R = (st >> 1) * 16 + swz / 64; C = (st & 1) * 32 + (swz % 64) / 2; }
__host__ __device__ __forceinline__ int perm32(int rho) { const int n = rho >> 4, i = rho & 15; return 8 * (i >> 2) + 4 * n + (i & 3); }

struct Unit { int pm, pn, kind; const char* A; const char* B; };

__device__ __forceinline__ unsigned cvt_pk_bf16(float lo, float hi) { unsigned r; asm volatile("v_cvt_pk_bf16_f32 %0, %1, %2" : "=v"(r) : "v"(lo), "v"(hi)); return r; }

typedef int v8i __attribute__((ext_vector_type(8)));
typedef int v4i __attribute__((ext_vector_type(4)));
struct NoSide { static constexpr bool ON = false; __device__ __forceinline__ bool has(int) const { return false; } __device__ __forceinline__ const void* src(int) const { return nullptr; } __device__ __forceinline__ unsigned row_stride_bytes() const { return 0u; } __device__ __forceinline__ void finish(int, const f32x4 (&)[8]) const {} };
template <class Epi, class Sched, bool GATHER = false, bool FP8 = false, bool ALIGN_EPI = true, bool SP2 = true, class Side = NoSide>
__device__ __forceinline__ void gemm_phase(PG8_LAS unsigned char* lds, const int KB, const Sched& S, const Epi& E, const Side& SD = Side()) {
    const int tid = threadIdx.x, wid = __builtin_amdgcn_readfirstlane(tid >> 6), lane = tid & 63, wr = wid >> 2, wc = wid & 3, fr = lane & 15, fq = lane >> 4;
    const int nt = KB / 128;
    unsigned voffA[2], voffB[2];
#pragma unroll
    for (int i = 0; i < 2; ++i) { int R, C; stage_rc(tid * 16 + i * 8192, R, C); const int Rb = Epi::PERM ? ((R & ~31) + perm32(R & 31)) : R;
        voffA[i] = (unsigned)(R * KB + C * 2); voffB[i] = (unsigned)(Rb * KB + C * 2); }
    const size_t kstep = (size_t)(BK * 2);
    const size_t hstep = (size_t)HALF * KB;
    const unsigned ldsw = (unsigned)wid * 1024u;
    const int aoff = lds_byte(wr * 64 + fr, fq * 8), boff = lds_byte(wc * 32 + fr, fq * 8);
#define PG8_SA(b, h) (((b) * 2 + (h)) * HTB)
#define PG8_SB(b, h) ((4 + (b) * 2 + (h)) * HTB)
#define PG8_STAGE(bufoff, gbase, voff) do { _Pragma("unroll") for (int _i = 0; _i < 2; ++_i) \
        __builtin_amdgcn_global_load_lds((const unsigned*)((const char*)(gbase) + (voff)[_i]), (PG8_LAS unsigned*)(lds + (bufoff) + ldsw + _i * 8192), 16, 0, 0); } while (0)
#define PG8_STAGE_A(bufoff, kptr, h, goff) do { _Pragma("unroll") for (int _i = 0; _i < 2; ++_i) \
        __builtin_amdgcn_global_load_lds((const unsigned*)((const char*)(kptr) + (GATHER ? (goff)[h][_i] : (voffA[_i] + (unsigned)((h) * hstep)))), (PG8_LAS unsigned*)(lds + (bufoff) + ldsw + _i * 8192), 16, 0, 0); } while (0)
#define PG8_LD16(p) (*(const PG8_LAS v4i*)(p))
#define PG8_LDA(dst, b, h) do { if constexpr (FP8) { _Pragma("unroll") for (int m = 0; m < 4; ++m) { const v4i lo_ = PG8_LD16(lds + PG8_SA(b, h) + aoff + m * 2048), hi_ = PG8_LD16(lds + PG8_SA(b, h) + aoff + m * 2048 + 1024); \
            dst##8[m] = __builtin_shufflevector(lo_, hi_, 0, 1, 2, 3, 4, 5, 6, 7); } } \
        else { _Pragma("unroll") for (int m = 0; m < 4; ++m) _Pragma("unroll") for (int k = 0; k < 2; ++k) dst[m][k] = *(const PG8_LAS bf16x8*)(lds + PG8_SA(b, h) + aoff + m * 2048 + k * 1024); } } while (0)
#define PG8_LDB(dst, b, h) do { if constexpr (FP8) { _Pragma("unroll") for (int n = 0; n < 2; ++n) { const v4i lo_ = PG8_LD16(lds + PG8_SB(b, h) + boff + n * 2048), hi_ = PG8_LD16(lds + PG8_SB(b, h) + boff + n * 2048 + 1024); \
            dst##8[n] = __builtin_shufflevector(lo_, hi_, 0, 1, 2, 3, 4, 5, 6, 7); } } \
        else { _Pragma("unroll") for (int n = 0; n < 2; ++n) _Pragma("unroll") for (int k = 0; k < 2; ++k) dst[n][k] = *(const PG8_LAS bf16x8*)(lds + PG8_SB(b, h) + boff + n * 2048 + k * 1024); } } while (0)
#define PG8_MMA(ai, bj, At, Bt) do { __builtin_amdgcn_s_setprio(1); _Pragma("unroll") for (int m = 0; m < 4; ++m) _Pragma("unroll") for (int n = 0; n < 2; ++n) { \
        if constexpr (FP8) { asm volatile("v_mfma_scale_f32_16x16x128_f8f6f4 %0, %1, %2, %0, %3, %4 op_sel_hi:[0,0,0]" : "+v"(acc[ai][bj][m][n]) : "v"(Bt##8[n]), "v"(At##8[m]), "v"(wsc_), "v"(one_)); } \
        else { _Pragma("unroll") for (int k = 0; k < 2; ++k) acc[ai][bj][m][n] = __builtin_amdgcn_mfma_f32_16x16x32_bf16(Bt[n][k], At[m][k], acc[ai][bj][m][n], 0, 0, 0); } } \
        __builtin_amdgcn_s_setprio(0); } while (0)
#define PG8_WAIT_V(n) asm volatile("s_waitcnt vmcnt(" #n ")" ::: "memory")
#define PG8_WAIT_L(n) asm volatile("s_waitcnt lgkmcnt(" #n ")" ::: "memory")
#define PG8_BAR __builtin_amdgcn_s_barrier()
#define PG8_SCHED __builtin_amdgcn_sched_barrier(0)
    Unit cur, nxt; int ui = 0;
    if (!S.next(0, cur)) return;
    f32x4 acc[2][2][4][2];
#pragma unroll
    for (int a = 0; a < 2; ++a)
#pragma unroll
        for (int b = 0; b < 2; ++b)
#pragma unroll
            for (int m = 0; m < 4; ++m)
#pragma unroll
                for (int n = 0; n < 2; ++n) acc[a][b][m][n] = (f32x4){0.f, 0.f, 0.f, 0.f};
    bf16x8 At[4][2], B0[2][2], B1[2][2];
    v8i At8[4], B08[2], B18[2];
    int wsc_ = WSCALE_WORD, one_ = 0x7f7f7f7f; asm volatile("" : "+v"(wsc_), "+v"(one_));
    const char* cA = cur.A; const char* cB = cur.B;
    unsigned goffC[2][2] = {{0u, 0u}, {0u, 0u}};
    if constexpr (GATHER) {
#pragma unroll
        for (int h = 0; h < 2; ++h)
#pragma unroll
            for (int i = 0; i < 2; ++i) { int R_, C_; stage_rc(tid * 16 + i * 8192, R_, C_); goffC[h][i] = (unsigned)((S.row_base(cur) + S.rows(cur)[h * HALF + R_]) * KB + C_ * 2); }
    }
    if constexpr (SP2) {
        PG8_STAGE(PG8_SB(0, 0), cB, voffB); PG8_STAGE(PG8_SB(0, 1), cB + hstep, voffB); PG8_STAGE_A(PG8_SA(0, 0), cA, 0, goffC); PG8_STAGE_A(PG8_SA(0, 1), cA, 1, goffC);
        if (wr == 1) PG8_BAR;
        PG8_WAIT_V(2); PG8_BAR;
        PG8_STAGE(PG8_SB(1, 0), cB + kstep, voffB); PG8_STAGE_A(PG8_SA(1, 0), cA + kstep, 0, goffC); PG8_STAGE(PG8_SB(1, 1), cB + hstep + kstep, voffB);
        PG8_WAIT_V(6); PG8_BAR;
    } else {
        PG8_STAGE(PG8_SB(0, 0), cB, voffB); PG8_STAGE_A(PG8_SA(0, 0), cA, 0, goffC); PG8_STAGE(PG8_SB(0, 1), cB + hstep, voffB); PG8_STAGE_A(PG8_SA(0, 1), cA, 1, goffC);
        if (wr == 1) PG8_BAR;
        PG8_WAIT_V(4); PG8_BAR;
        PG8_STAGE(PG8_SB(1, 0), cB + kstep, voffB); PG8_STAGE_A(PG8_SA(1, 0), cA + kstep, 0, goffC); PG8_STAGE(PG8_SB(1, 1), cB + hstep + kstep, voffB);
        PG8_WAIT_V(6); PG8_BAR;
    }
    for (;;) {
        const bool has_next = S.next(ui + 1, nxt);
        const char* nA = has_next ? nxt.A : cA; const char* nB = has_next ? nxt.B : cB;
        if constexpr (GATHER) {
            if (has_next && wid < 4) __builtin_amdgcn_global_load_lds((const unsigned*)(S.rows(nxt) + tid), (PG8_LAS unsigned*)(lds + GIDX_OFF + ((ui + 1) & 1) * 1024 + wid * 256), 4, 0, 0);
        }
#pragma unroll 1
        for (int t = 0; t < nt; t += 2) {
            const bool last = (t == nt - 2);
            const char* a1 = cA + (size_t)(t + 1) * kstep;
            const char* a2 = last ? nA : cA + (size_t)(t + 2) * kstep; const char* b2 = last ? nB : cB + (size_t)(t + 2) * kstep;
            const char* a3 = a2 + kstep; const char* b3 = b2 + kstep;
            if constexpr (SP2) {
            PG8_LDB(B0, 0, 0); PG8_LDB(B1, 0, 1); PG8_SCHED; PG8_LDA(At, 0, 0); PG8_STAGE_A(PG8_SA(1, 1), a1, 1, goffC);
            if constexpr (GATHER) { if (last && has_next) { const PG8_LAS int* mb = (const PG8_LAS int*)(lds + GIDX_OFF + ((ui + 1) & 1) * 1024); const int rb = S.row_base(nxt);
                _Pragma("unroll") for (int h = 0; h < 2; ++h) _Pragma("unroll") for (int i = 0; i < 2; ++i) { int R_, C_; stage_rc(tid * 16 + i * 8192, R_, C_); goffC[h][i] = (unsigned)((rb + mb[h * HALF + R_]) * KB + C_ * 2); } } }
            PG8_WAIT_V(8); PG8_WAIT_L(0); PG8_BAR; PG8_MMA(0, 0, At, B0); PG8_MMA(0, 1, At, B1); PG8_BAR; PG8_SCHED;
            PG8_LDA(At, 0, 1); PG8_STAGE(PG8_SB(0, 0), b2, voffB); PG8_STAGE(PG8_SB(0, 1), b2 + hstep, voffB); PG8_STAGE_A(PG8_SA(0, 0), a2, 0, goffC);
            PG8_WAIT_V(8); PG8_WAIT_L(0); PG8_BAR; PG8_MMA(1, 0, At, B0); PG8_MMA(1, 1, At, B1); PG8_BAR; PG8_SCHED;
            PG8_LDB(B0, 1, 0); PG8_LDB(B1, 1, 1); PG8_SCHED; PG8_LDA(At, 1, 0); PG8_STAGE_A(PG8_SA(0, 1), a2, 1, goffC);
            PG8_WAIT_V(8); PG8_WAIT_L(0); PG8_BAR; PG8_MMA(0, 0, At, B0); PG8_MMA(0, 1, At, B1); PG8_BAR; PG8_SCHED;
            PG8_LDA(At, 1, 1); PG8_STAGE(PG8_SB(1, 0), b3, voffB); PG8_STAGE(PG8_SB(1, 1), b3 + hstep, voffB); PG8_STAGE_A(PG8_SA(1, 0), a3, 0, goffC);
            PG8_WAIT_V(8); PG8_WAIT_L(0); PG8_BAR; PG8_MMA(1, 0, At, B0); PG8_MMA(1, 1, At, B1); PG8_BAR; PG8_SCHED;
            } else {
            PG8_LDB(B0, 0, 0); PG8_SCHED; PG8_LDA(At, 0, 0); PG8_STAGE_A(PG8_SA(1, 1), a1, 1, goffC);
            if constexpr (GATHER) { if (last && has_next) { const PG8_LAS int* mb = (const PG8_LAS int*)(lds + GIDX_OFF + ((ui + 1) & 1) * 1024); const int rb = S.row_base(nxt);
                _Pragma("unroll") for (int h = 0; h < 2; ++h) _Pragma("unroll") for (int i = 0; i < 2; ++i) { int R_, C_; stage_rc(tid * 16 + i * 8192, R_, C_); goffC[h][i] = (unsigned)((rb + mb[h * HALF + R_]) * KB + C_ * 2); } } }
            PG8_WAIT_L(8); PG8_BAR; PG8_WAIT_L(0); PG8_MMA(0, 0, At, B0); PG8_BAR; PG8_SCHED;
            PG8_LDB(B1, 0, 1); PG8_STAGE(PG8_SB(0, 0), b2, voffB);
            PG8_BAR; PG8_WAIT_L(0); PG8_MMA(0, 1, At, B1); PG8_BAR;
            PG8_LDA(At, 0, 1); PG8_STAGE_A(PG8_SA(0, 0), a2, 0, goffC);
            PG8_BAR; PG8_WAIT_L(0); PG8_MMA(1, 0, At, B0); PG8_BAR; PG8_SCHED;
            PG8_STAGE(PG8_SB(0, 1), b2 + hstep, voffB);
            PG8_WAIT_V(6); PG8_BAR; PG8_MMA(1, 1, At, B1); PG8_BAR;
            PG8_LDB(B0, 1, 0); PG8_SCHED; PG8_LDA(At, 1, 0); PG8_STAGE_A(PG8_SA(0, 1), a2, 1, goffC);
            PG8_WAIT_L(8); PG8_BAR; PG8_WAIT_L(0); PG8_MMA(0, 0, At, B0); PG8_BAR; PG8_SCHED;
            PG8_LDB(B1, 1, 1); PG8_STAGE(PG8_SB(1, 0), b3, voffB);
            PG8_BAR; PG8_WAIT_L(0); PG8_MMA(0, 1, At, B1); PG8_BAR;
            PG8_LDA(At, 1, 1); PG8_STAGE_A(PG8_SA(1, 0), a3, 0, goffC);
            PG8_BAR; PG8_WAIT_L(0); PG8_MMA(1, 0, At, B0); PG8_BAR; PG8_SCHED;
            PG8_STAGE(PG8_SB(1, 1), b3 + hstep, voffB);
            PG8_WAIT_V(6); PG8_BAR; PG8_MMA(1, 1, At, B1); PG8_BAR;
            }
        }
        if constexpr (ALIGN_EPI) { if (wr == 0) PG8_BAR; }
        if constexpr (FP8) {
#pragma unroll
            for (int b_ = 0; b_ < 2; ++b_) asm volatile("s_nop 15\n\ts_nop 15" : "+v"(acc[1][b_][0][0]), "+v"(acc[1][b_][0][1]), "+v"(acc[1][b_][1][0]), "+v"(acc[1][b_][1][1]), "+v"(acc[1][b_][2][0]), "+v"(acc[1][b_][2][1]), "+v"(acc[1][b_][3][0]), "+v"(acc[1][b_][3][1]));
        }
        if constexpr (Side::ON) {
            const bool son = SD.has(ui); const char* sp = son ? (const char*)SD.src(ui) : nullptr; const unsigned sst = SD.row_stride_bytes();
            f32x4 sv_[8];
            if (son) {
#define PG8_SLD(R, r) asm volatile("global_load_dwordx4 %0, %1, off nt" : "=v"(R) : "v"(sp + (size_t)(r) * sst) : "memory")
                PG8_SLD(sv_[0], 0); PG8_SLD(sv_[1], 1); PG8_SLD(sv_[2], 2); PG8_SLD(sv_[3], 3);
            }
            __builtin_amdgcn_sched_barrier(0);
            E.half(acc, cur, wr, wc, fr, fq, 0); asm volatile("" ::: "memory"); __builtin_amdgcn_sched_barrier(0);
            if (son) { PG8_SLD(acc[0][0][0][0], 4); PG8_SLD(acc[0][0][0][1], 5); PG8_SLD(acc[0][0][1][0], 6); PG8_SLD(acc[0][0][1][1], 7); }
#undef PG8_SLD
            __builtin_amdgcn_sched_barrier(0);
            E.half(acc, cur, wr, wc, fr, fq, 1);
            if (son) {
                asm volatile("s_waitcnt vmcnt(0)" : "+v"(sv_[0]), "+v"(sv_[1]), "+v"(sv_[2]), "+v"(sv_[3]), "+v"(acc[0][0][0][0]), "+v"(acc[0][0][0][1]), "+v"(acc[0][0][1][0]), "+v"(acc[0][0][1][1]) :: "memory");
                sv_[4] = acc[0][0][0][0]; sv_[5] = acc[0][0][0][1]; sv_[6] = acc[0][0][1][0]; sv_[7] = acc[0][0][1][1];
                SD.finish(ui, sv_);
            }
        }
        else E(acc, cur, wr, wc, fr, fq);
        if (!has_next) break;
#pragma unroll
        for (int a = 0; a < 2; ++a)
#pragma unroll
            for (int b = 0; b < 2; ++b)
#pragma unroll
                for (int m = 0; m < 4; ++m)
#pragma unroll
                    for (int n = 0; n < 2; ++n) acc[a][b][m][n] = (f32x4){0.f, 0.f, 0.f, 0.f};
        cur = nxt; cA = nA; cB = nB; ++ui;
        if constexpr (ALIGN_EPI) { if (wr == 1) PG8_BAR; }
    }
    PG8_WAIT_V(0);
    if constexpr (!ALIGN_EPI) { if (wr == 0) PG8_BAR; }
    PG8_BAR;
#undef PG8_SA
#undef PG8_SB
#undef PG8_STAGE
#undef PG8_STAGE_A
#undef PG8_LDA
#undef PG8_LDB
#undef PG8_MMA
#undef PG8_LD16
#undef PG8_WAIT_V
#undef PG8_WAIT_L
#undef PG8_BAR
#undef PG8_SCHED
}
}

constexpr int NWAVES = 8;
constexpr int DM = 1024, NB = 2, SEQ = 8192, MTOK = NB * SEQ;
constexpr int CTXL = 256, MCTX = NB * CTXL, MALL = MTOK + MCTX;
constexpr int NMODV = 6 * DM;
constexpr int CONVC = 512, CONVW = 31, NHEADS = 8, HD = 64, ATTW = 512;
constexpr int NINC = 2560;
constexpr int NEXP = 16, DEXP = 2048, CAP = 1024, MX = NB * NEXP * CAP;
constexpr int GROWS = SEQ / 64;
constexpr int KTILES = SEQ / 32 + CTXL / 32;
constexpr float EPS = 1e-6f;
constexpr float LOG2E = 1.4426950408889634f;

constexpr size_t MiB = 1u << 20;
constexpr size_t WS_CTL = 0, CTL_ZERO_BYTES = 32 * 1024;
constexpr size_t WS_MOD = 1 * MiB;
constexpr size_t WS_AFF = 2 * MiB;
constexpr size_t WS_INV = 3 * MiB;
constexpr size_t WS_TOK = 4 * MiB;
constexpr size_t WS_WT = 4 * MiB + 128 * 1024;
constexpr size_t WS_WIN = 5 * MiB;
constexpr size_t WS_WOUT = 10 * MiB;
constexpr size_t WS_WGU = 12 * MiB;
constexpr size_t WS_WD = 140 * MiB;
constexpr size_t WS_X1 = 204 * MiB;
constexpr size_t WS_YS = 268 * MiB;
constexpr size_t WS_H = 332 * MiB;
constexpr size_t WS_H8 = 240 * MiB;
constexpr size_t WS_WQKV8 = 7 * MiB;
constexpr size_t WS_U = 365 * MiB;
constexpr size_t WS_Q = 381 * MiB;
constexpr size_t WS_K = 397 * MiB;
constexpr size_t WS_VT = WS_K + 16 * MiB + 512 * 1024;
constexpr size_t WS_MIX = 430 * MiB;
constexpr size_t WS_HID = 332 * MiB;
constexpr size_t WS_H2 = 462 * MiB;
constexpr size_t WS_END = 494 * MiB;
static_assert(WS_VT + (size_t)512 * MALL * 2 <= WS_MIX && WS_HID + (size_t)MX * DEXP * 2 <= WS_H2, "ws map");

constexpr int CW_TMO = 0, CW_CODE = 1;
constexpr int CW_BAR = 4096;
constexpr int CW_WQ = 2048;
constexpr int CW_ARR3 = 2304, CW_ARR4 = 3072, CW_ARRS = 8;
constexpr int CW_P5Q = 2184;
constexpr int CW_ARR0 = 2112, CW_ARR5 = 2176;

constexpr int RING_OFF = 0, RING_BYTES = 131072;
constexpr int LDSCTL_OFF = RING_BYTES, MISC_OFF = LDSCTL_OFF + 320;
constexpr int LDS_BYTES = 163840;
static_assert(MISC_OFF + 128 + 8 * 15 * 32 * 4 <= LDS_BYTES, "LDS map");

#define GAS __attribute__((address_space(1)))
#define LAS __attribute__((address_space(3)))
typedef unsigned short bf16;
typedef unsigned v4u __attribute__((ext_vector_type(4)));
typedef unsigned v2u __attribute__((ext_vector_type(2)));
typedef float f32x4 __attribute__((ext_vector_type(4)));
typedef float f32x16 __attribute__((ext_vector_type(16)));
typedef float f32x2 __attribute__((ext_vector_type(2)));
typedef short bf16x8 __attribute__((ext_vector_type(8)));
typedef GAS unsigned gu32;
#define RLX_AGENT __ATOMIC_RELAXED, __HIP_MEMORY_SCOPE_AGENT
#define LDS_WAIT() asm volatile("s_waitcnt lgkmcnt(0)" ::: "memory")
#define VM_WAIT() asm volatile("s_waitcnt vmcnt(0)" ::: "memory")
__device__ __forceinline__ unsigned f2bf(float f) { unsigned u = __builtin_bit_cast(unsigned, f); return (u + 0x7fffu + ((u >> 16) & 1u)) >> 16; }
__device__ __forceinline__ unsigned pk2(float lo, float hi) { return f2bf(lo) | (f2bf(hi) << 16); }
__device__ __forceinline__ float bf_lo(unsigned w) { return __builtin_bit_cast(float, w << 16); }
__device__ __forceinline__ float bf_hi(unsigned w) { return __builtin_bit_cast(float, w & 0xffff0000u); }
__device__ __forceinline__ unsigned pk4_fp8(float a, float b, float c, float d) { int w = 0; w = __builtin_amdgcn_cvt_pk_fp8_f32(a, b, w, false); w = __builtin_amdgcn_cvt_pk_fp8_f32(c, d, w, true); return (unsigned)w; }
__device__ __forceinline__ float clamp448(float x) { return __builtin_fminf(__builtin_fmaxf(x, -448.f), 448.f); }
__device__ __forceinline__ float fast_sigmoid(float x) { return __builtin_amdgcn_rcpf(1.0f + __builtin_amdgcn_exp2f(-x * LOG2E)); }

#define XB_TMO      128
#define XB_XCNT(j)  (256  + 64 * (j))
#define XB_XSUB(j)  (1280 + 64 * (j))
#define XB_XGEN(j)  (2304 + 64 * (j))
#define XB_TOP      3328
#define XB_TOPGEN   3392
#define XCD_BAR_WORDS 3456
#define XB_SPIN_CAP (1u << 18)
__device__ __forceinline__ unsigned xb_ld(unsigned* p)              { return __hip_atomic_load(p, __ATOMIC_RELAXED, __HIP_MEMORY_SCOPE_AGENT); }
__device__ __forceinline__ unsigned xb_add(unsigned* p, unsigned v) { return __hip_atomic_fetch_add(p, v, __ATOMIC_RELAXED, __HIP_MEMORY_SCOPE_AGENT); }
__device__ __forceinline__ unsigned xb_xcc_id() { return (unsigned)__builtin_amdgcn_s_getreg((3 << 11) | 20) & 0xFu; }
#define XB_SPIN(cond, bar) do { unsigned _sp = 0; while (cond) { __builtin_amdgcn_s_sleep(1); \
    if ((++_sp & 255u) == 0u) { if (xb_ld(&(bar)[XB_TMO])) break; if (_sp > XB_SPIN_CAP) { atomicAdd(&(bar)[XB_TMO], 1u); break; } } } } while (0)
struct XcdBarrier { unsigned* bar; unsigned x; volatile LAS unsigned* st; };
__device__ __forceinline__ XcdBarrier xcd_barrier_post(unsigned* bar, volatile LAS unsigned* st) {
    XcdBarrier b; b.bar = bar; b.x = xb_xcc_id(); b.st = st;
    if (threadIdx.x == 0) (void)xb_add(&bar[XB_XCNT(b.x)], 1u);
    return b;
}
__device__ __forceinline__ void xcd_barrier_complete(unsigned* bar, unsigned x, unsigned& nloc, unsigned& nx) {
    const unsigned G = gridDim.x * gridDim.y * gridDim.z;
    unsigned sum, cnt, mine, sp = 0u;
    for (;;) {
        sum = 0u; cnt = 0u; mine = 0u;
#pragma unroll
        for (unsigned j = 0; j < 16; ++j) { const unsigned c = xb_ld(&bar[XB_XCNT(j)]); sum += c; cnt += (c > 0u) ? 1u : 0u; mine = (j == x) ? c : mine; }
        if (sum == G) break;
        __builtin_amdgcn_s_sleep(1);
        if ((++sp & 255u) == 0u) { if (xb_ld(&bar[XB_TMO])) break; if (sp > XB_SPIN_CAP) { atomicAdd(&bar[XB_TMO], 1u); break; } }
    }
    nloc = mine > 0u ? mine : 1u; nx = cnt > 0u ? cnt : 1u;
}
__device__ __forceinline__ void xcd_barrier(const XcdBarrier& b) {
    asm volatile("s_waitcnt vmcnt(0)" ::: "memory");
    __syncthreads();
    if (threadIdx.x == 0) {
        unsigned* bar = b.bar;
        __builtin_amdgcn_s_waitcnt(0);
        unsigned nloc = b.st[0], nx = b.st[1];
        if (nloc == 0u) { xcd_barrier_complete(bar, b.x, nloc, nx); b.st[0] = nloc; b.st[1] = nx; }
        const unsigned old = xb_add(&bar[XB_XSUB(b.x)], 1u);
        const unsigned gen = old / nloc;
        if (old + 1u == (gen + 1u) * nloc) {
            __builtin_amdgcn_fence(__ATOMIC_RELEASE, "agent");
            asm volatile("s_waitcnt vmcnt(0)" ::: "memory");
            const unsigned og = xb_add(&bar[XB_TOP], 1u);
            const unsigned tg = og / nx;
            if (og + 1u == (tg + 1u) * nx) xb_add(&bar[XB_TOPGEN], 1u);
            else XB_SPIN(xb_ld(&bar[XB_TOPGEN]) == tg, bar);
            __builtin_amdgcn_fence(__ATOMIC_ACQUIRE, "agent");
            xb_add(&bar[XB_XGEN(b.x)], 1u);
            asm volatile("s_waitcnt vmcnt(0)" ::: "memory");
        } else {
            XB_SPIN(xb_ld(&bar[XB_XGEN(b.x)]) == gen, bar);
            __builtin_amdgcn_fence(__ATOMIC_ACQUIRE, "agent");
            asm volatile("s_waitcnt vmcnt(0)" ::: "memory");
        }
    }
    __syncthreads();
}

__device__ __forceinline__ void st_wt(float* p, float v) { __hip_atomic_store(p, v, __ATOMIC_RELAXED, __HIP_MEMORY_SCOPE_AGENT); }
__device__ __forceinline__ void st_wt16(void* p, v4u v) { asm volatile("global_store_dwordx4 %0, %1, off sc1\n\ts_nop 1" :: "v"(p), "v"(v) : "memory"); }
__device__ __forceinline__ void st_wt8(void* p, v2u v) { __hip_atomic_store((unsigned long long*)p, ((unsigned long long)v.y << 32) | v.x, __ATOMIC_RELAXED, __HIP_MEMORY_SCOPE_AGENT); }
__device__ __forceinline__ void arrive_counter(unsigned* cnt) {
    asm volatile("s_waitcnt vmcnt(0)" ::: "memory"); __syncthreads();
    if (threadIdx.x == 0) __hip_atomic_fetch_add(cnt, 1u, __ATOMIC_RELAXED, __HIP_MEMORY_SCOPE_AGENT);
}
__device__ __forceinline__ void arrive_counter2(unsigned* cnt, unsigned* total) {
    asm volatile("s_waitcnt vmcnt(0)" ::: "memory"); __syncthreads();
    if (threadIdx.x == 0) { __hip_atomic_fetch_add(cnt, 1u, __ATOMIC_RELAXED, __HIP_MEMORY_SCOPE_AGENT); __hip_atomic_fetch_add(total, 1u, __ATOMIC_RELAXED, __HIP_MEMORY_SCOPE_AGENT); }
}
__device__ __forceinline__ void wait_counter(unsigned* cnt, unsigned need, unsigned* tmo) {
    if (threadIdx.x == 0) {
        unsigned sp = 0u;
        while (__hip_atomic_load(cnt, __ATOMIC_RELAXED, __HIP_MEMORY_SCOPE_AGENT) < need) { __builtin_amdgcn_s_sleep(2); if (++sp > (1u << 20)) { __hip_atomic_store(tmo, 1u, __ATOMIC_RELAXED, __HIP_MEMORY_SCOPE_AGENT); break; } }
        __builtin_amdgcn_fence(__ATOMIC_ACQUIRE, "agent");
        asm volatile("s_waitcnt vmcnt(0)" ::: "memory");
    }
    __syncthreads();
}

struct Args { const float* in[20]; float* out; unsigned char* ws; int ph_lo, ph_hi; };
struct Frame {
    LAS unsigned char* lds;
    volatile LAS unsigned* MISC;
    int tid, lane, wave;
    int vcu, G;
    const Args* a;
    unsigned long long pacc;
};
#ifndef PROBE_SEC
#define PROBE_SEC 0
#endif
#ifndef PROBE_AMP
#define PROBE_AMP 1
#endif
#define SEC_BEGIN(id) unsigned long long sec_t0_##id = 0ull; if (PROBE_SEC == (id)) { __builtin_amdgcn_s_barrier(); sec_t0_##id = __builtin_amdgcn_s_memrealtime(); }
#define SEC_END(id) if (PROBE_SEC == (id)) { __builtin_amdgcn_s_barrier(); F.pacc += __builtin_amdgcn_s_memrealtime() - sec_t0_##id; }
#define FIN(name, idx) (F.a->in[idx])
#define F_x FIN(x, 0)
#define F_c FIN(c, 1)
#define F_ctx FIN(ctx, 2)
#define F_c_ctx FIN(c_ctx, 3)
#define F_w_mod FIN(w_mod, 4)
#define F_b_mod FIN(b_mod, 5)
#define F_norm_mix_g FIN(norm_mix_g, 6)
#define F_w_in FIN(w_in, 7)
#define F_conv_w FIN(conv_w, 8)
#define F_conv_b FIN(conv_b, 9)
#define F_conv_ln_g FIN(conv_ln_g, 10)
#define F_conv_ln_b FIN(conv_ln_b, 11)
#define F_rpb FIN(rpb, 12)
#define F_w_out FIN(w_out, 13)
#define F_norm_ffn_g FIN(norm_ffn_g, 14)
#define F_w_router FIN(w_router, 15)
#define F_w_gate FIN(w_gate, 16)
#define F_w_up FIN(w_up, 17)
#define F_w_down FIN(w_down, 18)
#define F_norm_final_g FIN(norm_final_g, 19)
#define F_out (F.a->out)
#define WSP(T, off) ((T*)(F.a->ws + (off)))
#define F_MOD WSP(float, WS_MOD)
#define F_AFF WSP(float, WS_AFF)
#define F_INV WSP(int, WS_INV)
#define F_TOK WSP(int, WS_TOK)
#define F_WTS WSP(float, WS_WT)
#define F_X1 WSP(bf16, WS_X1)
#define F_WIN WSP(bf16, WS_WIN)
#define F_WOUT WSP(bf16, WS_WOUT)
#define F_WGU WSP(bf16, WS_WGU)
#define F_WD WSP(bf16, WS_WD)
#define F_YS WSP(bf16, WS_YS)
#define F_H WSP(bf16, WS_H)
#define F_H8 WSP(unsigned char, WS_H8)
#define F_WQKV8 WSP(unsigned char, WS_WQKV8)
#define F_U WSP(bf16, WS_U)
#define F_Q WSP(bf16, WS_Q)
#define F_K WSP(bf16, WS_K)
#define F_VT WSP(bf16, WS_VT)
#define F_MIX WSP(bf16, WS_MIX)
#define F_HID WSP(bf16, WS_HID)
#define F_H2 WSP(bf16, WS_H2)

template <int CTRL> __device__ __forceinline__ float dpp_mov(float v) { return __builtin_bit_cast(float, __builtin_amdgcn_update_dpp(0, __builtin_bit_cast(int, v), CTRL, 0xF, 0xF, true)); }
__device__ __forceinline__ float row16_sum(float v) { v += dpp_mov<0xB1>(v); v += dpp_mov<0x4E>(v); v += dpp_mov<0x141>(v); v += dpp_mov<0x140>(v); return v; }
__device__ __forceinline__ float row16_max(float v) { v = fmaxf(v, dpp_mov<0xB1>(v)); v = fmaxf(v, dpp_mov<0x4E>(v)); v = fmaxf(v, dpp_mov<0x141>(v)); v = fmaxf(v, dpp_mov<0x140>(v)); return v; }
__device__ __forceinline__ float rdlane(float v, int l) { return __builtin_bit_cast(float, __builtin_amdgcn_readlane(__builtin_bit_cast(int, v), l)); }
__device__ __forceinline__ float wave_sum(float v) {
    v = row16_sum(v);
    return (rdlane(v, 0) + rdlane(v, 16)) + (rdlane(v, 32) + rdlane(v, 48));
}
__device__ __forceinline__ float half_sum(float v, int half) {
    v = row16_sum(v);
    const float lo = rdlane(v, 0) + rdlane(v, 16), hi = rdlane(v, 32) + rdlane(v, 48);
    return half ? hi : lo;
}
__device__ __forceinline__ float wave_max(float v) {
#pragma unroll
    for (int o = 1; o < 64; o <<= 1) v = fmaxf(v, __shfl_xor(v, o));
    return v;
}

__device__ __forceinline__ void tr_load(const float* W, int N, int k0, int n0, int lane, f32x4 (&v)[8]) {
    const float* p = W + (size_t)(k0 + 8 * (lane & 7)) * N + n0 + 4 * (lane >> 3);
#pragma unroll
    for (int r = 0; r < 8; ++r) v[r] = __builtin_nontemporal_load((const f32x4*)(p + (size_t)r * N));
}
__device__ __forceinline__ void tr_store(const f32x4 (&v)[8], bf16* WT, int Kdst, int drow0, int k0, int lane) {
    bf16* q = WT + (size_t)(drow0 + 4 * (lane >> 3)) * Kdst + k0 + 8 * (lane & 7);
#pragma unroll
    for (int c = 0; c < 4; ++c) { v4u o; o.x = pk2(v[0][c], v[1][c]); o.y = pk2(v[2][c], v[3][c]); o.z = pk2(v[4][c], v[5][c]); o.w = pk2(v[6][c], v[7][c]);
        *(GAS v4u*)(q + (size_t)c * Kdst) = o; }
}
__device__ __forceinline__ void transpose_item(const float* W, int N, int k0, int n0, bf16* WT, int Kdst, int drow0, int lane) {
    f32x4 v[8]; tr_load(W, N, k0, n0, lane, v); tr_store(v, WT, Kdst, drow0, k0, lane);
}

__device__ __forceinline__ void tr8_load(const float* W, int N, int k0, int n0, int lane, f32x4 (&v)[16]);
__device__ __forceinline__ void tr8_store(const f32x4 (&v)[16], unsigned char* WT, int Kdst, int drow0, int k0, int lane, const float WPRESCALE);
constexpr int P1_RW = 2, P1_IT = 4;
__device__ __forceinline__ void p1_load(Frame& F, f32x4 (&xv)[P1_IT][P1_RW][4]);
__device__ __forceinline__ void p0_prologue(Frame& F, f32x4 (&xv)[P1_IT][P1_RW][4]) {
    {
        LAS float* sl = (LAS float*)(F.lds + RING_OFF);
        LAS float* part = sl + 3 * DM;
        for (int i = F.tid; i < 3 * DM; i += NWAVES * 64) { const int r = i >> 10, k = i & 1023; const float cv = (r < 2) ? F_c[r * DM + k] : F_c_ctx[k]; sl[i] = cv * fast_sigmoid(cv); }
        __syncthreads();
        for (int it = F.vcu; it < NMODV / 32; it += F.G) {
            const int c32 = F.lane & 31, n = it * 32 + c32, kb = F.wave * 128 + (F.lane >> 5);
            float wv[64];
#pragma unroll
            for (int i = 0; i < 64; ++i) wv[i] = __builtin_nontemporal_load(&F_w_mod[(size_t)(kb + 2 * i) * NMODV + n]);
            float a0 = 0.f, a1 = 0.f, a2 = 0.f;
#pragma unroll
            for (int i = 0; i < 64; ++i) { const int k = kb + 2 * i; a0 += sl[k] * wv[i]; a1 += sl[DM + k] * wv[i]; a2 += sl[2 * DM + k] * wv[i]; }
            a0 += __shfl_xor(a0, 32); a1 += __shfl_xor(a1, 32); a2 += __shfl_xor(a2, 32);
            if (F.lane < 32) { part[(F.wave * 3 + 0) * 32 + c32] = a0; part[(F.wave * 3 + 1) * 32 + c32] = a1; part[(F.wave * 3 + 2) * 32 + c32] = a2; }
            __syncthreads();
            if (F.tid < 96) { const int r = F.tid >> 5, c = F.tid & 31; float sacc = F_b_mod[it * 32 + c];
#pragma unroll
                for (int w = 0; w < 8; ++w) sacc += part[(w * 3 + r) * 32 + c];
                st_wt(&F_MOD[r * NMODV + it * 32 + c], sacc); }
            arrive_counter((unsigned*)WSP(unsigned, WS_CTL) + CW_ARR0);
        }
        __syncthreads();
    }
    asm volatile("" ::: "memory"); __builtin_amdgcn_sched_barrier(0);
    p1_load(F, xv);
    const int gw = F.vcu * NWAVES + F.wave, NGW = F.G * NWAVES;
    constexpr int I_GLU = (DM / 64) * (1024 / 32);
    constexpr int I_QKV = (DM / 128) * (1536 / 32);
    constexpr int I_OUT = (DM / 64) * (DM / 32);
    for (int it = gw; it < I_GLU + I_QKV + I_OUT; it += NGW) {
        int r = it;
        if (r < I_GLU) { const int kb = r >> 5, n0 = (r & 31) * 32; const int half = n0 >> 9, rem = n0 & 511, drow = 256 * (rem >> 7) + 128 * half + (rem & 127);
            transpose_item(F_w_in, NINC, kb * 64, n0, F_WIN, DM, drow, F.lane); continue; }
        r -= I_GLU;
        if (r < I_QKV) { const int kb = r / 48, nb = r % 48; f32x4 v[16]; tr8_load(F_w_in, NINC, kb * 128, 1024 + nb * 32, F.lane, v); tr8_store(v, F_WQKV8, DM, nb * 32, kb * 128, F.lane, 32.0f); continue; }
        r -= I_QKV;
        { const int nblk = DM / 32, kb = r / nblk, nb = r % nblk; transpose_item(F_w_out, DM, kb * 64, nb * 32, F_WOUT, DM, nb * 32, F.lane); }
    }
}

constexpr int MOE_I_G = (DM / 128) * (DEXP / 32);
constexpr int MOE_I_D = (DEXP / 128) * (DM / 32);
constexpr int MOE_ITEMS = NEXP * (2 * MOE_I_G), MOE_CHUNK = 4, MOE_NCHUNK = MOE_ITEMS / MOE_CHUNK;
constexpr float WPRE = 32.0f;
struct MoeSrc { const float* W; int N, k0, n0; unsigned char* WT; int Kdst, half; };
__device__ __forceinline__ MoeSrc moe_chunk_src(Frame& F, int ch) {
    int r = ch * MOE_CHUNK; MoeSrc m;
    const int e = r / (2 * MOE_I_G); r -= e * (2 * MOE_I_G);
    const int half = r / MOE_I_G; r -= half * MOE_I_G; const int nblk = DEXP / 32;
    m.W = (half ? F_w_up : F_w_gate) + (size_t)e * DM * DEXP; m.N = DEXP; m.k0 = (r / nblk) * 128; m.n0 = (r % nblk) * 32; m.WT = (unsigned char*)F_WGU + (size_t)e * 2 * DEXP * DM; m.Kdst = DM; m.half = half;
    return m;
}
__device__ __forceinline__ float moe_prescale(const MoeSrc& m) { return m.half == 0 ? WPRE * LOG2E : (m.half == 1 ? WPRE / LOG2E : WPRE); }
__device__ __forceinline__ int moe_drow(const MoeSrc& m, int n0) { return m.half == 2 ? n0 : 256 * (n0 >> 7) + 128 * m.half + (n0 & 127); }
__device__ __forceinline__ void tr8_load(const float* W, int N, int k0, int n0, int lane, f32x4 (&v)[16]) {
    const float* p = W + (size_t)(k0 + 16 * (lane & 7)) * N + n0 + 4 * (lane >> 3);
#pragma unroll
    for (int r = 0; r < 16; ++r) v[r] = __builtin_nontemporal_load((const f32x4*)(p + (size_t)r * N));
}
__device__ __forceinline__ void tr8_store(const f32x4 (&v)[16], unsigned char* WT, int Kdst, int drow0, int k0, int lane, const float WPRESCALE = 32.0f) {
    unsigned char* q = WT + (size_t)(drow0 + 4 * (lane >> 3)) * Kdst + k0 + 16 * (lane & 7);
#pragma unroll
    for (int c = 0; c < 4; ++c) { v4u o;
        o.x = pk4_fp8(v[0][c] * WPRESCALE, v[1][c] * WPRESCALE, v[2][c] * WPRESCALE, v[3][c] * WPRESCALE); o.y = pk4_fp8(v[4][c] * WPRESCALE, v[5][c] * WPRESCALE, v[6][c] * WPRESCALE, v[7][c] * WPRESCALE);
        o.z = pk4_fp8(v[8][c] * WPRESCALE, v[9][c] * WPRESCALE, v[10][c] * WPRESCALE, v[11][c] * WPRESCALE); o.w = pk4_fp8(v[12][c] * WPRESCALE, v[13][c] * WPRESCALE, v[14][c] * WPRESCALE, v[15][c] * WPRESCALE);
        *(GAS v4u*)(q + (size_t)c * Kdst) = o; }
}
template <bool STATIC_FIRST>
__device__ __forceinline__ void moe_weights(Frame& F, unsigned* counter, int quota, int second = -1, const int extra = 0) {
    const int gw = F.vcu * NWAVES + F.wave, NGW = F.G * NWAVES + extra, lane = F.lane;
    int ch;
    if (STATIC_FIRST) ch = gw;
    else { unsigned t0 = 0u; if (lane == 0) t0 = __hip_atomic_fetch_add(counter, 1u, __ATOMIC_RELAXED, __HIP_MEMORY_SCOPE_AGENT); ch = NGW + (int)__builtin_amdgcn_readfirstlane(t0); }
    unsigned nx = 0u; bool pending = false;
    for (int done = 0; ch < MOE_NCHUNK && done != quota; ++done) {
        const MoeSrc m = moe_chunk_src(F, ch);
        const bool more = (done + 1 != quota);
        if (more && !pending) { if (lane == 0) nx = __hip_atomic_fetch_add(counter, 1u, __ATOMIC_RELAXED, __HIP_MEMORY_SCOPE_AGENT); pending = true; }
        f32x4 va[16], vb[16]; const float wpre = moe_prescale(m);
        tr8_load(m.W, m.N, m.k0, m.n0, lane, va);
#pragma unroll
        for (int k = 0; k < MOE_CHUNK; k += 2) {
            tr8_load(m.W, m.N, m.k0, m.n0 + 32 * (k + 1), lane, vb);
            tr8_store(va, m.WT, m.Kdst, moe_drow(m, m.n0 + 32 * k), m.k0, lane, wpre);
            if (k + 2 < MOE_CHUNK) tr8_load(m.W, m.N, m.k0, m.n0 + 32 * (k + 2), lane, va);
            tr8_store(vb, m.WT, m.Kdst, moe_drow(m, m.n0 + 32 * (k + 1)), m.k0, lane, wpre);
        }
        if (second >= 0) { ch = second; second = -1; }
        else { ch = NGW + (int)__builtin_amdgcn_readfirstlane(nx); pending = false; }
    }
}

constexpr int DOWN_IPE = (DEXP / 64) * (DM / 32);
constexpr int DOWN_ITEMS = NEXP * DOWN_IPE;
struct DownSide {
    static constexpr bool ON = true;
    const float* w_down; unsigned char* WD; int gw, NGW, lane;
    __device__ __forceinline__ bool has(int ui) const { return ui * NGW + gw < DOWN_ITEMS; }
    __device__ __forceinline__ unsigned row_stride_bytes() const { return DM * 4u; }
    __device__ __forceinline__ const void* src(int ui) const {
        int lane = this->lane; asm volatile("" : "+v"(lane));
        const int d = ui * NGW + gw, e = d / DOWN_IPE, r = d % DOWN_IPE, kb = r / (DM / 32), nb = r % (DM / 32);
        return w_down + (size_t)e * DEXP * DM + (size_t)(kb * 64 + 8 * (lane & 7)) * DM + nb * 32 + 4 * (lane >> 3);
    }
    __device__ __forceinline__ void issue(int ui, f32x4 (&v)[8]) const {
        if (!has(ui)) return; const char* p = (const char*)src(ui);
#pragma unroll
        for (int r = 0; r < 8; ++r) v[r] = __builtin_nontemporal_load((const f32x4*)(p + (size_t)r * row_stride_bytes()));
    }
    __device__ __forceinline__ void finish(int ui, const f32x4 (&v)[8]) const {
        int lane = this->lane; asm volatile("" : "+v"(lane));
        const int d = ui * NGW + gw; if (d >= DOWN_ITEMS) return;
        const int e = d / DOWN_IPE, r = d % DOWN_IPE, kb = r / (DM / 32), nb = r % (DM / 32);
        unsigned char* q = WD + (size_t)e * DM * DEXP + (size_t)(nb * 32 + 4 * (lane >> 3)) * DEXP + kb * 64 + 8 * (lane & 7);
#pragma unroll
        for (int c = 0; c < 4; ++c) { v2u o; o.x = pk4_fp8(v[0][c] * WPRE, v[1][c] * WPRE, v[2][c] * WPRE, v[3][c] * WPRE); o.y = pk4_fp8(v[4][c] * WPRE, v[5][c] * WPRE, v[6][c] * WPRE, v[7][c] * WPRE);
            *(GAS v2u*)(q + (size_t)c * DEXP) = o; }
    }
};

__device__ __forceinline__ void p1_load(Frame& F, f32x4 (&xv)[P1_IT][P1_RW][4]) {
    const int gw = F.vcu * NWAVES + F.wave, NGW = F.G * NWAVES, lane = F.lane;
#pragma unroll
    for (int k = 0; k < P1_IT; ++k) { const int pr = gw + k * NGW;
        if (pr < MALL / P1_RW) { const int m0 = P1_RW * pr; const float* xr = (m0 < MTOK) ? F_x + (size_t)m0 * DM : F_ctx + (size_t)(m0 - MTOK) * DM;
#pragma unroll
            for (int q = 0; q < P1_RW; ++q)
#pragma unroll
                for (int j = 0; j < 4; ++j) xv[k][q][j] = __builtin_nontemporal_load((const f32x4*)(xr + (size_t)q * DM + 8 * (lane & 31) + 4 * (lane >> 5) + 256 * j)); } }
}
__device__ __forceinline__ void p1_row_pair(Frame& F, int pr, f32x4 (&v)[P1_RW][4]) {
    const int lane = F.lane, m0 = P1_RW * pr;
    const float* mod = F_MOD + (size_t)((m0 < MTOK) ? (m0 >> 13) : 2) * NMODV;
    float rstd[P1_RW];
#pragma unroll
    for (int q = 0; q < P1_RW; ++q) { float ss = 0.f;
#pragma unroll
        for (int j = 0; j < 4; ++j) ss += (v[q][j].x * v[q][j].x + v[q][j].y * v[q][j].y) + (v[q][j].z * v[q][j].z + v[q][j].w * v[q][j].w);
        rstd[q] = 1.0f / sqrtf(wave_sum(ss) * (1.0f / DM) + EPS); }
    const int l32 = lane & 31, hh = lane >> 5;
#pragma unroll
    for (int j = 0; j < 4; ++j) { const int col = 8 * l32 + 4 * hh + 256 * j;
        const f32x4 g = *(const GAS f32x4*)(F_norm_mix_g + col), sh = *(const GAS f32x4*)(mod + col), sc = *(const GAS f32x4*)(mod + DM + col);
        const f32x4 gs = g * (1.0f + sc);
        const f32x4 h0 = v[0][j] * rstd[0] * gs + sh, h1 = v[1][j] * rstd[1] * gs + sh;
        const auto s0 = __builtin_amdgcn_permlane32_swap(pk2(h0.x, h0.y), pk2(h1.x, h1.y), false, false), s1 = __builtin_amdgcn_permlane32_swap(pk2(h0.z, h0.w), pk2(h1.z, h1.w), false, false);
        const auto s8 = __builtin_amdgcn_permlane32_swap(pk4_fp8(clamp448(h0.x), clamp448(h0.y), clamp448(h0.z), clamp448(h0.w)), pk4_fp8(clamp448(h1.x), clamp448(h1.y), clamp448(h1.z), clamp448(h1.w)), false, false);
        *(GAS v4u*)(F_H + (size_t)(m0 + hh) * DM + 8 * l32 + 256 * j) = (v4u){s0[0], s1[0], s0[1], s1[1]};
        *(GAS v2u*)(F_H8 + (size_t)(m0 + hh) * DM + 8 * l32 + 256 * j) = (v2u){s8[0], s8[1]}; }
    static_assert(P1_RW == 2, "the row pair is what the half-wave swap merges");
}
__device__ __forceinline__ void p1_hpass(Frame& F, f32x4 (&xv)[P1_IT][P1_RW][4]) {
    wait_counter((unsigned*)WSP(unsigned, WS_CTL) + CW_ARR0, NMODV / 32, (unsigned*)WSP(unsigned, WS_CTL) + CW_TMO);
    const int gw = F.vcu * NWAVES + F.wave, NGW = F.G * NWAVES, lane = F.lane;
#pragma unroll
    for (int k = 0; k < P1_IT; ++k) { const int pr = gw + k * NGW; if (pr < MALL / P1_RW) p1_row_pair(F, pr, xv[k]); }
    for (int pr = gw + P1_IT * NGW; pr < MALL / P1_RW; pr += NGW) {
        const int m0 = P1_RW * pr; const float* xr = (m0 < MTOK) ? F_x + (size_t)m0 * DM : F_ctx + (size_t)(m0 - MTOK) * DM; f32x4 v[P1_RW][4];
#pragma unroll
        for (int q = 0; q < P1_RW; ++q)
#pragma unroll
            for (int j = 0; j < 4; ++j) v[q][j] = __builtin_nontemporal_load((const f32x4*)(xr + (size_t)q * DM + 8 * (lane & 31) + 4 * (lane >> 5) + 256 * j));
        p1_row_pair(F, pr, v); }
}

struct GluOrder {
    int vcu, G; const char *H, *WIN;
    __device__ __forceinline__ bool next(int i, pg8::Unit& u) const {
        const size_t tstep = (size_t)256 * DM * 2;
        int pm, pn;
        if (G == 256) { if (i > 0) return false; const int x = vcu >> 5, s = vcu & 31; pm = 8 * x + (s & 7); pn = s >> 3; }
        else { const int L = i * G + vcu; if (L >= 256) return false; pm = L >> 2; pn = L & 3; }
        u.pm = pm; u.pn = pn; u.kind = 0; u.A = H + (size_t)pm * tstep; u.B = WIN + (size_t)pn * tstep; return true;
    }
};
struct QkvOrder {
    int vcu, G; const char *H8, *W8;
    __device__ __forceinline__ bool next(int i, pg8::Unit& u) const {
        const size_t tstep = (size_t)256 * DM;
        int pm, pn, kind;
        if (G == 256) {
            const int x = vcu >> 5, s = vcu & 31;
            if (i == 0) { pm = 8 * x + (s & 7); pn = 4 + (s >> 3); kind = pn < 6 ? 1 : 2; }
            else if (i == 1) {
                if (s < 16) { kind = 3; pm = s & 1; pn = 8 * x + (s >> 1); }
                else if (s == 16) { if (x < 4) { kind = 3; pm = x & 1; pn = 64 + (x >> 1); } else { kind = 2; pm = 64 + ((x - 4) >> 1); pn = 6 + ((x - 4) & 1); } }
                else return false;
            } else return false;
        } else {
            const int L = i * G + vcu;
            if (L < 256) { pm = L >> 2; pn = 4 + (L & 3); kind = pn < 6 ? 1 : 2; }
            else if (L < 260) { kind = 2; pm = 64 + ((L - 256) >> 1); pn = 6 + ((L - 256) & 1); }
            else if (L < 392) { kind = 3; pm = (L - 260) & 1; pn = (L - 260) >> 1; }
            else return false;
        }
        u.pm = pm; u.pn = pn; u.kind = kind;
        if (kind == 3) { u.A = W8 + (size_t)(4 + pm) * tstep; u.B = H8 + (size_t)pn * tstep; }
        else { u.A = H8 + (size_t)pm * tstep; u.B = W8 + (size_t)(pn - 4) * tstep; }
        return true;
    }
};
struct EpiInProj {
    static constexpr bool PERM = true;
    bf16 *U, *Q, *Kb, *Vt; float qscale;
    __device__ __forceinline__ void operator()(const pg8::f32x4 (&acc)[2][2][4][2], const pg8::Unit& u, int wr, int wc, int fr, int fq) const {
        const int row0 = u.pm * 256 + wr * 64 + fr;
        if (u.kind == 0) {
            const int col0 = u.pn * 128 + wc * 32 + 8 * fq;
#pragma unroll
            for (int ai = 0; ai < 2; ++ai)
#pragma unroll
                for (int m = 0; m < 4; ++m) {
                    float v[8];
#pragma unroll
                    for (int n = 0; n < 2; ++n)
#pragma unroll
                        for (int i = 0; i < 4; ++i) v[4 * n + i] = acc[ai][0][m][n][i] * fast_sigmoid(acc[ai][1][m][n][i]);
                    v4u w; w.x = pg8::cvt_pk_bf16(v[0], v[1]); w.y = pg8::cvt_pk_bf16(v[2], v[3]); w.z = pg8::cvt_pk_bf16(v[4], v[5]); w.w = pg8::cvt_pk_bf16(v[6], v[7]);
                    *(v4u*)(U + (size_t)(row0 + ai * 128 + m * 16) * CONVC + col0) = w; }
        } else if (u.kind == 3) {
            const int b = u.pn < 64 ? (u.pn >> 5) : (u.pn - 64), tb0 = u.pn < 64 ? ((u.pn & 31) << 8) : SEQ;
#pragma unroll
            for (int ai = 0; ai < 2; ++ai)
#pragma unroll
                for (int m = 0; m < 4; ++m) { const int vc = row0 + ai * 128 + m * 16, head = vc >> 6, d = vc & 63;
#pragma unroll
                    for (int bj = 0; bj < 2; ++bj) { const int tb = tb0 + bj * 128 + wc * 32 + 8 * fq, w0 = tb & 31;
                        const size_t off = ((((size_t)(b * 8 + head) * KTILES + (tb >> 5)) * 2 + (d >> 5)) * 2 + (w0 >> 4)) * 512 + (((w0 >> 3) & 1) * 32 + (d & 31)) * 8;
                        const pg8::f32x4 v0 = acc[ai][bj][m][0], v1 = acc[ai][bj][m][1];
                        v4u w; w.x = pg8::cvt_pk_bf16(v0[0], v0[1]); w.y = pg8::cvt_pk_bf16(v0[2], v0[3]); w.z = pg8::cvt_pk_bf16(v1[0], v1[1]); w.w = pg8::cvt_pk_bf16(v1[2], v1[3]);
                        *(v4u*)(Vt + off) = w; } }
        } else {
            const bool isq = u.kind == 1; const float sc = isq ? qscale : 1.f;
            const int colt = (u.pn - (isq ? 4 : 6)) * 256;
            const int b = u.pm < 64 ? (u.pm >> 5) : (u.pm - 64), tb0 = u.pm < 64 ? ((u.pm & 31) << 8) : SEQ;
            bf16* base = isq ? Q : Kb; const int ntile = isq ? (SEQ / 32) : KTILES;
#pragma unroll
            for (int ai = 0; ai < 2; ++ai)
#pragma unroll
                for (int m = 0; m < 4; ++m) { const int tb = tb0 + wr * 64 + fr + ai * 128 + m * 16; int w = tb & 31; if (!isq) w = (w & 0x13) | ((w & 4) << 1) | ((w & 8) >> 1);
#pragma unroll
                    for (int bj = 0; bj < 2; ++bj) { const int c0 = colt + bj * 128 + wc * 32 + 8 * fq, head = c0 >> 6, d0 = c0 & 63;
                        const size_t off = (((size_t)(b * 8 + head) * ntile + (tb >> 5)) * 4 + (d0 >> 4)) * 512 + (((d0 >> 3) & 1) * 32 + w) * 8;
                        const pg8::f32x4 v0 = acc[ai][bj][m][0] * sc, v1 = acc[ai][bj][m][1] * sc;
                        v4u wv; wv.x = pg8::cvt_pk_bf16(v0[0], v0[1]); wv.y = pg8::cvt_pk_bf16(v0[2], v0[3]); wv.z = pg8::cvt_pk_bf16(v1[0], v1[1]); wv.w = pg8::cvt_pk_bf16(v1[2], v1[3]);
                        *(v4u*)(base + off) = wv; } }
        }
    }
};

constexpr int P3_Y_OFF = 0;
constexpr int P3_BIAS_OFF = 0;
constexpr float ATT_THR = 8.0f;

struct AttnState { f32x16 O[2][2]; float mref[2], lsum[2]; };
template <bool LOCAL>
__device__ __forceinline__ void attn_tile(AttnState& st, const bf16x8 (&Ak)[4], const bf16x8 (&Av)[2][2], const bf16x8 (&Bq)[2][4], const LAS float* btrow, const int half, int q32, int hh) {
    f32x16 S[2];
    if (LOCAL) {
#pragma unroll
        for (int qt = 0; qt < 2; ++qt) { const int qc = 32 * qt + q32; int c0 = qc - 8; c0 = c0 < 0 ? 0 : (c0 > 48 ? 48 : c0);
            const int vb = 8 * hh + 32 * half - c0;
            const LAS float* bp = btrow + (8 * hh + 32 * half - qc + 63);
            const int rlo = (qt != half) ? (qt == 0 ? 0 : 8) : 0, rhi = (qt != half) ? rlo + 8 : 16;
#pragma unroll
            for (int rr = 0; rr < 16; ++rr) { const int kconst = 16 * (rr >> 3) + (rr & 7);
                if (rr >= rlo && rr < rhi) { const float bv = bp[kconst]; S[qt][rr] = ((unsigned)(kconst + vb) < 16u) ? bv : -1e30f; } else S[qt][rr] = 0.f; } }
    } else {
#pragma unroll
        for (int qt = 0; qt < 2; ++qt)
#pragma unroll
            for (int rr = 0; rr < 16; ++rr) S[qt][rr] = 0.f;
    }
#pragma unroll
    for (int qt = 0; qt < 2; ++qt)
#pragma unroll
        for (int ds = 0; ds < 4; ++ds) S[qt] = __builtin_amdgcn_mfma_f32_32x32x16_bf16(Ak[ds], Bq[qt][ds], S[qt], 0, 0, 0);
#pragma unroll
    for (int qt = 0; qt < 2; ++qt) {
        const bool corner = LOCAL && (qt != half);
        const int rlo = corner ? (qt == 0 ? 0 : 8) : 0, rhi = corner ? rlo + 8 : 16;
        float tm = fmaxf(S[qt][rlo], S[qt][rlo + 1]);
#pragma unroll
        for (int rr = rlo + 2; rr < rhi; ++rr) tm = fmaxf(tm, S[qt][rr]);
        tm = fmaxf(tm, __shfl_xor(tm, 32));
        if (__any(tm > st.mref[qt] + ATT_THR)) {
            const float mn = fmaxf(st.mref[qt], tm), sc = __builtin_amdgcn_exp2f(st.mref[qt] - mn);
            st.mref[qt] = mn; st.lsum[qt] *= sc;
#pragma unroll
            for (int i = 0; i < 16; ++i) { st.O[0][qt][i] *= sc; st.O[1][qt][i] *= sc; }
        }
        float p[16]; float ps = 0.f;
#pragma unroll
        for (int rr = 0; rr < 16; ++rr) { if (rr >= rlo && rr < rhi) { p[rr] = __builtin_amdgcn_exp2f(S[qt][rr] - st.mref[qt]); ps += p[rr]; } else p[rr] = 0.f; }
        st.lsum[qt] += ps;
#pragma unroll
        for (int s2 = 0; s2 < 2; ++s2) {
            if (8 * s2 >= rlo && 8 * s2 < rhi) {
                v4u w; w.x = pg8::cvt_pk_bf16(p[8 * s2 + 0], p[8 * s2 + 1]); w.y = pg8::cvt_pk_bf16(p[8 * s2 + 2], p[8 * s2 + 3]); w.z = pg8::cvt_pk_bf16(p[8 * s2 + 4], p[8 * s2 + 5]); w.w = pg8::cvt_pk_bf16(p[8 * s2 + 6], p[8 * s2 + 7]);
                const bf16x8 Bp = __builtin_bit_cast(bf16x8, w);
#pragma unroll
                for (int dt = 0; dt < 2; ++dt) st.O[dt][qt] = __builtin_amdgcn_mfma_f32_32x32x16_bf16(Av[dt][s2], Bp, st.O[dt][qt], 0, 0, 0);
            }
        }
    }
}
#define ATT_LOADK(AK, TILE) do { _Pragma("unroll") for (int ds = 0; ds < 4; ++ds) AK[ds] = *(const GAS bf16x8*)(Kh + ((size_t)(TILE) * 4 + ds) * 512); } while (0)
#define ATT_LOADV(AV, TILE) do { _Pragma("unroll") for (int dt = 0; dt < 2; ++dt) _Pragma("unroll") for (int s2 = 0; s2 < 2; ++s2) AV[dt][s2] = *(const GAS bf16x8*)(Vh + (((size_t)(TILE) * 2 + dt) * 2 + s2) * 512); } while (0)
__device__ __forceinline__ void attn_wave(Frame& F, int b, int r) {
    const int lane = F.lane, head = F.wave, q32 = lane & 31, hh = lane >> 5;
    const LAS float* bt = (const LAS float*)(F.lds + P3_BIAS_OFF) + head * 15 * 128;
    const int tok0 = b * SEQ + r * 64;
    bf16x8 Bq[2][4];
#pragma unroll
    for (int qt = 0; qt < 2; ++qt)
#pragma unroll
        for (int ds = 0; ds < 4; ++ds) Bq[qt][ds] = *(const GAS bf16x8*)(F_Q + ((((size_t)(b * 8 + head) * (SEQ / 32) + 2 * r + qt) * 4 + ds) * 64 + lane) * 8);
    AttnState st;
#pragma unroll
    for (int a = 0; a < 2; ++a)
#pragma unroll
        for (int c = 0; c < 2; ++c)
#pragma unroll
            for (int i = 0; i < 16; ++i) st.O[a][c][i] = 0.f;
    st.mref[0] = st.mref[1] = -1e30f; st.lsum[0] = st.lsum[1] = 0.f;
    int r0 = r - 4; r0 = r0 < 0 ? 0 : (r0 > GROWS - 8 ? GROWS - 8 : r0);
    const bf16* Kh = F_K + (size_t)(b * 8 + head) * KTILES * 2048 + lane * 8;
    const bf16* Vh = F_VT + (size_t)(b * 8 + head) * KTILES * 2048 + lane * 8;
    const int ctx0 = SEQ / 32, loc0 = 2 * r0;
    bf16x8 Ka[4], Kb[4], Vc[2][2];
    ATT_LOADK(Ka, ctx0);
#pragma unroll 1
    for (int t = 0; t < 8; t += 2) {
        ATT_LOADV(Vc, ctx0 + t); ATT_LOADK(Kb, ctx0 + t + 1);
        attn_tile<false>(st, Ka, Vc, Bq, bt, 0, q32, hh);
        ATT_LOADV(Vc, ctx0 + t + 1); { const int nt = (t + 2 < 8) ? ctx0 + t + 2 : loc0; ATT_LOADK(Ka, nt); }
        attn_tile<false>(st, Kb, Vc, Bq, bt, 0, q32, hh);
    }
#pragma unroll 1
    for (int j = 0; j < 8; ++j) { const int kr = r0 + j; const LAS float* btrow = bt + (kr - r + 7) * 128;
        ATT_LOADV(Vc, loc0 + 2 * j); ATT_LOADK(Kb, loc0 + 2 * j + 1);
        attn_tile<true>(st, Ka, Vc, Bq, btrow, 0, q32, hh);
        ATT_LOADV(Vc, loc0 + 2 * j + 1); { const int nt = (j + 1 < 8) ? loc0 + 2 * (j + 1) : loc0; ATT_LOADK(Ka, nt); }
        attn_tile<true>(st, Kb, Vc, Bq, btrow, 1, q32, hh);
    }
#pragma unroll
    for (int qt = 0; qt < 2; ++qt) {
        const float lt = st.lsum[qt] + __shfl_xor(st.lsum[qt], 32), inv = 1.0f / lt;
        bf16* orow = F_MIX + (size_t)(tok0 + 32 * qt + q32) * DM + CONVC + head * HD;
#pragma unroll
        for (int dt = 0; dt < 2; ++dt)
#pragma unroll
            for (int gp = 0; gp < 2; ++gp) { unsigned wa[2], wb[2];
#pragma unroll
                for (int c = 0; c < 2; ++c) { wa[c] = pg8::cvt_pk_bf16(st.O[dt][qt][8 * gp + 2 * c] * inv, st.O[dt][qt][8 * gp + 2 * c + 1] * inv); wb[c] = pg8::cvt_pk_bf16(st.O[dt][qt][8 * gp + 4 + 2 * c] * inv, st.O[dt][qt][8 * gp + 4 + 2 * c + 1] * inv); }
                const auto s0 = __builtin_amdgcn_permlane32_swap(wa[0], wb[0], false, false), s1 = __builtin_amdgcn_permlane32_swap(wa[1], wb[1], false, false);
                v4u w; w.x = s0[0]; w.y = s1[0]; w.z = s0[1]; w.w = s1[1];
                st_wt16(orow + 32 * dt + 8 * (2 * gp + hh), w); }
    }
}

__device__ __forceinline__ void conv_unit(Frame& F, int b, int r) {
    const int lane = F.lane, w = F.wave;
    const int cp = F.tid & 255, th = F.tid >> 8;
    LAS float* yb = (LAS float*)(F.lds + P3_Y_OFF);
    const float *cw = F_conv_w, *cb = F_conv_b, *lg = F_conv_ln_g, *lb = F_conv_ln_b;
    asm volatile("" : "+s"(cw), "+s"(cb), "+s"(lg), "+s"(lb));
    {
        const int t0 = r * 64 + 32 * th - 15;
        f32x2 wj[CONVW];
#pragma unroll
        for (int j = 0; j < CONVW; ++j) wj[j] = *(const GAS f32x2*)(cw + j * CONVC + 2 * cp);
        const f32x2 bias = *(const GAS f32x2*)(cb + 2 * cp);
        unsigned inw[62];
        const bf16* up = F_U + (size_t)b * SEQ * CONVC + 2 * cp;
#pragma unroll
        for (int k = 0; k < 62; ++k) { const int tt = t0 + k, tc = tt < 0 ? 0 : (tt > SEQ - 1 ? SEQ - 1 : tt); inw[k] = *(const GAS unsigned*)(up + (size_t)tc * CONVC); }
        __builtin_amdgcn_sched_barrier(0);
        f32x2 in[62];
#pragma unroll
        for (int k = 0; k < 62; ++k) { const int tt = t0 + k; const unsigned wv = (tt >= 0 && tt < SEQ) ? inw[k] : 0u; in[k] = (f32x2){bf_lo(wv), bf_hi(wv)}; }
#pragma unroll
        for (int t = 0; t < 32; ++t) { f32x2 a = bias;
#pragma unroll
            for (int j = 0; j < CONVW; ++j) a = wj[j] * in[t + j] + a;
            *(LAS f32x2*)(yb + (32 * th + t) * CONVC + 2 * cp) = a; }
    }
    __syncthreads();
    const f32x4 g0 = *(const GAS f32x4*)(lg + 8 * lane), g1 = *(const GAS f32x4*)(lg + 8 * lane + 4);
    const f32x4 b0 = *(const GAS f32x4*)(lb + 8 * lane), b1 = *(const GAS f32x4*)(lb + 8 * lane + 4);
#pragma unroll 2
    for (int k = 0; k < 8; ++k) { const int tk = 8 * w + k;
        f32x4 y0 = *(const LAS f32x4*)(yb + tk * CONVC + 8 * lane), y1 = *(const LAS f32x4*)(yb + tk * CONVC + 8 * lane + 4);
        const float s = wave_sum((y0.x + y0.y) + (y0.z + y0.w) + (y1.x + y1.y) + (y1.z + y1.w));
        const float mean = s * (1.0f / CONVC);
        y0 = y0 - mean; y1 = y1 - mean;
        const float q = wave_sum((y0.x * y0.x + y0.y * y0.y) + (y0.z * y0.z + y0.w * y0.w) + (y1.x * y1.x + y1.y * y1.y) + (y1.z * y1.z + y1.w * y1.w));
        const float rstd = 1.0f / sqrtf(q * (1.0f / CONVC) + EPS);
        y0 = y0 * rstd * g0 + b0; y1 = y1 * rstd * g1 + b1;
        v4u wv; wv.x = pk2(y0.x * fast_sigmoid(y0.x), y0.y * fast_sigmoid(y0.y)); wv.y = pk2(y0.z * fast_sigmoid(y0.z), y0.w * fast_sigmoid(y0.w));
        wv.z = pk2(y1.x * fast_sigmoid(y1.x), y1.y * fast_sigmoid(y1.y)); wv.w = pk2(y1.z * fast_sigmoid(y1.z), y1.w * fast_sigmoid(y1.w));
        st_wt16(F_MIX + (size_t)(b * SEQ + r * 64 + tk) * DM + 8 * lane, wv); }
    __syncthreads();
}

__device__ __forceinline__ void p3_bias_fill(Frame& F, int r) {
    LAS float* bt = (LAS float*)(F.lds + P3_BIAS_OFF);
    int r0 = r - 4; r0 = r0 < 0 ? 0 : (r0 > GROWS - 8 ? GROWS - 8 : r0); const int dr0 = r0 - r + 7;
    for (int i = F.tid; i < NHEADS * 8 * 128; i += NWAVES * 64) { const int d = (i & 127) - 48, dr = dr0 + ((i >> 7) & 7), hd = i >> 10; bt[(hd * 15 + dr) * 128 + (i & 127)] = (d >= 0 && d < 31) ? F_rpb[(hd * 15 + dr) * 31 + d] * LOG2E : 0.f; }
}
__device__ __forceinline__ void p3_mixers(Frame& F, const bool prefilled) {
    LAS float* bt = (LAS float*)(F.lds + P3_BIAS_OFF);
    for (int u = F.vcu; u < NB * GROWS; u += F.G) {
        const int b = u / GROWS, r = u % GROWS;
        SEC_BEGIN(3)
        if (u != F.vcu || !prefilled) p3_bias_fill(F, r);
        __syncthreads();
        SEC_END(3)
        SEC_BEGIN(1)
#ifndef PROBE_ATTN
#define PROBE_ATTN 1
#endif
#pragma unroll 1
        for (int rp = 0; rp < PROBE_ATTN; ++rp) attn_wave(F, b, r);
        asm volatile("" ::: "memory"); __builtin_amdgcn_sched_barrier(0); __syncthreads(); asm volatile("" ::: "memory");
        SEC_END(1)
        SEC_BEGIN(2)
        conv_unit(F, b, r);
        SEC_END(2)
        arrive_counter2((unsigned*)WSP(unsigned, WS_CTL) + CW_ARR3 + CW_ARRS * (u >> 2), (unsigned*)WSP(unsigned, WS_CTL) + CW_ARR3 - CW_ARRS);
    }
}

struct OutProjOrder {
    int vcu, G; const char *MIX, *WOUT;
    __device__ __forceinline__ bool next(int i, pg8::Unit& u) const {
        const size_t tstep = (size_t)256 * DM * 2;
        int pm, pn;
        if (G == 256) { if (i > 0) return false; const int x = vcu >> 5, s = vcu & 31; pm = 8 * x + (s & 7); pn = s >> 3; }
        else { const int L = i * G + vcu; if (L >= 256) return false; pm = L >> 2; pn = L & 3; }
        u.pm = pm; u.pn = pn; u.kind = 0; u.A = MIX + (size_t)pm * tstep; u.B = WOUT + (size_t)pn * tstep; return true;
    }
};
struct EpiOutProj {
    static constexpr bool PERM = true;
    const float* x; const float* MOD; bf16* X1;
    __device__ __forceinline__ void operator()(const pg8::f32x4 (&acc)[2][2][4][2], const pg8::Unit& u, int wr, int wc, int fr, int fq) const {
        const int row0 = u.pm * 256 + wr * 64 + fr, col0 = u.pn * 256 + wc * 32 + 8 * fq;
        const float* g1 = MOD + (size_t)(u.pm >> 5) * NMODV + 2 * DM;
        pg8::f32x4 gv[2][2];
#pragma unroll
        for (int bj = 0; bj < 2; ++bj)
#pragma unroll
            for (int n = 0; n < 2; ++n) gv[bj][n] = *(const pg8::f32x4*)(g1 + col0 + bj * 128 + n * 4);
#pragma unroll
        for (int ai = 0; ai < 2; ++ai) {
            pg8::f32x4 xr[4][2][2];
#pragma unroll
            for (int m = 0; m < 4; ++m) { const size_t off = (size_t)(row0 + ai * 128 + m * 16) * DM + col0;
#pragma unroll
                for (int bj = 0; bj < 2; ++bj) { xr[m][bj][0] = *(const pg8::f32x4*)(x + off + bj * 128); xr[m][bj][1] = *(const pg8::f32x4*)(x + off + bj * 128 + 4); } }
#pragma unroll
            for (int m = 0; m < 4; ++m) { const size_t off = (size_t)(row0 + ai * 128 + m * 16) * DM + col0;
#pragma unroll
                for (int bj = 0; bj < 2; ++bj) { const pg8::f32x4 v0 = xr[m][bj][0] + gv[bj][0] * acc[ai][bj][m][0], v1 = xr[m][bj][1] + gv[bj][1] * acc[ai][bj][m][1];
                    v4u w; w.x = pg8::cvt_pk_bf16(v0[0], v0[1]); w.y = pg8::cvt_pk_bf16(v0[2], v0[3]); w.z = pg8::cvt_pk_bf16(v1[0], v1[1]); w.w = pg8::cvt_pk_bf16(v1[2], v1[3]);
                    st_wt16(X1 + off + bj * 128, w); } }
        }
    }
};

#ifndef P5_CONV
#define P5_CONV 112
#endif
__device__ __forceinline__ bool p5_is_converter(const Frame& F) { return F.G == 256 && (F.vcu & 31) >= 32 - P5_CONV / 8; }
__device__ __forceinline__ void p5_router(Frame& F) {
    if (p5_is_converter(F)) { arrive_counter((unsigned*)WSP(unsigned, WS_CTL) + CW_ARR5); return; }
    LAS f32x4* wl = (LAS f32x4*)(F.lds + RING_OFF);
    for (int idx = F.tid; idx < DM * 4; idx += NWAVES * 64) { const int c = idx >> 2, q = idx & 3; const f32x4 v = *(const GAS f32x4*)(F_w_router + c * NEXP + 4 * q);
        const int l = c >> 4, j = (c >> 2) & 3, i = c & 3; wl[((j * 4 + i) * 4 + q) * 64 + l] = v; }
    __syncthreads();
    const int gw = F.vcu * NWAVES + F.wave, NGW = F.G * NWAVES, lane = F.lane;
    unsigned* c4 = (unsigned*)WSP(unsigned, WS_CTL) + CW_ARR4; unsigned* tmo = (unsigned*)WSP(unsigned, WS_CTL) + CW_TMO;
    if (F.G != 256) wait_counter(c4 - CW_ARRS, 256u, tmo);
    volatile LAS int* tk = (volatile LAS int*)(F.lds + RING_OFF + 65536);
    unsigned tnext = 0u; bool alldone = false;
    f32x4 gsv[4], shv[4]; int modb = -1;
#pragma unroll
    for (int j = 0; j < 4; ++j) { gsv[j] = (f32x4){0.f, 0.f, 0.f, 0.f}; shv[j] = gsv[j]; }
    for (int round = 0;; ++round) {
      int qbeg, qend, qstep;
      if (F.G == 256) {
          if (F.tid == 0) {
              unsigned* q5 = (unsigned*)WSP(unsigned, WS_CTL) + CW_P5Q + 8 * (F.vcu >> 5);
              if (round == 0) tnext = __hip_atomic_fetch_add(q5, 1u, __ATOMIC_RELAXED, __HIP_MEMORY_SCOPE_AGENT);
              const unsigned t = tnext; tk[round & 1] = (int)t;
              if (t < 64u) {
                  tnext = __hip_atomic_fetch_add(q5, 1u, __ATOMIC_RELAXED, __HIP_MEMORY_SCOPE_AGENT);
                  if (!alldone) {
                      if (__hip_atomic_load(c4 - CW_ARRS, __ATOMIC_RELAXED, __HIP_MEMORY_SCOPE_AGENT) >= (unsigned)(MTOK / 64)) alldone = true;
                      else { unsigned sp = 0u; while (__hip_atomic_load(c4 + CW_ARRS * (8 * (F.vcu >> 5) + (t >> 3)), __ATOMIC_RELAXED, __HIP_MEMORY_SCOPE_AGENT) < 4u) { __builtin_amdgcn_s_sleep(2); if (++sp > (1u << 20)) { __hip_atomic_store(tmo, 1u, __ATOMIC_RELAXED, __HIP_MEMORY_SCOPE_AGENT); break; } } }
                      __builtin_amdgcn_fence(__ATOMIC_ACQUIRE, "agent");
                  }
              }
          }
          __syncthreads();
          const int t = tk[round & 1];
          if (t >= 64) break;
          qbeg = (32 * (F.vcu >> 5) + (t >> 1)) * 16 + (t & 1) * 8 + F.wave; qend = qbeg + 1; qstep = 1;
      } else { if (round > 0) break; qbeg = gw; qend = MTOK / 4; qstep = NGW; }
    for (int qd = qbeg; qd < qend; qd += qstep) {
        const int m0 = 4 * qd, b = m0 >> 13;
        const float* mod = F_MOD + (size_t)b * NMODV;
        f32x4 v[4][4];
#pragma unroll
        for (int tk = 0; tk < 4; ++tk) { const GAS v4u* xr = (const GAS v4u*)(F_X1 + (size_t)(m0 + tk) * DM) + 2 * lane; const v4u w0 = xr[0], w1 = xr[1];
            v[tk][0] = (f32x4){bf_lo(w0.x), bf_hi(w0.x), bf_lo(w0.y), bf_hi(w0.y)}; v[tk][1] = (f32x4){bf_lo(w0.z), bf_hi(w0.z), bf_lo(w0.w), bf_hi(w0.w)};
            v[tk][2] = (f32x4){bf_lo(w1.x), bf_hi(w1.x), bf_lo(w1.y), bf_hi(w1.y)}; v[tk][3] = (f32x4){bf_lo(w1.z), bf_hi(w1.z), bf_lo(w1.w), bf_hi(w1.w)}; }
        float rstd[4];
#pragma unroll
        for (int tk = 0; tk < 4; ++tk) { float ss = 0.f;
#pragma unroll
            for (int j = 0; j < 4; ++j) ss += (v[tk][j].x * v[tk][j].x + v[tk][j].y * v[tk][j].y) + (v[tk][j].z * v[tk][j].z + v[tk][j].w * v[tk][j].w);
            rstd[tk] = 1.0f / sqrtf(wave_sum(ss) * (1.0f / DM) + EPS); }
        float lg[64]; unsigned hp[4][4];
#pragma unroll
        for (int e = 0; e < 64; ++e) lg[e] = 0.f;
        if (b != modb) {
            f32x4 gv[4], scv[4];
#pragma unroll
            for (int j = 0; j < 4; ++j) { const int col = 16 * lane + 4 * j; gv[j] = *(const GAS f32x4*)(F_norm_ffn_g + col); shv[j] = *(const GAS f32x4*)(mod + 3 * DM + col); scv[j] = *(const GAS f32x4*)(mod + 4 * DM + col); }
#pragma unroll
            for (int j = 0; j < 4; ++j) gsv[j] = gv[j] * (1.0f + scv[j]);
            modb = b; }
#pragma unroll
        for (int j = 0; j < 4; ++j) { const f32x4 gs = gsv[j], sh = shv[j];
#pragma unroll
            for (int tk = 0; tk < 4; ++tk) { v[tk][j] = v[tk][j] * rstd[tk] * gs + sh;
                hp[tk][j] = pk4_fp8(clamp448(v[tk][j].x), clamp448(v[tk][j].y), clamp448(v[tk][j].z), clamp448(v[tk][j].w)); }
#pragma unroll
            for (int i = 0; i < 4; ++i) {
#pragma unroll
                for (int q = 0; q < 4; ++q) { const f32x4 wv = wl[((j * 4 + i) * 4 + q) * 64 + lane];
#pragma unroll
                    for (int tk = 0; tk < 4; ++tk) { const float hv = v[tk][j][i];
                        lg[tk * 16 + 4 * q + 0] += hv * wv.x; lg[tk * 16 + 4 * q + 1] += hv * wv.y; lg[tk * 16 + 4 * q + 2] += hv * wv.z; lg[tk * 16 + 4 * q + 3] += hv * wv.w; } }
                __builtin_amdgcn_sched_barrier(0); } }
#pragma unroll
        for (int tk = 0; tk < 4; ++tk) *(GAS v4u*)((unsigned char*)F_H2 + (size_t)(m0 + tk) * DM + 16 * lane) = (v4u){hp[tk][0], hp[tk][1], hp[tk][2], hp[tk][3]};
#pragma unroll
        for (int w = 32; w >= 1; w >>= 1) {
#pragma unroll
            for (int i = 0; i < w; ++i) { const bool up = (lane & w) != 0; const float send = up ? lg[i] : lg[i + w], keep = up ? lg[i + w] : lg[i]; lg[i] = keep + __shfl_xor(send, w); } }
        const float logit = lg[0];
        const float mx = row16_max(logit), p = __expf(logit - mx), den = row16_sum(p);
        const int tk = lane >> 4, e = lane & 15, t = (m0 + tk) & (SEQ - 1);
        st_wt(&F_AFF[(size_t)(b * NEXP + e) * SEQ + t], p / den);
    }
    }
    arrive_counter((unsigned*)WSP(unsigned, WS_CTL) + CW_ARR5);
}

__device__ __forceinline__ int block_excl_scan(int v, LAS int* sc, int tid, int lane, int wave, int& total) {
    int inc = v;
#pragma unroll
    for (int o = 1; o < 64; o <<= 1) { const int t = __shfl_up(inc, o); if (lane >= o) inc += t; }
    __syncthreads();
    if (lane == 63) sc[wave] = inc;
    __syncthreads();
    int base = 0, tot = 0;
#pragma unroll
    for (int w = 0; w < 8; ++w) { const int c = sc[w]; if (w < wave) base += c; tot += c; }
    total = tot;
    return base + inc - v;
}
__device__ __forceinline__ void p6_topk(Frame& F) {
    LAS int* hist = (LAS int*)(F.lds + RING_OFF);
    LAS int* sel = hist + 256;
    LAS int* sc = hist + 264;
    if ((int)blockIdx.x < NB * NEXP) wait_counter((unsigned*)WSP(unsigned, WS_CTL) + CW_ARR5, (unsigned)F.G, (unsigned*)WSP(unsigned, WS_CTL) + CW_TMO);
    for (int be = blockIdx.x; be < NB * NEXP; be += F.G) {
        const int b = be >> 4, e = be & 15;
        const float* a = F_AFF + (size_t)be * SEQ + 16 * F.tid;
        unsigned v[16];
#pragma unroll
        for (int j = 0; j < 4; ++j) { const v4u q = *(const GAS v4u*)(a + 4 * j); v[4 * j] = q.x; v[4 * j + 1] = q.y; v[4 * j + 2] = q.z; v[4 * j + 3] = q.w; }
        unsigned prefix = 0u, mask = 0u; int kk = CAP;
#pragma unroll 1
        for (int pass = 0; pass < 4; ++pass) { const int shift = 24 - 8 * pass;
            __syncthreads();
            if (F.tid < 256) hist[F.tid] = 0;
            __syncthreads();
#pragma unroll
            for (int j = 0; j < 16; ++j) if ((v[j] & mask) == prefix) __hip_atomic_fetch_add(&hist[(v[j] >> shift) & 255u], 1, __ATOMIC_RELAXED, __HIP_MEMORY_SCOPE_WORKGROUP);
            __syncthreads();
            if (F.wave == 0) {
                int c[4]; int s4 = 0;
#pragma unroll
                for (int j = 0; j < 4; ++j) { c[j] = hist[4 * F.lane + j]; s4 += c[j]; }
                int suf = s4;
#pragma unroll
                for (int o = 1; o < 64; o <<= 1) { const int t = __shfl_down(suf, o); if (F.lane + o < 64) suf += t; }
                int above = suf - s4;
#pragma unroll
                for (int j = 3; j >= 0; --j) { if (above < kk && kk <= above + c[j]) { sel[0] = 4 * F.lane + j; sel[1] = kk - above; } above += c[j]; }
            }
            __syncthreads();
            prefix |= (unsigned)sel[0] << shift; mask |= 255u << shift; kk = sel[1];
        }
        const unsigned T = prefix; const int need_eq = kk;
        int ceq = 0;
#pragma unroll
        for (int j = 0; j < 16; ++j) ceq += (v[j] == T) ? 1 : 0;
        int tot; int eqb = block_excl_scan(ceq, sc, F.tid, F.lane, F.wave, tot);
        unsigned selm = 0u; int csel = 0;
#pragma unroll
        for (int j = 0; j < 16; ++j) { bool s = v[j] > T; if (v[j] == T) { s = eqb < need_eq; ++eqb; } if (s) { selm |= 1u << j; ++csel; } }
        int slot = block_excl_scan(csel, sc, F.tid, F.lane, F.wave, tot);
        const int obase = (e * 2 + b) * CAP;
        int iv[16];
#pragma unroll
        for (int j = 0; j < 16; ++j) { const bool s = (selm >> j) & 1u; iv[j] = s ? slot : -1;
            if (s) { F_TOK[obase + slot] = 16 * F.tid + j; F_WTS[obase + slot] = __builtin_bit_cast(float, v[j]); ++slot; } }
        int* ip = F_INV + (size_t)be * SEQ + 16 * F.tid;
#pragma unroll
        for (int j = 0; j < 4; ++j) *(GAS v4u*)(ip + 4 * j) = (v4u){(unsigned)iv[4 * j], (unsigned)iv[4 * j + 1], (unsigned)iv[4 * j + 2], (unsigned)iv[4 * j + 3]};
        __syncthreads();
    }
}

struct GateUpOrder {
    int vcu, G; const char *H2, *WGU; const int* TOK;
    __device__ __forceinline__ bool next(int i, pg8::Unit& u) const {
        int e, pml, pn;
        if (G == 256) { if (i >= 8) return false; const int x = vcu >> 5, s = vcu & 31; e = 2 * x + (i >> 2); pml = s & 7; pn = 4 * (i & 3) + (s >> 3); }
        else { const int L = i * G + vcu; if (L >= 2048) return false; e = L >> 7; pml = L & 7; pn = (L >> 3) & 15; }
        u.pm = e * 8 + pml; u.pn = pn; u.kind = 0;
        u.A = H2; u.B = WGU + ((size_t)e * 2 * DEXP + (size_t)pn * 256) * DM; return true;
    }
    __device__ __forceinline__ const int* rows(const pg8::Unit& u) const { return TOK + u.pm * 256; }
    __device__ __forceinline__ int row_base(const pg8::Unit& u) const { return ((u.pm >> 2) & 1) * SEQ; }
};
struct EpiSwiGLU {
    static constexpr bool PERM = true;
    unsigned char* HID;
    __device__ __forceinline__ void operator()(const pg8::f32x4 (&acc)[2][2][4][2], const pg8::Unit& u, int wr, int wc, int fr, int fq) const { half(acc, u, wr, wc, fr, fq, 0); half(acc, u, wr, wc, fr, fq, 1); }
    __device__ __forceinline__ void half(const pg8::f32x4 (&acc)[2][2][4][2], const pg8::Unit& u, int wr, int wc, int fr, int fq, const int ai) const {
        asm volatile("" : "+v"(fr), "+v"(fq));
        const int row0 = u.pm * 256 + wr * 64 + fr, col0 = u.pn * 128 + wc * 32 + 8 * fq;
            v2u wm[4];
#pragma unroll
            for (int m = 0; m < 4; ++m) {
                float v[8];
#pragma unroll
                for (int n = 0; n < 2; ++n)
#pragma unroll
                    for (int i = 0; i < 4; i += 2) { const f32x2 g2 = (f32x2){acc[ai][0][m][n][i], acc[ai][0][m][n][i + 1]}, u2 = (f32x2){acc[ai][1][m][n][i], acc[ai][1][m][n][i + 1]};
                        f32x2 d2 = (f32x2){__builtin_amdgcn_exp2f(-g2.x), __builtin_amdgcn_exp2f(-g2.y)} + 1.0f;
                        const f32x2 r2 = (f32x2){__builtin_amdgcn_rcpf(d2.x), __builtin_amdgcn_rcpf(d2.y)}, h2 = (g2 * u2) * r2;
                        v[4 * n + i] = clamp448(h2.x); v[4 * n + i + 1] = clamp448(h2.y); }
                wm[m].x = pk4_fp8(v[0], v[1], v[2], v[3]); wm[m].y = pk4_fp8(v[4], v[5], v[6], v[7]); }
#pragma unroll
            for (int mp = 0; mp < 4; mp += 2) {
                const auto s0 = __builtin_amdgcn_permlane16_swap(wm[mp].x, wm[mp + 1].x, false, false), s1 = __builtin_amdgcn_permlane16_swap(wm[mp].y, wm[mp + 1].y, false, false);
                v4u w; w.x = s0[0]; w.y = s1[0]; w.z = s0[1]; w.w = s1[1];
                *(v4u*)(HID + (size_t)(row0 + ai * 128 + (mp + (fq & 1)) * 16) * DEXP + col0 - 8 * (fq & 1)) = w; }
    }
};
struct DownOrder {
    int vcu, G; const char *HID, *WD;
    __device__ __forceinline__ bool next(int i, pg8::Unit& u) const {
        int e, pml, pn;
        if (G == 256) { if (i >= 2) return false; const int x = vcu >> 5, s = vcu & 31; e = 2 * x + i; pml = s & 7; pn = s >> 3; }
        else { const int L = i * G + vcu; if (L >= 512) return false; e = L >> 5; pml = L & 7; pn = (L >> 3) & 3; }
        u.pm = e * 8 + pml; u.pn = pn; u.kind = 0;
        u.A = HID + (size_t)u.pm * 256 * DEXP; u.B = WD + ((size_t)e * DM + (size_t)pn * 256) * DEXP; return true;
    }
};
constexpr float YS_SCALE = 16.0f;
struct EpiDown {
    static constexpr bool PERM = true;
    unsigned char* YS; const float* WTS;
    __device__ __forceinline__ void operator()(const pg8::f32x4 (&acc)[2][2][4][2], const pg8::Unit& u, int wr, int wc, int fr, int fq) const {
        const int row0 = u.pm * 256 + wr * 64 + fr, col0 = u.pn * 256 + wc * 32 + 8 * fq;
#pragma unroll
        for (int ai = 0; ai < 2; ++ai) {
            v2u wm[4][2];
#pragma unroll
            for (int m = 0; m < 4; ++m) { const int row = row0 + ai * 128 + m * 16; const float wt = WTS[row] * YS_SCALE;
#pragma unroll
                for (int bj = 0; bj < 2; ++bj) { const pg8::f32x4 v0 = acc[ai][bj][m][0] * wt, v1 = acc[ai][bj][m][1] * wt;
                    wm[m][bj].x = pk4_fp8(clamp448(v0[0]), clamp448(v0[1]), clamp448(v0[2]), clamp448(v0[3])); wm[m][bj].y = pk4_fp8(clamp448(v1[0]), clamp448(v1[1]), clamp448(v1[2]), clamp448(v1[3])); } }
#pragma unroll
            for (int mp = 0; mp < 4; mp += 2)
#pragma unroll
                for (int bj = 0; bj < 2; ++bj) {
                    const auto s0 = __builtin_amdgcn_permlane16_swap(wm[mp][bj].x, wm[mp + 1][bj].x, false, false), s1 = __builtin_amdgcn_permlane16_swap(wm[mp][bj].y, wm[mp + 1][bj].y, false, false);
                    v4u w; w.x = s0[0]; w.y = s1[0]; w.z = s0[1]; w.w = s1[1];
                    *(v4u*)(YS + (size_t)(row0 + ai * 128 + (mp + (fq & 1)) * 16) * DM + col0 + bj * 128 - 8 * (fq & 1)) = w; } }
    }
};

__device__ __forceinline__ void p9_final(Frame& F) {
    const int gw = F.vcu * NWAVES + F.wave, NGW = F.G * NWAVES, lane = F.lane, half = lane >> 5, l32 = lane & 31;
    for (int pr = gw; pr < MTOK / 2; pr += NGW) {
        const int m = 2 * pr + half, b = m >> 13, t = m & (SEQ - 1);
        const float* mod = F_MOD + (size_t)b * NMODV;
        int slotv = -1;
        if (l32 < 16) slotv = F_INV[(size_t)(b * NEXP + l32) * SEQ + t];
        f32x4 v[8], sum[8];
#pragma unroll
        for (int j = 0; j < 4; ++j) { const v4u w = ((const GAS v4u*)(F_X1 + (size_t)m * DM))[l32 + 32 * j];
            v[2 * j] = (f32x4){bf_lo(w.x), bf_hi(w.x), bf_lo(w.y), bf_hi(w.y)}; v[2 * j + 1] = (f32x4){bf_lo(w.z), bf_hi(w.z), bf_lo(w.w), bf_hi(w.w)};
            sum[2 * j] = (f32x4){0.f, 0.f, 0.f, 0.f}; sum[2 * j + 1] = (f32x4){0.f, 0.f, 0.f, 0.f}; }
        const unsigned long long bal = __ballot(slotv >= 0);
        unsigned my16 = (unsigned)(bal >> (32 * half)) & 0xffffu;
        const int cnt = __popc(my16), ocnt = __popc((unsigned)(bal >> (32 * (1 - half))) & 0xffffu);
        const int maxcnt = cnt > ocnt ? cnt : ocnt;
        for (int k0 = 0; k0 < maxcnt; k0 += 4) {
            v2u rows[4][4]; bool val[4];
#pragma unroll
            for (int kk = 0; kk < 4; ++kk) { val[kk] = my16 != 0u; const int e = val[kk] ? (__ffs(my16) - 1) : 0; my16 &= my16 - 1u;
                const int sl = __shfl(slotv, 32 * half + e);
                const GAS v2u* yr = (const GAS v2u*)((const unsigned char*)F_YS + (size_t)((e * 2 + b) * CAP + (sl < 0 ? 0 : sl)) * DM) + l32;
#pragma unroll
                for (int j = 0; j < 4; ++j) rows[kk][j] = val[kk] ? yr[32 * j] : (v2u){0u, 0u}; }
#pragma unroll
            for (int kk = 0; kk < 4; ++kk)
#pragma unroll
                for (int j = 0; j < 4; ++j) { const v2u w = rows[kk][j];
                    const auto a0 = __builtin_amdgcn_cvt_pk_f32_fp8((int)w.x, false), a1 = __builtin_amdgcn_cvt_pk_f32_fp8((int)w.x, true), a2 = __builtin_amdgcn_cvt_pk_f32_fp8((int)w.y, false), a3 = __builtin_amdgcn_cvt_pk_f32_fp8((int)w.y, true);
                    sum[2 * j].x += a0[0]; sum[2 * j].y += a0[1]; sum[2 * j].z += a1[0]; sum[2 * j].w += a1[1];
                    sum[2 * j + 1].x += a2[0]; sum[2 * j + 1].y += a2[1]; sum[2 * j + 1].z += a3[0]; sum[2 * j + 1].w += a3[1]; }
        }
        float ss = 0.f;
#pragma unroll
        for (int q = 0; q < 8; ++q) { const int col = 8 * l32 + 256 * (q >> 1) + 4 * (q & 1); const f32x4 g2 = *(const GAS f32x4*)(mod + 5 * DM + col);
            v[q] = v[q] + g2 * (sum[q] * (1.0f / YS_SCALE)); ss += (v[q].x * v[q].x + v[q].y * v[q].y) + (v[q].z * v[q].z + v[q].w * v[q].w); }
        const float rstd = 1.0f / sqrtf(half_sum(ss, half) * (1.0f / DM) + EPS);
#pragma unroll
        for (int q = 0; q < 8; ++q) { const int col = 8 * l32 + 256 * (q >> 1) + 4 * (q & 1); const f32x4 g = *(const GAS f32x4*)(F_norm_final_g + col);
            *(GAS f32x4*)(F_out + (size_t)m * DM + col) = v[q] * rstd * g; }
    }
}

constexpr int N_PHASES = 9;
#ifndef P2_QUOTA
#define P2_QUOTA 0
#endif
#ifndef P2_QWAVES
#define P2_QWAVES 8
#endif
__global__ void __launch_bounds__(NWAVES * 64, 2) mk_fwd(Args args) {
    extern __shared__ __attribute__((aligned(16))) unsigned char lds[];
    Frame F;
    F.lds = (LAS unsigned char*)lds;
    F.MISC = (volatile LAS unsigned*)(F.lds + MISC_OFF);
    F.tid = threadIdx.x; F.lane = F.tid & 63; F.wave = __builtin_amdgcn_readfirstlane(F.tid >> 6);
    F.G = gridDim.x; { const int bx = blockIdx.x; F.vcu = (F.G % 8 == 0) ? (bx % 8) * (F.G / 8) + bx / 8 : bx; }
    F.a = &args; F.pacc = 0ull;
    gu32* ctl = (gu32*)(args.ws + WS_CTL);
    for (int u = F.tid; u < (MISC_OFF + 128 - LDSCTL_OFF) / 4; u += NWAVES * 64) ((LAS unsigned*)(F.lds + LDSCTL_OFF))[u] = 0u;
    __syncthreads();
    const int lo = args.ph_lo, hi = args.ph_hi;
    const bool multi = (hi - lo) > 1;
    XcdBarrier bar; bar.bar = (unsigned*)(ctl + CW_BAR); bar.x = 0; bar.st = nullptr;
    if (multi) bar = xcd_barrier_post((unsigned*)(ctl + CW_BAR), F.MISC + 8);
#ifndef PH_MASK
#define PH_MASK 0xFFFF
#endif
#define IN(k) ((((PH_MASK) >> (k)) & 1) && lo <= (k) && (k) < hi)
#define SEAM(k) do { if ((k) != 0 && (k) != 3 && (k) != 4 && (k) != 5 && IN(k) && IN((k) + 1)) xcd_barrier(bar); } while (0)

#ifndef PROBE_REP
#define PROBE_REP 0
#endif
#define NREP(k) (1 + (((PROBE_REP) >> (k)) & 1))
#ifndef PROBE_SPAN
#define PROBE_SPAN -1
#endif
    unsigned long long span_t0 = 0ull, span_dt = 0ull;
#define PHASE(k, ...) if (IN(k)) { if ((k) == PROBE_SPAN) span_t0 = __builtin_amdgcn_s_memrealtime(); for (int rep_ = 0; rep_ < NREP(k); ++rep_) { __VA_ARGS__; if (rep_ + 1 < NREP(k)) xcd_barrier(bar); } SEAM(k); if ((k) == PROBE_SPAN) span_dt = __builtin_amdgcn_s_memrealtime() - span_t0; }
    if (PROBE_SPAN == 99) span_t0 = __builtin_amdgcn_s_memrealtime();
    f32x4 xv_[P1_IT][P1_RW][4];
    PHASE(0, p0_prologue(F, xv_))
    PHASE(1, p1_hpass(F, xv_))
    PHASE(2, { EpiInProj E{F_U, F_Q, F_K, F_VT, 0.125f * LOG2E};
               { GluOrder S{F.vcu, F.G, (const char*)F_H, (const char*)F_WIN}; pg8::gemm_phase<EpiInProj, GluOrder>(F.lds + RING_OFF, 2 * DM, S, E); }
               { QkvOrder S{F.vcu, F.G, (const char*)F_H8, (const char*)F_WQKV8}; pg8::gemm_phase<EpiInProj, QkvOrder, false, true>(F.lds + RING_OFF, DM, S, E); }
               if (F.vcu < NB * GROWS) p3_bias_fill(F, F.vcu % GROWS); })
    PHASE(3, p3_mixers(F, lo <= 2))
    PHASE(4, { OutProjOrder S{F.vcu, F.G, (const char*)F_MIX, (const char*)F_WOUT};
               EpiOutProj E{F_x, F_MOD, F_X1};
               unsigned* c3 = (unsigned*)WSP(unsigned, WS_CTL) + CW_ARR3; unsigned* c4 = (unsigned*)WSP(unsigned, WS_CTL) + CW_ARR4; unsigned* tmo = (unsigned*)WSP(unsigned, WS_CTL) + CW_TMO;
               pg8::Unit u0; const bool one = (F.G == 256) && S.next(0, u0);
               if (one) wait_counter(c3 + CW_ARRS * u0.pm, 4u, tmo); else wait_counter(c3 - CW_ARRS, (unsigned)(NB * GROWS), tmo);
               pg8::gemm_phase<EpiOutProj, OutProjOrder>(F.lds + RING_OFF, 2 * DM, S, E);
               if (one) arrive_counter2(c4 + CW_ARRS * u0.pm, c4 - CW_ARRS); else { pg8::Unit uu; for (int i = 0; S.next(i, uu); ++i) arrive_counter2(c4 + CW_ARRS * uu.pm, c4 - CW_ARRS); } })
    PHASE(5, p5_router(F))
    PHASE(6, { p6_topk(F);
               const bool spec = (F.G == 256); const int cpx = P5_CONV / 8;
               const int cwi = (((F.vcu >> 5) * cpx + ((F.vcu & 31) - (32 - cpx))) * NWAVES + F.wave);
               moe_weights<true>(F, (unsigned*)(ctl + CW_WQ), -1, (spec && p5_is_converter(F)) ? F.G * NWAVES + cwi : -1, spec ? P5_CONV * NWAVES : 0); })
    PHASE(7, { GateUpOrder S{F.vcu, F.G, (const char*)F_H2, (const char*)F_WGU, F_TOK};
               EpiSwiGLU E{(unsigned char*)F_HID};
               DownSide SD{F_w_down, (unsigned char*)F_WD, F.vcu * NWAVES + F.wave, F.G * NWAVES, F.lane};
               pg8::gemm_phase<EpiSwiGLU, GateUpOrder, true, true, true, true, DownSide>(F.lds + RING_OFF, DM, S, E, SD);
               { pg8::Unit uu; int nu = 0; while (S.next(nu, uu)) ++nu;
                 for (int ui = nu; ui * SD.NGW + SD.gw < DOWN_ITEMS; ++ui) { f32x4 v[8]; SD.issue(ui, v); SD.finish(ui, v); } } })
    PHASE(8, { DownOrder S{F.vcu, F.G, (const char*)F_HID, (const char*)F_WD};
               EpiDown E{(unsigned char*)F_YS, F_WTS};
               pg8::gemm_phase<EpiDown, DownOrder, false, true>(F.lds + RING_OFF, DEXP, S, E); })
    PHASE(9, p9_final(F))
    if (PROBE_SPAN == 99) span_dt = __builtin_amdgcn_s_memrealtime() - span_t0;
    if (PROBE_SEC > 0) span_dt = F.pacc;
    if ((PROBE_SPAN >= 0 || PROBE_SEC > 0) && blockIdx.x == 0) { const unsigned long long t0 = __builtin_amdgcn_s_memrealtime(); while (__builtin_amdgcn_s_memrealtime() - t0 < span_dt * PROBE_AMP) __builtin_amdgcn_s_sleep(8); }
#undef IN
#undef SEAM
}

extern "C" void kernel_launch(void* const* d_in, const int* in_sizes, int n_in, void* d_out, int out_size, void* d_ws, size_t ws_size, hipStream_t stream) {
    static int grid = 0;
    if (grid == 0) {
        if (n_in != 20 || out_size != MTOK * DM || ws_size < WS_END) { fprintf(stderr, "kernel_launch: unexpected shapes (n_in %d out %d ws %zu)\n", n_in, out_size, ws_size); grid = -1; return; }
        int dev = 0, cus = 0, per_cu = 0;
        if (hipGetDevice(&dev) != hipSuccess || hipDeviceGetAttribute(&cus, hipDeviceAttributeMultiprocessorCount, dev) != hipSuccess) { grid = -1; return; }
        if (hipFuncSetAttribute((const void*)mk_fwd, hipFuncAttributeMaxDynamicSharedMemorySize, LDS_BYTES) != hipSuccess) { fprintf(stderr, "kernel_launch: hipFuncSetAttribute failed\n"); grid = -1; return; }
        if (hipOccupancyMaxActiveBlocksPerMultiprocessor(&per_cu, (const void*)mk_fwd, NWAVES * 64, LDS_BYTES) != hipSuccess || per_cu < 1) { fprintf(stderr, "kernel_launch: occupancy query says %d\n", per_cu); per_cu = 1; }
        (void)hipGetLastError();
        grid = cus;
    }
    if (grid < 0) return;
    (void)hipMemsetAsync((char*)d_ws + WS_CTL, 0, CTL_ZERO_BYTES, stream);
    Args a{};
    for (int i = 0; i < 20; ++i) a.in[i] = (const float*)d_in[i];
    a.out = (float*)d_out; a.ws = (unsigned char*)d_ws;
#if MK_ONE_LAUNCH
    a.ph_lo = 0; a.ph_hi = N_PHASES + 1;
    hipLaunchKernelGGL(mk_fwd, dim3(grid), dim3(NWAVES * 64), LDS_BYTES, stream, a);
#else
    for (int p = 1; p <= N_PHASES; ++p) { a.ph_lo = (p == 1) ? 0 : p; a.ph_hi = p + 1; hipLaunchKernelGGL(mk_fwd, dim3(grid), dim3(NWAVES * 64), LDS_BYTES, stream, a); }
#endif
}
```
